# Optimizing an MI355X kernel written in HIP

```python
import jax
import jax.numpy as jnp
from jax import lax
import numpy as np

D_MODEL = 1024
BATCH = 16
SEQ = 256
DEPTH = 1
DEC_BATCH = 2
DEC_SEQ = 2048
PAST_LEN = 256

GRID_W = 64
RWKV_WIDTH = 512
HEAD_DIM = 64
N_HEADS = RWKV_WIDTH // HEAD_DIM
CONV_WIDTH = 512
CONV_K = 31
D_FF = 4 * D_MODEL
DECAY_LORA = 64
ICLR_LORA = 64
GATE_LORA = 128
N_DIR = 2
IN_COLS = 3 * RWKV_WIDTH + 2 * CONV_WIDTH + 2 * D_MODEL
RMS_EPS = 1e-6
LN_EPS = 1e-5
GN_EPS = 64e-5

kernel_name = 'hybrid_rwkv7_conformer_dit_step'


def _rmsnorm(x, g):
    xf = x.astype(jnp.float32)
    y = xf * lax.rsqrt(jnp.mean(xf * xf, axis=-1, keepdims=True) + RMS_EPS) * g.astype(jnp.float32)
    return y.astype(x.dtype)


def _heads(t):
    return t.reshape(t.shape[0], t.shape[1], N_HEADS, HEAD_DIM)


def _token_shift(u, mu_prev, mu_next):
    prev = jnp.pad(u, ((0, 0), (1, 0), (0, 0)))[:, :-1]
    nxt = jnp.pad(u, ((0, 0), (0, 1), (0, 0)))[:, 1:]
    return u + (prev - u) * mu_prev + (nxt - u) * mu_next


def _wkv(s0, r, w, k, v, a, b, reverse):
    xs = tuple(jnp.moveaxis(t.astype(jnp.float32), 1, 0) for t in (r, w, k, v, a, b))

    def step(S, inp):
        rt, wt, kt, vt, at, bt = inp
        sa = jnp.einsum('bhvk,bhk->bhv', S, at)
        S = S * wt[:, :, None, :] + sa[..., None] * bt[:, :, None, :] + vt[..., None] * kt[:, :, None, :]
        return S, jnp.einsum('bhvk,bhk->bhv', S, rt)

    s_fin, ys = lax.scan(step, s0.astype(jnp.float32), xs, reverse=reverse)
    return jnp.moveaxis(ys, 0, 1), s_fin


def _rwkv_branch(xn, rkv, s0_f, s0_b, lp):
    B, T, _ = xn.shape
    rkv = _token_shift(rkv, lp['mu_prev'], lp['mu_next'])
    r, k, v = jnp.split(rkv, 3, axis=-1)
    kk = _heads(k * lp['k_k']).astype(jnp.float32)
    kk = kk * lax.rsqrt(jnp.maximum(jnp.sum(kk * kk, axis=-1, keepdims=True), 1e-24))
    g = jax.nn.sigmoid(xn @ lp['gate_g1']) @ lp['gate_g2']
    rh, vh = _heads(r), _heads(v)

    def direction(d, s0, reverse):
        w_log = -jax.nn.softplus(-(lp['decay_w0'][d] + jnp.tanh(xn @ lp['decay_w1'][d]) @ lp['decay_w2'][d])) - 0.5
        decay = jnp.exp(-jnp.exp(w_log.astype(jnp.float32)))
        a = jax.nn.sigmoid(lp['iclr_a0'][d] + (xn @ lp['iclr_a1'][d]) @ lp['iclr_a2'][d])
        kd = _heads(k * (1 + (a - 1) * lp['k_a']))
        ah = _heads(a).astype(jnp.float32)
        y, s_fin = _wkv(s0, rh, _heads(decay), kd, vh, -kk, kk * ah, reverse)
        bonus = jnp.sum((rh * kd).astype(jnp.float32) * lp['r_k'], axis=-1, keepdims=True) * vh.astype(jnp.float32)
        return y, bonus, s_fin

    y_f, bonus_f, s_f = direction(0, s0_f, False)
    y_b, bonus_b, s_b = direction(1, s0_b, True)
    y = y_f + y_b
    mu = jnp.mean(y, axis=-1, keepdims=True)
    var = jnp.mean(jnp.square(y - mu), axis=-1, keepdims=True)
    yn = ((y - mu) * lax.rsqrt(var + GN_EPS)).reshape(B, T, RWKV_WIDTH) * lp['lnx_g'] + lp['lnx_b']
    out = (yn + (bonus_f + bonus_b).reshape(B, T, RWKV_WIDTH)) * g
    return out.astype(xn.dtype) @ lp['w_out_rwkv'], s_f, s_b


def _conv_branch(glu_in, rows, lp):
    a, gt = jnp.split(glu_in, 2, axis=-1)
    u = a * jax.nn.sigmoid(gt)
    B, T, C = u.shape
    if rows is not None:
        u = u.reshape(B * rows, T // rows, C)
    u = lax.conv_general_dilated(u, lp['conv_w'][:, None, :], (1,), [(CONV_K // 2, CONV_K // 2)],
                                 dimension_numbers=('NWC', 'WIO', 'NWC'), feature_group_count=C) + lp['conv_b']
    u = u.reshape(B, T, C)
    uf = u.astype(jnp.float32)
    mu = jnp.mean(uf, axis=-1, keepdims=True)
    var = jnp.mean(jnp.square(uf - mu), axis=-1, keepdims=True)
    un = ((uf - mu) * lax.rsqrt(var + LN_EPS) * lp['conv_ln_g'] + lp['conv_ln_b']).astype(u.dtype)
    return jax.nn.silu(un) @ lp['w_out_conv']


def _layer(x, cond, s0_f, s0_b, rows, lp):
    mod = jax.nn.silu(cond) @ lp['ada_w'] + lp['ada_b']
    sh1, sc1, g1, sh2, sc2, g2 = jnp.split(mod[:, None, :], 6, axis=-1)
    xn = _rmsnorm(x, lp['norm1_g']) * (1 + sc1) + sh1
    proj = xn @ lp['w_in']
    rkv, glu_in, gates = jnp.split(proj, [3 * RWKV_WIDTH, 3 * RWKV_WIDTH + 2 * CONV_WIDTH], axis=-1)
    gate_r, gate_c = jnp.split(gates, 2, axis=-1)
    y_r, s_f, s_b = _rwkv_branch(xn, rkv, s0_f, s0_b, lp)
    y_c = _conv_branch(glu_in, rows, lp)
    merged = jax.nn.sigmoid(gate_r) * y_r + jax.nn.sigmoid(gate_c) * y_c
    x = x + g1 * (merged @ lp['w_o'])
    xn2 = _rmsnorm(x, lp['norm2_g']) * (1 + sc2) + sh2
    h = jnp.square(jax.nn.relu(xn2 @ lp['mlp_w1']))
    x = x + g2 * (h @ lp['mlp_w2'])
    return x, s_f, s_b


def setup_inputs(seed: int = 0) -> dict:
    key = jax.random.key(seed)
    ks = jax.random.split(key, 40)
    f32 = jnp.float32

    def nrm(i, shape, scale):
        return jax.random.normal(ks[i], shape, f32) * scale

    def uni(i, shape, lo, hi):
        return jax.random.uniform(ks[i], shape, f32, lo, hi)

    st_shape = (DEC_BATCH, DEPTH, N_HEADS, HEAD_DIM, HEAD_DIM)
    return {
        'x_prompt': nrm(0, (BATCH, SEQ, D_MODEL), 1.0),
        'x_sample': nrm(1, (DEC_BATCH, DEC_SEQ, D_MODEL), 1.0),
        'state_fwd': nrm(2, st_shape, 0.1),
        'state_bwd': nrm(3, st_shape, 0.1),
        'c': nrm(4, (DEC_BATCH, D_MODEL), 1.0),
        'c_ctx': nrm(5, (D_MODEL,), 1.0),
        'ada_w': nrm(6, (DEPTH, D_MODEL, 6 * D_MODEL), D_MODEL ** -0.5),
        'ada_b': nrm(7, (DEPTH, 6 * D_MODEL), 0.02),
        'norm1_g': 1.0 + nrm(8, (DEPTH, D_MODEL), 0.02),
        'norm2_g': 1.0 + nrm(9, (DEPTH, D_MODEL), 0.02),
        'w_in': nrm(10, (DEPTH, D_MODEL, IN_COLS), D_MODEL ** -0.5),
        'mu_prev': uni(11, (DEPTH, 3 * RWKV_WIDTH), 0.0, 0.5),
        'mu_next': uni(12, (DEPTH, 3 * RWKV_WIDTH), 0.0, 0.5),
        'decay_w0': uni(13, (DEPTH, N_DIR, RWKV_WIDTH), -6.0, -1.0),
        'decay_w1': nrm(14, (DEPTH, N_DIR, D_MODEL, DECAY_LORA), D_MODEL ** -0.5),
        'decay_w2': nrm(15, (DEPTH, N_DIR, DECAY_LORA, RWKV_WIDTH), 0.5 * DECAY_LORA ** -0.5),
        'iclr_a0': nrm(16, (DEPTH, N_DIR, RWKV_WIDTH), 0.1),
        'iclr_a1': nrm(17, (DEPTH, N_DIR, D_MODEL, ICLR_LORA), D_MODEL ** -0.5),
        'iclr_a2': nrm(18, (DEPTH, N_DIR, ICLR_LORA, RWKV_WIDTH), ICLR_LORA ** -0.5),
        'gate_g1': nrm(19, (DEPTH, D_MODEL, GATE_LORA), D_MODEL ** -0.5),
        'gate_g2': nrm(20, (DEPTH, GATE_LORA, RWKV_WIDTH), GATE_LORA ** -0.5),
        'k_k': 0.85 + nrm(21, (DEPTH, RWKV_WIDTH), 0.05),
        'k_a': 1.0 + nrm(22, (DEPTH, RWKV_WIDTH), 0.05),
        'r_k': nrm(23, (DEPTH, N_HEADS, HEAD_DIM), 0.1),
        'lnx_g': 1.0 + nrm(24, (DEPTH, RWKV_WIDTH), 0.02),
        'lnx_b': nrm(25, (DEPTH, RWKV_WIDTH), 0.02),
        'w_out_rwkv': nrm(26, (DEPTH, RWKV_WIDTH, D_MODEL), RWKV_WIDTH ** -0.5),
        'conv_w': nrm(27, (DEPTH, CONV_K, CONV_WIDTH), CONV_K ** -0.5),
        'conv_b': nrm(28, (DEPTH, CONV_WIDTH), 0.02),
        'conv_ln_g': 1.0 + nrm(29, (DEPTH, CONV_WIDTH), 0.02),
        'conv_ln_b': nrm(30, (DEPTH, CONV_WIDTH), 0.02),
        'w_out_conv': nrm(31, (DEPTH, CONV_WIDTH, D_MODEL), CONV_WIDTH ** -0.5),
        'w_o': nrm(32, (DEPTH, D_MODEL, D_MODEL), D_MODEL ** -0.5),
        'mlp_w1': nrm(33, (DEPTH, D_MODEL, D_FF), D_MODEL ** -0.5),
        'mlp_w2': nrm(34, (DEPTH, D_FF, D_MODEL), D_FF ** -0.5),
        'final_g': 1.0 + nrm(35, (D_MODEL,), 0.02),
    }


def reference(x_prompt, x_sample, state_fwd, state_bwd, c, c_ctx, ada_w, ada_b, norm1_g, norm2_g, w_in,
              mu_prev, mu_next, decay_w0, decay_w1, decay_w2, iclr_a0, iclr_a1, iclr_a2, gate_g1, gate_g2,
              k_k, k_a, r_k, lnx_g, lnx_b, w_out_rwkv, conv_w, conv_b, conv_ln_g, conv_ln_b, w_out_conv,
              w_o, mlp_w1, mlp_w2, final_g):
    rows = x_sample.shape[1] // GRID_W
    n_ctx_batch = x_prompt.shape[0]
    xp = x_prompt
    xs = x_sample
    new_f = []
    new_b = []
    for l in range(DEPTH):
        lp = dict(ada_w=ada_w[l], ada_b=ada_b[l], norm1_g=norm1_g[l], norm2_g=norm2_g[l], w_in=w_in[l],
                  mu_prev=mu_prev[l], mu_next=mu_next[l], decay_w0=decay_w0[l], decay_w1=decay_w1[l],
                  decay_w2=decay_w2[l], iclr_a0=iclr_a0[l], iclr_a1=iclr_a1[l], iclr_a2=iclr_a2[l],
                  gate_g1=gate_g1[l], gate_g2=gate_g2[l], k_k=k_k[l], k_a=k_a[l], r_k=r_k[l],
                  lnx_g=lnx_g[l], lnx_b=lnx_b[l], w_out_rwkv=w_out_rwkv[l], conv_w=conv_w[l], conv_b=conv_b[l],
                  conv_ln_g=conv_ln_g[l], conv_ln_b=conv_ln_b[l], w_out_conv=w_out_conv[l], w_o=w_o[l],
                  mlp_w1=mlp_w1[l], mlp_w2=mlp_w2[l])
        zeros = jnp.zeros((n_ctx_batch, N_HEADS, HEAD_DIM, HEAD_DIM), jnp.float32)
        xp, s_f, s_b = _layer(xp, c_ctx[None, :], zeros, zeros, None, lp)
        new_f.append(s_f.astype(x_prompt.dtype))
        new_b.append(s_b.astype(x_prompt.dtype))
        xs, _, _ = _layer(xs, c, state_fwd[:, l], state_bwd[:, l], rows, lp)
    y_prompt = _rmsnorm(xp, final_g)
    y_sample = _rmsnorm(xs, final_g)
    new_state_fwd = jnp.stack(new_f, axis=1)
    new_state_bwd = jnp.stack(new_b, axis=1)
    return (y_prompt, y_sample, new_state_fwd, new_state_bwd)
```

```cpp
#include <hip/hip_runtime.h>
#include <cstdio>
#include <cstdint>
namespace pg8 {
#define PG8_LAS __attribute__((address_space(3)))
typedef unsigned short bf16_t;
typedef short bf16x8 __attribute__((ext_vector_type(8)));
typedef float f32x4 __attribute__((ext_vector_type(4)));
typedef unsigned u32x4 __attribute__((ext_vector_type(4)));
constexpr int BM = 256, BK = 64, HALF = 128, HTB = HALF * BK * 2  , STAGE_BYTES = 8 * HTB, NXCD = 8, WGM = 8;

__host__ __device__ __forceinline__ int lds_byte(int r, int c) { const int st = (r >> 4) * 2 + (c >> 5), rr = r & 15, cc = c & 31, ob = rr * 64 + cc * 2; return st * 1024 + (ob ^ (((ob >> 9) & 1) << 5)); }
__host__ __device__ __forceinline__ void stage_rc(int b, int& R, int& C) { const int st = b / 1024, sb = b % 1024, swz = sb ^ (((sb >> 9) & 1) << 5); R = (st >> 1) * 16 + swz / 64; C = (st & 1) * 32 + (swz % 64) / 2; }
__host__ __device__ __forceinline__ int perm32(int rho) { const int n = rho >> 4, i = rho & 15; return 8 * (i >> 2) + 4 * n + (i & 3); }

struct Unit { int pm, pn; };
template <int LDA, int LDB, int KK, int GA, int ACOFF, int GB, int BCOFF>
struct Gemm { const bf16_t* A; const bf16_t* Bt;
    static constexpr int lda = LDA, ldb = LDB, K = KK;
    __device__ __forceinline__ const char* aptr(const Unit& u) const { return (const char*)(A + (size_t)u.pm * BM * LDA + (size_t)(u.pn / GA) * ACOFF); }
    __device__ __forceinline__ const char* bptr(const Unit& u) const { return (const char*)(Bt + (size_t)(u.pn % GB) * BM * LDB + (size_t)(u.pn / GB) * BCOFF); }
};

struct StaticOrder {
    int nM, nN, nwg, G, c;
    __host__ __device__ void init(int M, int N, int G_, int c_) { nM = M / BM; nN = N / BM; nwg = nM * nN; G = G_; c = c_; }
    __host__ __device__ bool next(int i, Unit& u) const {
        const long L = (long)i * G + c; if (L >= nwg) return false;
        int wgid = (int)L; { const int q = nwg / NXCD, r = nwg % NXCD, xcd = wgid % NXCD, off = wgid / NXCD; wgid = (xcd < r ? xcd * (q + 1) : r * (q + 1) + (xcd - r) * q) + off; }
        const int nig = WGM * nN, gid = wgid / nig, fm = gid * WGM, gsz = (nM - fm) < WGM ? (nM - fm) : WGM;
        u.pm = fm + ((wgid % nig) % gsz); u.pn = (wgid % nig) / gsz; return true;
    }
    __device__ __forceinline__ void a_ready(const Unit&) const {}
    __device__ __forceinline__ void done(const Unit&) const {}
};
#define PG8_LANE(x) asm volatile("v_mbcnt_lo_u32_b32 %0, -1, 0\n\tv_mbcnt_hi_u32_b32 %0, -1, %0" : "=v"(x))
typedef __bf16 bf16n2 __attribute__((ext_vector_type(2)));
typedef float f32n2 __attribute__((ext_vector_type(2)));
__device__ __forceinline__ unsigned cvt_pk_bf16(float lo, float hi) { const f32n2 v = {lo, hi}; const bf16n2 b = __builtin_convertvector(v, bf16n2); return __builtin_bit_cast(unsigned, b); }

template <class Epi, class Sched, class GemmT, bool ALIGN_EPI = false, bool SP2 = false>
__device__ __forceinline__ void gemm_phase(PG8_LAS unsigned char* lds, const GemmT g, const Sched& S, const Epi& E, const int wid) {
    int lane; PG8_LANE(lane);
    const int tid = wid * 64 + lane, wr = wid >> 2, wc = wid & 3, fr = lane & 15, fq = lane >> 4;
    const int K = g.K, nt = K / BK;
    unsigned voffA[2], voffB[2];
#pragma unroll
    for (int i = 0; i < 2; ++i) { int R, C; stage_rc(tid * 16 + i * 8192, R, C); const int Rb = Epi::PERM ? ((R & ~31) + perm32(R & 31)) : R;
        voffA[i] = (unsigned)(R * g.lda + C) * 2u; voffB[i] = (unsigned)(Rb * g.ldb + C) * 2u; }
    const size_t kstep = (size_t)(BK * 2);
    const size_t hstepA = (size_t)HALF * g.lda * 2, hstepB = (size_t)HALF * g.ldb * 2;
    const unsigned ldsw = (unsigned)wid * 1024u;
    const int aoff = lds_byte(wr * 64 + fr, fq * 8), boff = lds_byte(wc * 32 + fr, fq * 8);
#define PG8_SA(b, h) (((b) * 2 + (h)) * HTB)
#define PG8_SB(b, h) ((4 + (b) * 2 + (h)) * HTB)
#define PG8_STAGE(bufoff, gbase, voff) do { _Pragma("unroll") for (int _i = 0; _i < 2; ++_i) \
        __builtin_amdgcn_global_load_lds((const unsigned*)((const char*)(gbase) + (voff)[_i]), (PG8_LAS unsigned*)(lds + (bufoff) + ldsw + _i * 8192), 16, 0, 0); } while (0)
#define PG8_LDA(dst, b, h) do { _Pragma("unroll") for (int m = 0; m < 4; ++m) _Pragma("unroll") for (int k = 0; k < 2; ++k) dst[m][k] = *(const PG8_LAS bf16x8*)(lds + PG8_SA(b, h) + aoff + m * 2048 + k * 1024); } while (0)
#define PG8_LDB(dst, b, h) do { _Pragma("unroll") for (int n = 0; n < 2; ++n) _Pragma("unroll") for (int k = 0; k < 2; ++k) dst[n][k] = *(const PG8_LAS bf16x8*)(lds + PG8_SB(b, h) + boff + n * 2048 + k * 1024); } while (0)
#define PG8_MMA(ai, bj, At, Bt) do { __builtin_amdgcn_s_setprio(1); _Pragma("unroll") for (int m = 0; m < 4; ++m) _Pragma("unroll") for (int n = 0; n < 2; ++n) _Pragma("unroll") for (int k = 0; k < 2; ++k) \
        acc[ai][bj][m][n] = __builtin_amdgcn_mfma_f32_16x16x32_bf16(Bt[n][k], At[m][k], acc[ai][bj][m][n], 0, 0, 0); __builtin_amdgcn_s_setprio(0); } while (0)
#define PG8_WAIT_V(n) asm volatile("s_waitcnt vmcnt(" #n ")" ::: "memory")
#define PG8_WAIT_L(n) asm volatile("s_waitcnt lgkmcnt(" #n ")" ::: "memory")
#define PG8_BAR __builtin_amdgcn_s_barrier()
#define PG8_SCHED __builtin_amdgcn_sched_barrier(0)
    Unit cur, nxt; int ui = 0;
    if (!S.next(0, cur)) return;
    f32x4 acc[2][2][4][2];
#pragma unroll
    for (int a = 0; a < 2; ++a)
#pragma unroll
        for (int b = 0; b < 2; ++b)
#pragma unroll
            for (int m = 0; m < 4; ++m)
#pragma unroll
                for (int n = 0; n < 2; ++n) acc[a][b][m][n] = (f32x4){0.f, 0.f, 0.f, 0.f};
    bf16x8 At[4][2], B0[2][2], B1[2][2];
    const char* cA = g.aptr(cur); const char* cB = g.bptr(cur);
    S.a_ready(cur);
    if constexpr (SP2) {
        PG8_STAGE(PG8_SB(0, 0), cB, voffB); PG8_STAGE(PG8_SB(0, 1), cB + hstepB, voffB); PG8_STAGE(PG8_SA(0, 0), cA, voffA); PG8_STAGE(PG8_SA(0, 1), cA + hstepA, voffA);
        if (wr == 1) PG8_BAR;
        PG8_WAIT_V(2); PG8_BAR;
        PG8_STAGE(PG8_SB(1, 0), cB + kstep, voffB); PG8_STAGE(PG8_SA(1, 0), cA + kstep, voffA); PG8_STAGE(PG8_SB(1, 1), cB + hstepB + kstep, voffB);
        PG8_WAIT_V(6); PG8_BAR;
    } else {
        PG8_STAGE(PG8_SB(0, 0), cB, voffB); PG8_STAGE(PG8_SA(0, 0), cA, voffA); PG8_STAGE(PG8_SB(0, 1), cB + hstepB, voffB); PG8_STAGE(PG8_SA(0, 1), cA + hstepA, voffA);
        if (wr == 1) PG8_BAR;
        PG8_WAIT_V(4); PG8_BAR;
        PG8_STAGE(PG8_SB(1, 0), cB + kstep, voffB); PG8_STAGE(PG8_SA(1, 0), cA + kstep, voffA); PG8_STAGE(PG8_SB(1, 1), cB + hstepB + kstep, voffB);
        PG8_WAIT_V(6); PG8_BAR;
    }
    for (;;) {
        const bool has_next = S.next(ui + 1, nxt);
        const char* nA = has_next ? g.aptr(nxt) : cA; const char* nB = has_next ? g.bptr(nxt) : cB;
        for (int t = 0; t < nt; t += 2) {
            const bool last = (t == nt - 2);
            const char* a1 = cA + (size_t)(t + 1) * kstep;
            const char* a2 = last ? nA : cA + (size_t)(t + 2) * kstep; const char* b2 = last ? nB : cB + (size_t)(t + 2) * kstep;
            const char* a3 = a2 + kstep; const char* b3 = b2 + kstep;
            if (last && has_next) S.a_ready(nxt);
            if constexpr (SP2) {
            PG8_LDB(B0, 0, 0); PG8_LDB(B1, 0, 1); PG8_SCHED; PG8_LDA(At, 0, 0); PG8_STAGE(PG8_SA(1, 1), a1 + hstepA, voffA);
            PG8_WAIT_V(8); PG8_WAIT_L(0); PG8_BAR; PG8_MMA(0, 0, At, B0); PG8_MMA(0, 1, At, B1); PG8_BAR; PG8_SCHED;
            PG8_LDA(At, 0, 1); PG8_STAGE(PG8_SB(0, 0), b2, voffB); PG8_STAGE(PG8_SB(0, 1), b2 + hstepB, voffB); PG8_STAGE(PG8_SA(0, 0), a2, voffA);
            PG8_WAIT_V(8); PG8_WAIT_L(0); PG8_BAR; PG8_MMA(1, 0, At, B0); PG8_MMA(1, 1, At, B1); PG8_BAR; PG8_SCHED;
            PG8_LDB(B0, 1, 0); PG8_LDB(B1, 1, 1); PG8_SCHED; PG8_LDA(At, 1, 0); PG8_STAGE(PG8_SA(0, 1), a2 + hstepA, voffA);
            PG8_WAIT_V(8); PG8_WAIT_L(0); PG8_BAR; PG8_MMA(0, 0, At, B0); PG8_MMA(0, 1, At, B1); PG8_BAR; PG8_SCHED;
            PG8_LDA(At, 1, 1); PG8_STAGE(PG8_SB(1, 0), b3, voffB); PG8_STAGE(PG8_SB(1, 1), b3 + hstepB, voffB); PG8_STAGE(PG8_SA(1, 0), a3, voffA);
            PG8_WAIT_V(8); PG8_WAIT_L(0); PG8_BAR; PG8_MMA(1, 0, At, B0); PG8_MMA(1, 1, At, B1); PG8_BAR; PG8_SCHED;
            } else {
            PG8_LDB(B0, 0, 0); PG8_SCHED; PG8_LDA(At, 0, 0); PG8_STAGE(PG8_SA(1, 1), a1 + hstepA, voffA);
            PG8_WAIT_L(8); PG8_BAR; PG8_WAIT_L(0); PG8_MMA(0, 0, At, B0); PG8_BAR; PG8_SCHED;
            PG8_LDB(B1, 0, 1); PG8_STAGE(PG8_SB(0, 0), b2, voffB);
            PG8_BAR; PG8_WAIT_L(0); PG8_MMA(0, 1, At, B1); PG8_BAR;
            PG8_LDA(At, 0, 1); PG8_STAGE(PG8_SA(0, 0), a2, voffA);
            PG8_BAR; PG8_WAIT_L(0); PG8_MMA(1, 0, At, B0); PG8_BAR; PG8_SCHED;
            PG8_STAGE(PG8_SB(0, 1), b2 + hstepB, voffB);
            PG8_WAIT_V(6); PG8_BAR; PG8_MMA(1, 1, At, B1); PG8_BAR;
            PG8_LDB(B0, 1, 0); PG8_SCHED; PG8_LDA(At, 1, 0); PG8_STAGE(PG8_SA(0, 1), a2 + hstepA, voffA);
            PG8_WAIT_L(8); PG8_BAR; PG8_WAIT_L(0); PG8_MMA(0, 0, At, B0); PG8_BAR; PG8_SCHED;
            PG8_LDB(B1, 1, 1); PG8_STAGE(PG8_SB(1, 0), b3, voffB);
            PG8_BAR; PG8_WAIT_L(0); PG8_MMA(0, 1, At, B1); PG8_BAR;
            PG8_LDA(At, 1, 1); PG8_STAGE(PG8_SA(1, 0), a3, voffA);
            PG8_BAR; PG8_WAIT_L(0); PG8_MMA(1, 0, At, B0); PG8_BAR; PG8_SCHED;
            PG8_STAGE(PG8_SB(1, 1), b3 + hstepB, voffB);
            PG8_WAIT_V(6); PG8_BAR; PG8_MMA(1, 1, At, B1); PG8_BAR;
            }
        }
        if constexpr (ALIGN_EPI) { if (wr == 0) PG8_BAR; }
        if constexpr (!Epi::AFTER_DRAIN) { int el; PG8_LANE(el); E(acc, cur, wr, wc, el & 15, el >> 4); S.done(cur); }
        if (!has_next) break;
#pragma unroll
        for (int a = 0; a < 2; ++a)
#pragma unroll
            for (int b = 0; b < 2; ++b)
#pragma unroll
                for (int m = 0; m < 4; ++m)
#pragma unroll
                    for (int n = 0; n < 2; ++n) acc[a][b][m][n] = (f32x4){0.f, 0.f, 0.f, 0.f};
        cur = nxt; cA = nA; cB = nB; ++ui;
        if constexpr (ALIGN_EPI) { if (wr == 1) PG8_BAR; }
    }
    PG8_WAIT_V(0);
    if constexpr (!ALIGN_EPI) { if (wr == 0) PG8_BAR; }
    PG8_BAR;
    if constexpr (Epi::AFTER_DRAIN) { E.fused(acc, cur, wr, wc, fr, fq, lds, wid, lane); S.done(cur); }
#undef PG8_SA
#undef PG8_SB
#undef PG8_STAGE
#undef PG8_LDA
#undef PG8_LDB
#undef PG8_MMA
#undef PG8_WAIT_V
#undef PG8_WAIT_L
#undef PG8_BAR
#undef PG8_SCHED
}
}

constexpr int NWAVES = 8;
constexpr int NTOK = 8192, NCTX = 4096, DM = 1024, RW = 512, NH = 8, HD = 64, DFF = 4096;
constexpr int N_IN = 5888;
constexpr int NPH = 13;
#ifndef MK_ONE_LAUNCH
#define MK_ONE_LAUNCH 1
#endif
constexpr size_t MiB = 1u << 20;
constexpr size_t WS_CTL = 0, CTL_ZERO_BYTES = 64 * 1024;
constexpr size_t WS_MOD = 1 * MiB;
constexpr size_t WS_WIN = 2 * MiB;
constexpr size_t WS_B2 = 14 * MiB;
constexpr size_t WS_WOUT = 16 * MiB;
constexpr size_t WS_WO = 18 * MiB;
constexpr size_t WS_W1 = 20 * MiB;
constexpr size_t WS_W2 = 28 * MiB;
constexpr size_t WS_XN = 36 * MiB;
constexpr size_t WS_A2 = 52 * MiB;
constexpr size_t WS_RKV = 72 * MiB;
constexpr size_t WS_PB = 120 * MiB;
constexpr size_t WS_WD = 168 * MiB;
constexpr size_t WS_AL = 200 * MiB;
constexpr size_t WS_RECB = 216 * MiB;
constexpr size_t WS_GC = 252 * MiB;
constexpr size_t WS_END = 256 * MiB;
constexpr size_t WS_RECA = 168 * MiB;
constexpr size_t REC_BYTES = 18432;
constexpr size_t WS_YF = WS_RKV, WS_YB = WS_RKV + 16 * MiB, WS_RC = WS_RKV + 32 * MiB;
constexpr size_t WS_GM = WS_RKV, WS_H = WS_RKV;
constexpr size_t WS_PART = 168 * MiB;
constexpr size_t DO_G = 0, DO_V = 8 * MiB, DO_VT = 16 * MiB, DO_DOT = 24 * MiB;
constexpr int CW_MODCNT = 512;
constexpr int CW_BAR = 1024;
constexpr int RING_BYTES = 131072;
constexpr int LDSCTL_OFF = RING_BYTES, MISC_OFF = LDSCTL_OFF + 320;
constexpr int LDS_BYTES = 147456;

#define GAS __attribute__((address_space(1)))
#define LAS __attribute__((address_space(3)))
typedef unsigned short bf16;
typedef unsigned v4u __attribute__((ext_vector_type(4)));
typedef unsigned v2u __attribute__((ext_vector_type(2)));
typedef float f32x4 __attribute__((ext_vector_type(4)));
#define LDS_WAIT() asm volatile("s_waitcnt lgkmcnt(0)" ::: "memory")
#define VM_WAIT() asm volatile("s_waitcnt vmcnt(0)" ::: "memory")
__device__ __forceinline__ unsigned pk2(float lo, float hi) { return pg8::cvt_pk_bf16(lo, hi); }
__device__ __forceinline__ float bflo(unsigned u) { return __uint_as_float(u << 16); }
__device__ __forceinline__ float bfhi(unsigned u) { return __uint_as_float(u & 0xffff0000u); }
__device__ __forceinline__ float bf1(bf16 u) { return __uint_as_float((unsigned)u << 16); }
__device__ __forceinline__ float sigm(float x) { return __builtin_amdgcn_rcpf(1.0f + __expf(-x)); }
__device__ __forceinline__ float tanh_fast(float x) { const float t = __expf(2.0f * x); return 1.0f - 2.0f * __builtin_amdgcn_rcpf(t + 1.0f); }
__device__ __forceinline__ v4u pack8(const f32x4 a, const f32x4 b) { v4u w; w.x = pk2(a[0], a[1]); w.y = pk2(a[2], a[3]); w.z = pk2(b[0], b[1]); w.w = pk2(b[2], b[3]); return w; }
__device__ __forceinline__ void unpack8(const v4u w, float (&o)[8]) { o[0] = bflo(w.x); o[1] = bfhi(w.x); o[2] = bflo(w.y); o[3] = bfhi(w.y); o[4] = bflo(w.z); o[5] = bfhi(w.z); o[6] = bflo(w.w); o[7] = bfhi(w.w); }
__device__ __forceinline__ float wave_sum(float v) {
#pragma unroll
    for (int o = 1; o < 64; o <<= 1) v += __shfl_xor(v, o);
    return v;
}
__device__ __forceinline__ float oct_sum(float v) { v += __shfl_xor(v, 1); v += __shfl_xor(v, 2); v += __shfl_xor(v, 4); return v; }

#define XB_TMO      128
#define XB_XCNT(j)  (256  + 64 * (j))
#define XB_XSUB(j)  (1280 + 64 * (j))
#define XB_XGEN(j)  (2304 + 64 * (j))
#define XB_TOP      3328
#define XB_TOPGEN   3392
#define XCD_BAR_WORDS 3456
#define XB_SPIN_CAP (1u << 18)
__device__ __forceinline__ unsigned xb_ld(unsigned* p)              { return __hip_atomic_load(p, __ATOMIC_RELAXED, __HIP_MEMORY_SCOPE_AGENT); }
__device__ __forceinline__ unsigned xb_add(unsigned* p, unsigned v) { return __hip_atomic_fetch_add(p, v, __ATOMIC_RELAXED, __HIP_MEMORY_SCOPE_AGENT); }
__device__ __forceinline__ unsigned xb_xcc_id() { return (unsigned)__builtin_amdgcn_s_getreg((3 << 11) | 20) & 0xFu; }
#define XB_SPIN(cond, bar) do { unsigned _sp = 0; while (cond) { __builtin_amdgcn_s_sleep(1); \
    if ((++_sp & 255u) == 0u) { if (xb_ld(&(bar)[XB_TMO])) break; if (_sp > XB_SPIN_CAP) { atomicAdd(&(bar)[XB_TMO], 1u); break; } } } } while (0)
struct XcdBarrier { unsigned* bar; unsigned x; volatile LAS unsigned* st; };
__device__ __forceinline__ XcdBarrier xcd_barrier_post(unsigned* bar, volatile LAS unsigned* st) {
    XcdBarrier b; b.bar = bar; b.x = xb_xcc_id(); b.st = st;
    if (threadIdx.x == 0) (void)xb_add(&bar[XB_XCNT(b.x)], 1u);
    return b;
}
__device__ __forceinline__ void xcd_barrier_complete(unsigned* bar, unsigned x, unsigned& nloc, unsigned& nx) {
    const unsigned G = gridDim.x * gridDim.y * gridDim.z;
    unsigned sum, cnt, mine, sp = 0u;
    for (;;) {
        sum = 0u; cnt = 0u; mine = 0u;
#pragma unroll
        for (unsigned j = 0; j < 16; ++j) { const unsigned c = xb_ld(&bar[XB_XCNT(j)]); sum += c; cnt += (c > 0u) ? 1u : 0u; mine = (j == x) ? c : mine; }
        if (sum == G) break;
        __builtin_amdgcn_s_sleep(1);
        if ((++sp & 255u) == 0u) { if (xb_ld(&bar[XB_TMO])) break; if (sp > XB_SPIN_CAP) { atomicAdd(&bar[XB_TMO], 1u); break; } }
    }
    nloc = mine > 0u ? mine : 1u; nx = cnt > 0u ? cnt : 1u;
}
__device__ __forceinline__ void xcd_barrier(const XcdBarrier& b, const int wave0) {
    asm volatile("s_waitcnt vmcnt(0)" ::: "memory");
    __syncthreads();
    int l_; PG8_LANE(l_);
    if (wave0 == 0 && l_ == 0) {
        unsigned* bar = b.bar;
        __builtin_amdgcn_s_waitcnt(0);
        unsigned nloc = b.st[0], nx = b.st[1];
        if (nloc == 0u) { xcd_barrier_complete(bar, b.x, nloc, nx); b.st[0] = nloc; b.st[1] = nx; }
        const unsigned old = xb_add(&bar[XB_XSUB(b.x)], 1u);
        const unsigned gen = old / nloc;
        if (old + 1u == (gen + 1u) * nloc) {
            __builtin_amdgcn_fence(__ATOMIC_RELEASE, "agent");
            asm volatile("s_waitcnt vmcnt(0)" ::: "memory");
            const unsigned og = xb_add(&bar[XB_TOP], 1u);
            const unsigned tg = og / nx;
            if (og + 1u == (tg + 1u) * nx) xb_add(&bar[XB_TOPGEN], 1u);
            else XB_SPIN(xb_ld(&bar[XB_TOPGEN]) == tg, bar);
            __builtin_amdgcn_fence(__ATOMIC_ACQUIRE, "agent");
            xb_add(&bar[XB_XGEN(b.x)], 1u);
            asm volatile("s_waitcnt vmcnt(0)" ::: "memory");
        } else {
            XB_SPIN(xb_ld(&bar[XB_XGEN(b.x)]) == gen, bar);
            __builtin_amdgcn_fence(__ATOMIC_ACQUIRE, "agent");
            asm volatile("s_waitcnt vmcnt(0)" ::: "memory");
        }
    }
    __syncthreads();
}

struct Params { const float* in[36]; float* out; unsigned char* ws; int ph_lo, ph_hi, dupmask, pad; };
enum { I_XP = 0, I_XS, I_SF, I_SB, I_C, I_CCTX, I_ADAW, I_ADAB, I_N1G, I_N2G, I_WIN, I_MUP, I_MUN, I_DW0, I_DW1, I_DW2, I_IA0, I_IA1, I_IA2, I_GG1, I_GG2,
       I_KK, I_KA, I_RK, I_LNXG, I_LNXB, I_WOR, I_CW, I_CB, I_CLG, I_CLB, I_WOC, I_WO, I_W1, I_W2, I_FG };

typedef const __attribute__((address_space(4))) Params* KPtr;
__device__ __forceinline__ int cond_of(int m) { return m < NCTX ? 0 : 1 + ((m - NCTX) >> 11); }

struct EpiG1 {
    static constexpr bool PERM = true, AFTER_DRAIN = false;
    bf16* RKV; bf16* PB; bf16* A2;
    __device__ __forceinline__ void operator()(const f32x4 (&acc)[2][2][4][2], const pg8::Unit& u, int wr, int wc, int fr, int fq) const {
        const int row0 = u.pm * 256 + wr * 64 + fr, colt = wc * 32 + 8 * fq;
        if (u.pn < 6) {
#pragma unroll
            for (int ai = 0; ai < 2; ++ai)
#pragma unroll
                for (int m = 0; m < 4; ++m) { bf16* rp = RKV + (size_t)(row0 + ai * 128 + m * 16) * 1536 + u.pn * 256 + colt;
#pragma unroll
                    for (int bj = 0; bj < 2; ++bj) *(v4u*)(rp + bj * 128) = pack8(acc[ai][bj][m][0], acc[ai][bj][m][1]); }
        } else if (u.pn < 18) {
#pragma unroll
            for (int ai = 0; ai < 2; ++ai)
#pragma unroll
                for (int m = 0; m < 4; ++m) { bf16* rp = PB + (size_t)(row0 + ai * 128 + m * 16) * 3072 + (u.pn - 6) * 256 + colt;
#pragma unroll
                    for (int bj = 0; bj < 2; ++bj) *(v4u*)(rp + bj * 128) = pack8(acc[ai][bj][m][0], acc[ai][bj][m][1]); }
        } else {
            const int l = u.pn - 18;
#pragma unroll
            for (int ai = 0; ai < 2; ++ai)
#pragma unroll
                for (int m = 0; m < 4; ++m) { bf16* rp = A2 + (size_t)(row0 + ai * 128 + m * 16) * 1280 + l * 256 + colt;
#pragma unroll
                    for (int bj = 0; bj < 2; ++bj) { f32x4 a = acc[ai][bj][m][0], b = acc[ai][bj][m][1];
                        if (l == 0) {
#pragma unroll
                            for (int e = 0; e < 4; ++e) { a[e] = sigm(a[e]); b[e] = sigm(b[e]); }
                        } else if (l <= 2) {
#pragma unroll
                            for (int e = 0; e < 4; ++e) { a[e] = tanh_fast(a[e]); b[e] = tanh_fast(b[e]); }
                        }
                        *(v4u*)(rp + bj * 128) = pack8(a, b); } }
        }
    }
};
struct EpiG2 {
    static constexpr bool PERM = true, AFTER_DRAIN = false;
    bf16* G; float* WD; bf16* AL; const float* w0; const float* a0;
    __device__ __forceinline__ void operator()(const f32x4 (&acc)[2][2][4][2], const pg8::Unit& u, int wr, int wc, int fr, int fq) const {
        const int row0 = u.pm * 256 + wr * 64 + fr, l = u.pn >> 1, cb = (u.pn & 1) * 256 + wc * 32 + 8 * fq;
#pragma unroll
        for (int bj = 0; bj < 2; ++bj) {
            const int c0 = cb + bj * 128;
            f32x4 o0 = (f32x4){0.f, 0.f, 0.f, 0.f}, o1 = o0;
            if (l >= 1 && l <= 2) { o0 = *(const f32x4*)(w0 + (l - 1) * 512 + c0); o1 = *(const f32x4*)(w0 + (l - 1) * 512 + c0 + 4); }
            if (l >= 3) { o0 = *(const f32x4*)(a0 + (l - 3) * 512 + c0); o1 = *(const f32x4*)(a0 + (l - 3) * 512 + c0 + 4); }
#pragma unroll
            for (int ai = 0; ai < 2; ++ai)
#pragma unroll
                for (int m = 0; m < 4; ++m) { const size_t ro = (size_t)(row0 + ai * 128 + m * 16) * 512 + c0;
                    f32x4 a = acc[ai][bj][m][0] + o0, b = acc[ai][bj][m][1] + o1;
                    if (l == 0) { *(v4u*)(G + ro) = pack8(a, b); }
                    else if (l <= 2) {
#pragma unroll
                        for (int e = 0; e < 4; ++e) { a[e] = -0.6065306597126334f * sigm(a[e]); b[e] = -0.6065306597126334f * sigm(b[e]); }
                        float* wp = WD + (size_t)(l - 1) * NTOK * 512 + ro; *(f32x4*)wp = a; *(f32x4*)(wp + 4) = b;
                    } else {
#pragma unroll
                        for (int e = 0; e < 4; ++e) { a[e] = sigm(a[e]); b[e] = sigm(b[e]); }
                        *(v4u*)(AL + (size_t)(l - 3) * NTOK * 512 + ro) = pack8(a, b);
                    } }
        }
    }
};
struct EpiG3 {
    static constexpr bool PERM = true, AFTER_DRAIN = false;
    const bf16* PB; bf16* GM;
    __device__ __forceinline__ void operator()(const f32x4 (&acc)[2][2][4][2], const pg8::Unit& u, int wr, int wc, int fr, int fq) const {
        const int row0 = u.pm * 256 + wr * 64 + fr, cb = u.pn * 256 + wc * 32 + 8 * fq;
#pragma unroll
        for (int ai = 0; ai < 2; ++ai)
#pragma unroll
            for (int m = 0; m < 4; ++m) { const int row = row0 + ai * 128 + m * 16;
#pragma unroll
                for (int bj = 0; bj < 2; ++bj) { const int c0 = cb + bj * 128;
                    const v4u gw = *(const v4u*)(PB + (size_t)row * 3072 + 1024 + c0); float g[8]; unpack8(gw, g);
                    f32x4 a = acc[ai][bj][m][0], b = acc[ai][bj][m][1];
#pragma unroll
                    for (int e = 0; e < 4; ++e) { a[e] *= sigm(g[e]); b[e] *= sigm(g[4 + e]); }
                    *(v4u*)(GM + (size_t)row * 2048 + c0) = pack8(a, b); } }
    }
};
struct EpiPart {
    static constexpr bool PERM = true, AFTER_DRAIN = false;
    bf16* PART;
    __device__ __forceinline__ void operator()(const f32x4 (&acc)[2][2][4][2], const pg8::Unit& u, int wr, int wc, int fr, int fq) const {
        const int row0 = u.pm * 256 + wr * 64 + fr, cb = (u.pn & 3) * 256 + wc * 32 + 8 * fq;
        bf16* base = PART + (size_t)(u.pn >> 2) * NTOK * 1024;
#pragma unroll
        for (int ai = 0; ai < 2; ++ai)
#pragma unroll
            for (int m = 0; m < 4; ++m) { bf16* rp = base + (size_t)(row0 + ai * 128 + m * 16) * 1024 + cb;
#pragma unroll
                for (int bj = 0; bj < 2; ++bj) *(v4u*)(rp + bj * 128) = pack8(acc[ai][bj][m][0], acc[ai][bj][m][1]); }
    }
};
struct EpiG5 {
    static constexpr bool PERM = true, AFTER_DRAIN = false;
    bf16* H;
    __device__ __forceinline__ void operator()(const f32x4 (&acc)[2][2][4][2], const pg8::Unit& u, int wr, int wc, int fr, int fq) const {
        const int row0 = u.pm * 256 + wr * 64 + fr, cb = u.pn * 256 + wc * 32 + 8 * fq;
#pragma unroll
        for (int ai = 0; ai < 2; ++ai)
#pragma unroll
            for (int m = 0; m < 4; ++m) { bf16* rp = H + (size_t)(row0 + ai * 128 + m * 16) * DFF + cb;
#pragma unroll
                for (int bj = 0; bj < 2; ++bj) { f32x4 a = acc[ai][bj][m][0], b = acc[ai][bj][m][1];
#pragma unroll
                    for (int e = 0; e < 4; ++e) { const float x = fmaxf(a[e], 0.f), y = fmaxf(b[e], 0.f); a[e] = x * x; b[e] = y * y; }
                    *(v4u*)(rp + bj * 128) = pack8(a, b); } }
    }
};

__device__ __forceinline__ void p0_transpose_item(const float* W, int N, bf16* WT, int ldt, int row_off, LAS float* scr, int item, int lane) {
    const int nblk = N / 32, kb = item / nblk, nb = item % nblk, k0 = 64 * kb, n0 = 32 * nb;
    float tv[32];
#pragma unroll
    for (int i = 0; i < 32; ++i) { const int kk = 2 * i + (lane >> 5); tv[i] = W[(size_t)(k0 + kk) * N + n0 + (lane & 31)]; }
#pragma unroll
    for (int i = 0; i < 32; ++i) { const int kk = 2 * i + (lane >> 5); scr[kk * 33 + (lane & 31)] = tv[i]; }
    LDS_WAIT(); asm volatile("" ::: "memory");
    const int c = lane & 7;
#pragma unroll
    for (int j = 0; j < 4; ++j) { const int n = (lane >> 3) + 8 * j; const LAS float* s = scr + (8 * c) * 33 + n;
        v4u o; o.x = pk2(s[0 * 33], s[1 * 33]); o.y = pk2(s[2 * 33], s[3 * 33]); o.z = pk2(s[4 * 33], s[5 * 33]); o.w = pk2(s[6 * 33], s[7 * 33]);
        *(GAS v4u*)(WT + (size_t)(row_off + n0 + n) * ldt + k0 + 8 * c) = o; }
    LDS_WAIT(); asm volatile("" ::: "memory");
}
__device__ __forceinline__ void p0_mod_item(KPtr p, LAS unsigned char* lds, int item, int tid) {
    const int wave = tid >> 6, lane = tid & 63, kk = lane >> 3, c4 = lane & 7;
    const float* ada_w = p->in[I_ADAW]; const float* cc = p->in[I_C]; const float* cx = p->in[I_CCTX];
    f32x4 a0 = (f32x4){0.f, 0.f, 0.f, 0.f}, a1 = a0, a2 = a0;
#pragma unroll
    for (int i = 0; i < 16; ++i) {
        const int k = wave * 128 + i * 8 + kk;
        const f32x4 w = *(const f32x4*)(ada_w + (size_t)k * 6144 + item * 32 + c4 * 4);
        const float c0 = cx[k], c1 = cc[k], c2 = cc[1024 + k];
        a0 += w * (c0 * sigm(c0)); a1 += w * (c1 * sigm(c1)); a2 += w * (c2 * sigm(c2));
    }
#pragma unroll
    for (int e = 0; e < 4; ++e) {
#pragma unroll
        for (int o = 8; o < 64; o <<= 1) { a0[e] += __shfl_xor(a0[e], o); a1[e] += __shfl_xor(a1[e], o); a2[e] += __shfl_xor(a2[e], o); }
    }
    LAS float* red = (LAS float*)lds;
    if (lane < 8) {
#pragma unroll
        for (int e = 0; e < 4; ++e) { red[(wave * 3 + 0) * 32 + c4 * 4 + e] = a0[e]; red[(wave * 3 + 1) * 32 + c4 * 4 + e] = a1[e]; red[(wave * 3 + 2) * 32 + c4 * 4 + e] = a2[e]; }
    }
    __syncthreads();
    if (tid < 96) { const int j = tid >> 5, c = tid & 31; float s = p->in[I_ADAB][item * 32 + c];
#pragma unroll
        for (int w = 0; w < 8; ++w) s += red[(w * 3 + j) * 32 + c];
        ((float*)(p->ws + WS_MOD))[j * 6144 + item * 32 + c] = s; }
    asm volatile("s_waitcnt vmcnt(0)" ::: "memory");
    __syncthreads();
    if (tid == 0) { __builtin_amdgcn_fence(__ATOMIC_RELEASE, "agent"); asm volatile("s_waitcnt vmcnt(0)" ::: "memory");
        __hip_atomic_fetch_add((unsigned*)(p->ws + WS_CTL) + CW_MODCNT, 1u, __ATOMIC_RELAXED, __HIP_MEMORY_SCOPE_AGENT); }
}
__device__ __forceinline__ void p0_prologue(KPtr p, LAS unsigned char* lds, int vcu, int G, int tid) {
    const int wave = __builtin_amdgcn_readfirstlane(tid >> 6), lane = tid & 63;
    for (int it = vcu; it < 192; it += G) p0_mod_item(p, lds, it, tid);
    LAS float* scr = (LAS float*)(lds + wave * 16384);
    const int gw = vcu * NWAVES + wave, NGW = G * NWAVES;
    bf16* Win = (bf16*)(p->ws + WS_WIN); bf16* B2 = (bf16*)(p->ws + WS_B2); bf16* Wout = (bf16*)(p->ws + WS_WOUT);
    bf16* Wo = (bf16*)(p->ws + WS_WO); bf16* W1 = (bf16*)(p->ws + WS_W1); bf16* W2 = (bf16*)(p->ws + WS_W2);
    constexpr int T_WIN = 16 * 144, T_GG1 = 16 * 4, T_L1 = 16 * 2, T_GG2 = 2 * 16, T_L2 = 16, T_WOUT = 8 * 32, T_WO = 16 * 32, T_W1 = 16 * 128, T_W2 = 64 * 32;
    constexpr int NITEMS = T_WIN + T_GG1 + 4 * T_L1 + T_GG2 + 4 * T_L2 + 2 * T_WOUT + T_WO;
    for (int it = gw; it < NITEMS; it += NGW) {
        int r = it;
        if (r < T_WIN) { p0_transpose_item(p->in[I_WIN], 4608, Win, 1024, 0, scr, r, lane); continue; } r -= T_WIN;
        if (r < T_WO) { p0_transpose_item(p->in[I_WO], DM, Wo, 1024, 0, scr, r, lane); continue; } r -= T_WO;
        if (r < T_WOUT) { p0_transpose_item(p->in[I_WOR], DM, Wout, 512, 0, scr, r, lane); continue; } r -= T_WOUT;
        if (r < T_WOUT) { p0_transpose_item(p->in[I_WOC], DM, Wout, 512, 1024, scr, r, lane); continue; } r -= T_WOUT;
        if (r < T_GG1) { p0_transpose_item(p->in[I_GG1], 128, Win, 1024, 4608, scr, r, lane); continue; } r -= T_GG1;
        if (r < 4 * T_L1) { const int q = r / T_L1; r -= q * T_L1;
            const float* src = (q < 2 ? p->in[I_DW1] : p->in[I_IA1]) + (size_t)(q & 1) * 1024 * 64;
            p0_transpose_item(src, 64, Win, 1024, 4608 + 256 * (q + 1), scr, r, lane); continue; } r -= 4 * T_L1;
        if (r < T_GG2) { p0_transpose_item(p->in[I_GG2], 512, B2, 256, 0, scr, r, lane); continue; } r -= T_GG2;
        { const int q = r / T_L2; r -= q * T_L2;
            const float* src = (q < 2 ? p->in[I_DW2] : p->in[I_IA2]) + (size_t)(q & 1) * 64 * 512;
            p0_transpose_item(src, 512, B2, 256, 512 * (q + 1), scr, r, lane); }
    }
    const v4u z = (v4u){0u, 0u, 0u, 0u};
    for (int it = gw; it < 5 * 256; it += NGW) { const int l = it >> 8, rr = it & 255; const int real = (l == 0) ? 128 : 64;
        if (rr >= real) { GAS v4u* dst = (GAS v4u*)(Win + (size_t)(4608 + l * 256 + rr) * 1024); dst[lane] = z; dst[64 + lane] = z; } }
    for (int it = gw; it < 2560; it += NGW) { const int real = (it < 512) ? 128 : 64;
        if (lane * 4 >= real) *(GAS v2u*)(B2 + (size_t)it * 256 + lane * 4) = (v2u){0u, 0u}; }
}

__device__ __forceinline__ void p1_norm1(KPtr p, int gw, int NGW, int lane) {
    const float* MOD = (const float*)(p->ws + WS_MOD); bf16* XN = (bf16*)(p->ws + WS_XN); const float* ng = p->in[I_N1G];
    for (int mi = gw; mi < NTOK; mi += NGW) { const int m = (NGW == 2048) ? ((mi & 255) + 1024 * ((mi >> 8) & 7) + 256 * (mi >> 11)) : mi;

        const float* xr = (m < NCTX) ? p->in[I_XP] + (size_t)m * DM : p->in[I_XS] + (size_t)(m - NCTX) * DM;
        const float* md = MOD + cond_of(m) * 6144;
        f32x4 v[4]; float s = 0.f;
#pragma unroll
        for (int j = 0; j < 4; ++j) { v[j] = ((const f32x4*)xr)[lane + 64 * j]; s += (v[j][0] * v[j][0] + v[j][1] * v[j][1]) + (v[j][2] * v[j][2] + v[j][3] * v[j][3]); }
        const float rstd = rsqrtf(wave_sum(s) * (1.f / DM) + 1e-6f);
        GAS v2u* o8 = (GAS v2u*)(XN + (size_t)m * DM) + lane;
#pragma unroll
        for (int j = 0; j < 4; ++j) { const int c = 4 * (lane + 64 * j);
            const f32x4 g = *(const f32x4*)(ng + c), sh = *(const f32x4*)(md + c), sc = *(const f32x4*)(md + 1024 + c);
            const f32x4 y = v[j] * rstd * g * (sc + 1.0f) + sh;
            o8[64 * j] = (v2u){pk2(y[0], y[1]), pk2(y[2], y[3])}; }
    }
}
__device__ __forceinline__ void p7_res_norm2(KPtr p, int gw, int NGW, int lane) {
    const float* MOD = (const float*)(p->ws + WS_MOD); bf16* XN = (bf16*)(p->ws + WS_XN); const float* ng = p->in[I_N2G];
    const bf16* P0 = (const bf16*)(p->ws + WS_PART); const bf16* P1 = P0 + (size_t)NTOK * DM;
    for (int mi = gw; mi < NTOK; mi += NGW) { const int m = (NGW == 2048) ? ((mi & 255) + 1024 * ((mi >> 8) & 7) + 256 * (mi >> 11)) : mi;

        const float* xr = (m < NCTX) ? p->in[I_XP] + (size_t)m * DM : p->in[I_XS] + (size_t)(m - NCTX) * DM;
        const float* md = MOD + cond_of(m) * 6144;
        f32x4 v[4]; float s = 0.f;
#pragma unroll
        for (int j = 0; j < 4; ++j) { const int c = 4 * (lane + 64 * j);
            const f32x4 x = *(const f32x4*)(xr + c), g1 = *(const f32x4*)(md + 2048 + c); const v2u aw = *(const v2u*)(P0 + (size_t)m * DM + c), bw = *(const v2u*)(P1 + (size_t)m * DM + c);
            const f32x4 a = (f32x4){bflo(aw.x), bfhi(aw.x), bflo(aw.y), bfhi(aw.y)}, b = (f32x4){bflo(bw.x), bfhi(bw.x), bflo(bw.y), bfhi(bw.y)};
            v[j] = x + g1 * (a + b);
            *(f32x4*)(p->out + (size_t)m * DM + c) = v[j];
            s += (v[j][0] * v[j][0] + v[j][1] * v[j][1]) + (v[j][2] * v[j][2] + v[j][3] * v[j][3]); }
        const float rstd = rsqrtf(wave_sum(s) * (1.f / DM) + 1e-6f);
        GAS v2u* o8 = (GAS v2u*)(XN + (size_t)m * DM) + lane;
#pragma unroll
        for (int j = 0; j < 4; ++j) { const int c = 4 * (lane + 64 * j);
            const f32x4 g = *(const f32x4*)(ng + c), sh = *(const f32x4*)(md + 3072 + c), sc = *(const f32x4*)(md + 4096 + c);
            const f32x4 y = v[j] * rstd * g * (sc + 1.0f) + sh;
            o8[64 * j] = (v2u){pk2(y[0], y[1]), pk2(y[2], y[3])}; }
    }
}
__device__ __forceinline__ void p12_final(KPtr p, int gw, int NGW, int lane) {
    const float* MOD = (const float*)(p->ws + WS_MOD); const float* fg = p->in[I_FG];
    const bf16* P0 = (const bf16*)(p->ws + WS_PART); const bf16* P1 = P0 + (size_t)NTOK * DM;
    for (int mi = gw; mi < NTOK; mi += NGW) { const int m = (NGW == 2048) ? ((mi & 255) + 1024 * ((mi >> 8) & 7) + 256 * (mi >> 11)) : mi;

        const float* md = MOD + cond_of(m) * 6144;
        f32x4 v[4]; float s = 0.f;
#pragma unroll
        for (int j = 0; j < 4; ++j) { const int c = 4 * (lane + 64 * j);
            const f32x4 x = *(const f32x4*)(p->out + (size_t)m * DM + c), g2 = *(const f32x4*)(md + 5120 + c); const v2u aw = *(const v2u*)(P0 + (size_t)m * DM + c), bw = *(const v2u*)(P1 + (size_t)m * DM + c);
            const f32x4 a = (f32x4){bflo(aw.x), bfhi(aw.x), bflo(aw.y), bfhi(aw.y)}, b = (f32x4){bflo(bw.x), bfhi(bw.x), bflo(bw.y), bfhi(bw.y)};
            v[j] = x + g2 * (a + b);
            s += (v[j][0] * v[j][0] + v[j][1] * v[j][1]) + (v[j][2] * v[j][2] + v[j][3] * v[j][3]); }
        const float rstd = rsqrtf(wave_sum(s) * (1.f / DM) + 1e-6f);
#pragma unroll
        for (int j = 0; j < 4; ++j) { const int c = 4 * (lane + 64 * j);
            *(f32x4*)(p->out + (size_t)m * DM + c) = v[j] * rstd * *(const f32x4*)(fg + c); }
    }
}
__device__ __forceinline__ void load8(const float* p, float (&o)[8]) { const f32x4 a = *(const f32x4*)p, b = *(const f32x4*)(p + 4); o[0] = a[0]; o[1] = a[1]; o[2] = a[2]; o[3] = a[3]; o[4] = b[0]; o[5] = b[1]; o[6] = b[2]; o[7] = b[3]; }
__device__ __forceinline__ void store8bf(bf16* p, const float (&v)[8]) { v4u w; w.x = pk2(v[0], v[1]); w.y = pk2(v[2], v[3]); w.z = pk2(v[4], v[5]); w.w = pk2(v[6], v[7]); *(GAS v4u*)p = w; }
typedef short bf16x8v __attribute__((ext_vector_type(8)));
typedef float f32x16 __attribute__((ext_vector_type(16)));
#define MFMA32(a, b, c) __builtin_amdgcn_mfma_f32_32x32x16_bf16(a, b, c, 0, 0, 0)
__device__ __forceinline__ bf16x8v ldfrag(const LAS unsigned char* base, int row_stride, int row, int col) { return *(const LAS bf16x8v*)(base + row * row_stride + col * 2); }
__device__ __forceinline__ int trow(int reg, int half) { return (reg & 3) + 8 * (reg >> 2) + 4 * half; }
__device__ __forceinline__ bf16x8v pack_acc(const f32x16& x, int s) {
    v4u w; w.x = pk2(x[8 * s], x[8 * s + 1]); w.y = pk2(x[8 * s + 2], x[8 * s + 3]); w.z = pk2(x[8 * s + 4], x[8 * s + 5]); w.w = pk2(x[8 * s + 6], x[8 * s + 7]);
    return __builtin_bit_cast(bf16x8v, w);
}
__device__ __forceinline__ int rec_off_s(int fbase, int rr, int cc) { const int s = cc >> 4, o = cc & 15, hh = (o >> 2) & 1, j = 4 * (o >> 3) + (o & 3); return (fbase + s) * 1024 + (32 * hh + rr) * 16 + j * 2; }
__device__ __forceinline__ int rec_off_n(int fbase, int rr, int ii) { const int s = ii >> 4, o = ii & 15, hh = o >> 3, j = o & 7; return (fbase + s) * 1024 + (32 * hh + rr) * 16 + j * 2; }
constexpr int P1_WAVE_LDS = 32768;
constexpr int P1_AT = 0, P1_BT = 4608, P1_RT = 9216, P1_KT = 13824, P1_BTT = 18432, P1_NBR = 23552, P1_WT = 26112, P1_GCL = 31232, P1_RN = 32256;
constexpr int P1_L = 0, P1_NKA = 26112, P1_ZT = 0, P1_RED0 = 23552, P1_RED1 = 23552;

__device__ __forceinline__ void p4_decode(int task, int& b, int& h, int& n, int& m0, int& T) {
    if (task < 1024) { b = task >> 6; h = (task >> 3) & 7; n = task & 7; m0 = b * 256; T = 256; }
    else { const int t2 = task - 1024; b = t2 >> 9; h = (t2 >> 6) & 7; n = t2 & 63; m0 = NCTX + b * 2048; T = 2048; }
}
constexpr int P1_SYNC = 32384;
__device__ __forceinline__ void pair_sync(LAS unsigned char* wl, int half, unsigned& phase, int lane) {
    volatile LAS unsigned* sy = (volatile LAS unsigned*)(wl + P1_SYNC);
    ++phase;
    asm volatile("s_waitcnt lgkmcnt(0)" ::: "memory");
    if (lane == 0) sy[half] = phase;
    while (sy[half ^ 1] < phase) __builtin_amdgcn_s_sleep(1);
    asm volatile("" ::: "memory");
}
template <int D>
__device__ __forceinline__ void p4_pass1(KPtr p, LAS unsigned char* wl, int task, const int half, unsigned& phase) {
    int lane; PG8_LANE(lane);
    int b, h, n, m0, T; p4_decode(task, b, h, n, m0, T);
    const bf16* RKV = (const bf16*)(p->ws + WS_RKV);
    const int c = h * 64 + lane, mb = m0 + 32 * n;
    const bool has_prev = n > 0, has_next = (32 * n + 32) < T;
    const int hn = D ? 1 - half : half;
    float kraw[18];
    {   const bf16* srck = RKV + (size_t)(mb + 16 * hn) * 1536 + 512 + c;
        kraw[0] = (hn > 0 || has_prev) ? bf1(srck[-1536]) : 0.f;
        int eo = 0;
#pragma unroll
        for (int i = 0; i < 16; ++i) { kraw[i + 1] = bf1(srck[eo]); eo += 1536; asm volatile("" : "+v"(eo)); }
        kraw[17] = (hn == 0 || has_next) ? bf1(srck[eo]) : 0.f; }
    __builtin_amdgcn_sched_barrier(0);
    float lw[32], al[32];
    {   const int fr0 = lane & 31, fh0 = lane >> 5;
        const bf16* A2p = (const bf16*)(p->ws + WS_A2) + (size_t)(mb + fr0) * 1280 + 8 * fh0;
        const bf16* B2p = (const bf16*)(p->ws + WS_B2) + (size_t)(h * 64 + fr0) * 256 + 8 * fh0;
        const float w0c = p->in[I_DW0][D * 512 + c], a0c = p->in[I_IA0][D * 512 + c];
#pragma unroll
        for (int which = 0; which < 2; ++which) {
            const int l = (which == 0) ? 1 + D : 3 + D;
            f32x16 c0, c1;
#pragma unroll
            for (int e = 0; e < 16; ++e) { c0[e] = 0.f; c1[e] = 0.f; }
#pragma unroll
            for (int s4 = 0; s4 < 4; ++s4) { const bf16x8v a = *(const bf16x8v*)(A2p + 256 * l + 16 * s4);
                const bf16x8v b0 = *(const bf16x8v*)(B2p + (size_t)(l * 512) * 256 + 16 * s4), b1 = *(const bf16x8v*)(B2p + (size_t)(l * 512 + 32) * 256 + 16 * s4);
                c0 = MFMA32(a, b0, c0); c1 = MFMA32(a, b1, c1); }
#pragma unroll
            for (int e = 0; e < 16; ++e) {
                const auto sw = __builtin_amdgcn_permlane32_swap(__float_as_uint(c0[e]), __float_as_uint(c1[e]), false, false);
                const float x0 = __uint_as_float(sw[0]), x1 = __uint_as_float(sw[1]);
                const int t0 = trow(e, 0), t1 = trow(e, 1);
                if (which == 0) { lw[t0] = -0.6065306597126334f * sigm(w0c + x0); lw[t1] = -0.6065306597126334f * sigm(w0c + x1); }
                else { al[t0] = sigm(a0c + x0); al[t1] = sigm(a0c + x1); }
            }
        }
        if (D == 0) {
            f32x16 c0;
#pragma unroll
            for (int e = 0; e < 16; ++e) c0[e] = 0.f;
            const bf16* B2g = B2p + (size_t)(32 * half) * 256;
#pragma unroll
            for (int s4 = 0; s4 < 8; ++s4) c0 = MFMA32(*(const bf16x8v*)(A2p + 16 * s4), *(const bf16x8v*)(B2g + 16 * s4), c0);
            bf16* Gp = (bf16*)((unsigned char*)p->out + DO_G) + (size_t)mb * 512 + h * 64 + 32 * half + fr0;
#pragma unroll
            for (int e = 0; e < 16; ++e) Gp[(size_t)trow(e, fh0) * 512] = (bf16)(pk2(c0[e], 0.f) & 0xffffu);
        }
    }
    __builtin_amdgcn_sched_barrier(0);
    {   const float mp = p->in[I_MUP][512 + c], mn = p->in[I_MUN][512 + c], kkw = p->in[I_KK][c];
        LAS float* red = (LAS float*)(wl + P1_RED0) + 16 * hn * 68;
#pragma unroll
        for (int i = 0; i < 16; ++i) { const float u = (kraw[i + 1] + (kraw[i] - kraw[i + 1]) * mp + (kraw[i + 2] - kraw[i + 1]) * mn) * kkw; red[i * 68 + lane] = u * u; }
        asm volatile("" ::: "memory");
        const int ri = lane & 15, qt = lane >> 4; float ssum = 0.f;
#pragma unroll
        for (int q = 0; q < 4; ++q) { const f32x4 x = *(const LAS f32x4*)(red + ri * 68 + qt * 16 + 4 * q); ssum += (x[0] + x[1]) + (x[2] + x[3]); }
        ssum += __int_as_float(__builtin_amdgcn_ds_bpermute((lane ^ 16) << 2, __float_as_int(ssum)));
        ssum += __int_as_float(__builtin_amdgcn_ds_bpermute((lane ^ 32) << 2, __float_as_int(ssum)));
        if (lane < 16) ((LAS float*)(wl + P1_RN))[16 * hn + lane] = rsqrtf(fmaxf(ssum, 1e-24f));
    }
    asm volatile("" ::: "memory");
    float gC;
    {   const float kaw = p->in[I_KA][c], rkw = p->in[I_RK][c], kkw = p->in[I_KK][c];
        const float mpr = p->in[I_MUP][c], mnr = p->in[I_MUN][c], mpk = p->in[I_MUP][512 + c], mnk = p->in[I_MUN][512 + c], mpv = p->in[I_MUP][1024 + c], mnv = p->in[I_MUN][1024 + c];
        LAS bf16* lAT = (LAS bf16*)(wl + P1_AT) + 16 * half * 72; LAS bf16* lBT = (LAS bf16*)(wl + P1_BT) + 16 * half * 72; LAS bf16* lRT = (LAS bf16*)(wl + P1_RT) + 16 * half * 72; LAS bf16* lKT = (LAS bf16*)(wl + P1_KT) + 16 * half * 72;
        LAS float* red1 = (LAS float*)(wl + P1_RED1) + 16 * hn * 68; const LAS float* rnl = (const LAS float*)(wl + P1_RN) + 16 * hn;
        const int j0 = D ? 31 - 16 * half : 16 * half;
        const bf16* src = RKV + (size_t)(mb + j0) * 1536 + c; const bf16* srcv = src + 1024;
        bf16* VN = (bf16*)((unsigned char*)p->out + DO_V) + (size_t)(mb + 16 * half) * 512 + c;
        bf16* VT = (bf16*)((unsigned char*)p->out + DO_VT) + (size_t)m0 * 512 + (size_t)h * 64 * T + (size_t)lane * T + 32 * n + 16 * half;
        const bool has_behind = (half > 0) || (D ? has_next : has_prev), has_ahead = (half == 0) || (D ? has_prev : has_next);
        constexpr int stp = D ? -1536 : 1536;
        float rb = has_behind ? bf1(src[-stp]) : 0.f, kb = has_behind ? bf1(src[-stp + 512]) : 0.f, vb = has_behind ? bf1(srcv[-stp]) : 0.f;
        float rc = bf1(src[0]), kc = bf1(src[512]), vc = bf1(srcv[0]);
        float s_lo = 0.f, s_hi = 0.f;
#pragma unroll
        for (int i = 0; i < 16; ++i) { s_lo += lw[i]; s_hi += lw[16 + i]; }
        float Lc = half ? (D ? s_hi : s_lo) : 0.f, gprev = __expf(Lc); float btp[8], vtp[8];
        int eo = 0, vo = 0;
        float nra[8], nka[8], nva[8];
#define P1_LOAD_GROUP(g_) do { _Pragma("unroll") for (int u_ = 0; u_ < 8; ++u_) { const int s_ = 8 * (g_) + u_; \
            eo += stp; asm volatile("" : "+v"(eo)); const bool ha_ = (s_ < 15) || has_ahead; \
            nra[u_] = ha_ ? bf1(src[eo]) : 0.f; nka[u_] = ha_ ? bf1(src[eo + 512]) : 0.f; nva[u_] = ha_ ? bf1(srcv[eo]) : 0.f; } } while (0)
        P1_LOAD_GROUP(0);
#pragma unroll
        for (int g8 = 0; g8 < 2; ++g8) {
            float cra[8], cka[8], cva[8];
#pragma unroll
            for (int u = 0; u < 8; ++u) { cra[u] = nra[u]; cka[u] = nka[u]; cva[u] = nva[u]; }
            if (g8 < 1) P1_LOAD_GROUP(g8 + 1);
#pragma unroll
            for (int u = 0; u < 8; ++u) {
                const int sl = 8 * g8 + u;
                const int jl = D ? 15 - sl : sl;
                const float lwj = hn ? lw[16 + jl] : lw[jl], alj = hn ? al[16 + jl] : al[jl], ra = cra[u], ka = cka[u], va = cva[u];
                const float rp_ = D ? ra : rb, rn_ = D ? rb : ra, kp_ = D ? ka : kb, kn_ = D ? kb : ka, vp_ = D ? va : vb, vn_ = D ? vb : va;
                const float rj = rc + (rp_ - rc) * mpr + (rn_ - rc) * mnr, kj = kc + (kp_ - kc) * mpk + (kn_ - kc) * mnk, vj = vc + (vp_ - vc) * mpv + (vn_ - vc) * mnv;
                const float kkj = kj * kkw * rnl[jl];
                Lc += lwj;
                const float g = __expf(Lc), gi = __expf(-Lc);
                const float kd = kj * (1.f + (alj - 1.f) * kaw), bb = kkj * alj;
                const float at = -kkj * gprev;
                const float rt = rj * g, bt = bb * gi, kt = kd * gi;
                lAT[sl * 72 + lane] = (bf16)(pk2(at, 0.f) & 0xffffu); lBT[sl * 72 + lane] = (bf16)(pk2(bt, 0.f) & 0xffffu);
                lRT[sl * 72 + lane] = (bf16)(pk2(rt, 0.f) & 0xffffu); lKT[sl * 72 + lane] = (bf16)(pk2(kt, 0.f) & 0xffffu);
                btp[u] = bt;
                red1[jl * 68 + lane] = rj * kd * rkw;
                if (D == 0) { VN[vo] = (bf16)(pk2(vj, 0.f) & 0xffffu); vo += 512; asm volatile("" : "+v"(vo)); vtp[u] = vj; }
                gprev = g; rb = rc; kb = kc; vb = vc; rc = ra; kc = ka; vc = va;
            }
            { v4u w; w.x = pk2(btp[0], btp[1]); w.y = pk2(btp[2], btp[3]); w.z = pk2(btp[4], btp[5]); w.w = pk2(btp[6], btp[7]); *(LAS v4u*)(wl + P1_BTT + lane * 80 + (2 * half + g8) * 16) = w; }
            if (D == 0) { v4u w; w.x = pk2(vtp[0], vtp[1]); w.y = pk2(vtp[2], vtp[3]); w.z = pk2(vtp[4], vtp[5]); w.w = pk2(vtp[6], vtp[7]); *(GAS v4u*)(VT + 8 * g8) = w; }
            __builtin_amdgcn_sched_barrier(0);
        }
#undef P1_LOAD_GROUP
        gC = gprev;
    }
    asm volatile("" ::: "memory");
    {   LAS float* red = (LAS float*)(wl + P1_RED1) + 16 * hn * 68;
        const int ri = lane & 15, qt = lane >> 4; float ssum = 0.f;
#pragma unroll
        for (int q = 0; q < 4; ++q) { const f32x4 x = *(const LAS f32x4*)(red + ri * 68 + qt * 16 + 4 * q); ssum += (x[0] + x[1]) + (x[2] + x[3]); }
        ssum += __int_as_float(__builtin_amdgcn_ds_bpermute((lane ^ 16) << 2, __float_as_int(ssum)));
        ssum += __int_as_float(__builtin_amdgcn_ds_bpermute((lane ^ 32) << 2, __float_as_int(ssum)));
        if (lane < 16) ((float*)((unsigned char*)p->out + DO_DOT))[(size_t)D * NTOK * 8 + (size_t)(mb + 16 * hn + lane) * 8 + h] = ssum;
    }
    pair_sync(wl, half, phase, lane);
    const int fr = lane & 31, fh = lane >> 5;
    f32x16 nkr; float rhs[32];
#pragma unroll
    for (int e = 0; e < 16; ++e) nkr[e] = 0.f;
    {   f32x16 g0, g1;
#pragma unroll
        for (int e = 0; e < 16; ++e) { g0[e] = 0.f; g1[e] = 0.f; }
        bf16x8v fx[4], fb[4], fk[4];
        const int xoff = half ? P1_RT : P1_AT;
#pragma unroll
        for (int s4 = 0; s4 < 4; ++s4) { fx[s4] = ldfrag(wl + xoff, 144, fr, 16 * s4 + 8 * fh); fb[s4] = ldfrag(wl + P1_BT, 144, fr, 16 * s4 + 8 * fh); fk[s4] = ldfrag(wl + P1_KT, 144, fr, 16 * s4 + 8 * fh); }
        if (half == 0) {
            const LAS bf16* lAT = (const LAS bf16*)(wl + P1_AT);
#pragma unroll
            for (int t = 0; t < 32; ++t) rhs[t] = bf1(lAT[t * 72 + lane]);
#pragma unroll
            for (int s4 = 0; s4 < 4; ++s4) { g0 = MFMA32(fx[s4], fb[s4], g0); g1 = MFMA32(fx[s4], fk[s4], g1); }
            asm volatile("" ::: "memory");
            LAS float* lL = (LAS float*)(wl + P1_L); LAS float* lN = (LAS float*)(wl + P1_NKA);
#pragma unroll
            for (int e = 0; e < 16; ++e) { const int t = trow(e, fh), i = fr; lL[t * 32 + i] = (i < t) ? g0[e] : 0.f; lN[t * 33 + i] = (i < t) ? g1[e] : 0.f; }
        } else {
#pragma unroll
            for (int t = 0; t < 32; ++t) rhs[t] = 0.f;
#pragma unroll
            for (int s4 = 0; s4 < 4; ++s4) { g0 = MFMA32(fx[s4], fb[s4], g0); nkr = MFMA32(fk[s4], fx[s4], nkr); }
            LAS bf16* lB = (LAS bf16*)(wl + P1_NBR);
#pragma unroll
            for (int e = 0; e < 16; ++e) { const int t = trow(e, fh), i = fr; lB[t * 40 + i] = (bf16)(pk2((i <= t) ? g0[e] : 0.f, 0.f) & 0xffffu); nkr[e] = (t <= i) ? nkr[e] : 0.f; }
        }
    }
    pair_sync(wl, half, phase, lane);
    float X[32];
    { int dep = 0; asm volatile("" : "+v"(dep));
#pragma unroll
        for (int t = 0; t < 32; ++t) {
            if (t >= 2) asm volatile("" : "+v"(dep) : "v"(X[t - 2]));
            const LAS float* lL = (const LAS float*)(wl + P1_L) + dep; const LAS float* lN = (const LAS float*)(wl + P1_NKA) + dep;
            float a1 = half ? lN[t * 33 + fr] : rhs[t], a2 = 0.f;
#pragma unroll
            for (int i4 = 0; i4 * 4 < t; ++i4) { const f32x4 l4 = *(const LAS f32x4*)(lL + t * 32 + 4 * i4);
#pragma unroll
                for (int e = 0; e < 4; ++e) { const int i = 4 * i4 + e; if (i < t) { if (e & 1) a2 += l4[e] * X[i]; else a1 += l4[e] * X[i]; } } }
            X[t] = a1 + a2;
        } }
    pair_sync(wl, half, phase, lane);
    if (half == 0) {
#pragma unroll
        for (int q = 0; q < 4; ++q) { v4u w; w.x = pk2(X[8 * q], X[8 * q + 1]); w.y = pk2(X[8 * q + 2], X[8 * q + 3]); w.z = pk2(X[8 * q + 4], X[8 * q + 5]); w.w = pk2(X[8 * q + 6], X[8 * q + 7]); *(LAS v4u*)(wl + P1_WT + lane * 80 + 16 * q) = w; }
    } else {
        if (lane < 32) {
#pragma unroll
            for (int q = 0; q < 4; ++q) { v4u w; w.x = pk2(X[8 * q], X[8 * q + 1]); w.y = pk2(X[8 * q + 2], X[8 * q + 3]); w.z = pk2(X[8 * q + 4], X[8 * q + 5]); w.w = pk2(X[8 * q + 6], X[8 * q + 7]); *(LAS v4u*)(wl + P1_ZT + lane * 80 + 16 * q) = w; } }
        ((LAS float*)(wl + P1_GCL))[lane] = gC;
    }
    pair_sync(wl, half, phase, lane);
    const int wt = task * 2 + D;
    unsigned char* rec = p->ws + (wt < 2048 ? WS_RECA + (size_t)wt * REC_BYTES : WS_RECB + (size_t)(wt - 2048) * REC_BYTES);
    unsigned char* recl = rec + lane * 16;
    const LAS float* lG = (const LAS float*)(wl + P1_GCL);
    if (half == 0) {
        ((float*)(p->ws + WS_GC))[(size_t)wt * 64 + lane] = lG[lane];
#pragma unroll
        for (int a2 = 0; a2 < 2; ++a2) {
            bf16x8v fbt[2];
#pragma unroll
            for (int s2 = 0; s2 < 2; ++s2) fbt[s2] = ldfrag(wl + P1_BTT, 80, 32 * a2 + fr, 16 * s2 + 8 * fh);
            const float gcl = lG[32 * a2 + fr];
#pragma unroll
            for (int kt = 0; kt < 2; ++kt) { __builtin_amdgcn_sched_barrier(0); f32x16 acc;
#pragma unroll
                for (int e = 0; e < 16; ++e) acc[e] = 0.f;
#pragma unroll
                for (int s2 = 0; s2 < 2; ++s2) acc = MFMA32(ldfrag(wl + P1_WT, 80, 32 * kt + fr, 16 * s2 + 8 * fh), fbt[s2], acc);
#pragma unroll
                for (int e = 0; e < 16; ++e) acc[e] *= gcl;
                *(GAS bf16x8v*)(recl + (a2 * 4 + 2 * kt) * 1024) = pack_acc(acc, 0); *(GAS bf16x8v*)(recl + (a2 * 4 + 2 * kt + 1) * 1024) = pack_acc(acc, 1); }
        }
    } else {
        bf16x8v fnb[2], fzt[2];
#pragma unroll
        for (int s2 = 0; s2 < 2; ++s2) { fnb[s2] = ldfrag(wl + P1_NBR, 80, fr, 16 * s2 + 8 * fh); fzt[s2] = ldfrag(wl + P1_ZT, 80, fr, 16 * s2 + 8 * fh); }
        __builtin_amdgcn_sched_barrier(0);
        { f32x16 acc = nkr;
#pragma unroll
            for (int s2 = 0; s2 < 2; ++s2) acc = MFMA32(fzt[s2], fnb[s2], acc);
            *(GAS bf16x8v*)(recl + 16 * 1024) = pack_acc(acc, 0); *(GAS bf16x8v*)(recl + 17 * 1024) = pack_acc(acc, 1); }
#pragma unroll
        for (int a2 = 0; a2 < 2; ++a2) { __builtin_amdgcn_sched_barrier(0); f32x16 acc; const LAS bf16* lKT = (const LAS bf16*)(wl + P1_KT);
            const float gcl = lG[32 * a2 + fr];
#pragma unroll
            for (int e = 0; e < 16; ++e) acc[e] = bf1(lKT[trow(e, fh) * 72 + 32 * a2 + fr]);
#pragma unroll
            for (int s2 = 0; s2 < 2; ++s2) acc = MFMA32(fzt[s2], ldfrag(wl + P1_BTT, 80, 32 * a2 + fr, 16 * s2 + 8 * fh), acc);
#pragma unroll
            for (int e = 0; e < 16; ++e) acc[e] *= gcl;
            *(GAS bf16x8v*)(recl + (8 + 2 * a2) * 1024) = pack_acc(acc, 0); *(GAS bf16x8v*)(recl + (9 + 2 * a2) * 1024) = pack_acc(acc, 1); }
#pragma unroll
        for (int kt = 0; kt < 2; ++kt) { __builtin_amdgcn_sched_barrier(0); f32x16 acc; const LAS bf16* lRT = (const LAS bf16*)(wl + P1_RT);
#pragma unroll
            for (int e = 0; e < 16; ++e) acc[e] = bf1(lRT[fr * 72 + 32 * kt + trow(e, fh)]);
#pragma unroll
            for (int s2 = 0; s2 < 2; ++s2) acc = MFMA32(ldfrag(wl + P1_WT, 80, 32 * kt + fr, 16 * s2 + 8 * fh), fnb[s2], acc);
            *(GAS bf16x8v*)(recl + (12 + 2 * kt) * 1024) = pack_acc(acc, 0); *(GAS bf16x8v*)(recl + (13 + 2 * kt) * 1024) = pack_acc(acc, 1); }
    }
    pair_sync(wl, half, phase, lane);
}
__device__ __forceinline__ void p4_conv_item(KPtr p, LAS unsigned char* lds, int item, int tid) {
    const int wave = __builtin_amdgcn_readfirstlane(tid >> 6), lane = tid & 63;
    const bf16* PB = (const bf16*)(p->ws + WS_PB); bf16* RC = (bf16*)(p->ws + WS_RC);
    const int t0 = item * 32;
    int lo, hi; if (t0 < NCTX) { lo = t0 & ~255; hi = lo + 256; } else { lo = t0 & ~63; hi = lo + 64; }
    LAS bf16* U = (LAS bf16*)lds;
    LAS float* CWL = (LAS float*)(lds + 62 * 1024);
    for (int e = tid; e < 62 * 64; e += 512) {
        const int r = e >> 6, ch = (e & 63) * 8, tok = t0 - 15 + r;
        v4u w = (v4u){0u, 0u, 0u, 0u};
        if (tok >= lo && tok < hi) { float a[8], g[8]; unpack8(*(const v4u*)(PB + (size_t)tok * 3072 + ch), a); unpack8(*(const v4u*)(PB + (size_t)tok * 3072 + 512 + ch), g);
#pragma unroll
            for (int i = 0; i < 8; ++i) a[i] *= sigm(g[i]);
            w.x = pk2(a[0], a[1]); w.y = pk2(a[2], a[3]); w.z = pk2(a[4], a[5]); w.w = pk2(a[6], a[7]); }
        *(LAS v4u*)(U + r * 512 + ch) = w;
    }
    for (int e = tid; e < 31 * 128; e += 512) ((LAS f32x4*)CWL)[e] = ((const f32x4*)p->in[I_CW])[e];
    __syncthreads();
    const int c = 8 * lane;
    float cb[8], lg[8], lb[8]; load8(p->in[I_CB] + c, cb); load8(p->in[I_CLG] + c, lg); load8(p->in[I_CLB] + c, lb);
    {
        float acc[4][8];
#pragma unroll
        for (int tt = 0; tt < 4; ++tt)
#pragma unroll
            for (int e = 0; e < 8; ++e) acc[tt][e] = cb[e];
#pragma unroll 2
        for (int j = 0; j < 31; ++j) {
            const f32x4 w0 = *(const LAS f32x4*)(CWL + j * 512 + c), w1 = *(const LAS f32x4*)(CWL + j * 512 + c + 4);
#pragma unroll
            for (int tt = 0; tt < 4; ++tt) { float uv[8]; unpack8(*(const LAS v4u*)(U + (wave * 4 + tt + j) * 512 + c), uv);
#pragma unroll
                for (int e = 0; e < 4; ++e) { acc[tt][e] += uv[e] * w0[e]; acc[tt][4 + e] += uv[4 + e] * w1[e]; } }
        }
#pragma unroll
        for (int tt = 0; tt < 4; ++tt) {
            float s = 0.f;
#pragma unroll
            for (int e = 0; e < 8; ++e) s += acc[tt][e];
            const float mean = wave_sum(s) * (1.f / 512.f); float q = 0.f;
#pragma unroll
            for (int e = 0; e < 8; ++e) { acc[tt][e] -= mean; q += acc[tt][e] * acc[tt][e]; }
            const float rstd = rsqrtf(wave_sum(q) * (1.f / 512.f) + 1e-5f);
            float o[8];
#pragma unroll
            for (int e = 0; e < 8; ++e) { const float un = acc[tt][e] * rstd * lg[e] + lb[e]; o[e] = un * sigm(un); }
            store8bf(RC + (size_t)(t0 + wave * 4 + tt) * 1024 + 512 + c, o);
        }
    }
    __syncthreads();
}
__device__ __forceinline__ void p6_post(KPtr p, int gw, int NGW, int lane) {
    const float* YF = (const float*)(p->ws + WS_YF); const float* YB = (const float*)(p->ws + WS_YB);
    const bf16* VN = (const bf16*)((const unsigned char*)p->out + DO_V); const float* DOT = (const float*)((const unsigned char*)p->out + DO_DOT); const bf16* G = (const bf16*)((const unsigned char*)p->out + DO_G); bf16* RC = (bf16*)(p->ws + WS_RC);
    const int c = 8 * lane;
    float lg[8], lb[8]; load8(p->in[I_LNXG] + c, lg); load8(p->in[I_LNXB] + c, lb);
    for (int mi = gw; mi < NTOK; mi += NGW) { const int m = (NGW == 2048) ? ((mi & 255) + 1024 * ((mi >> 8) & 7) + 256 * (mi >> 11)) : mi;

        float a[8], b[8]; load8(YF + (size_t)m * 512 + c, a); load8(YB + (size_t)m * 512 + c, b);
        float s = 0.f;
#pragma unroll
        for (int e = 0; e < 8; ++e) { a[e] += b[e]; s += a[e]; }
        const float mu = oct_sum(s) * (1.f / 64.f); float q = 0.f;
#pragma unroll
        for (int e = 0; e < 8; ++e) { a[e] -= mu; q += a[e] * a[e]; }
        const float rstd = rsqrtf(oct_sum(q) * (1.f / 64.f) + 64e-5f);
        float vv[8], g[8]; unpack8(*(const v4u*)(VN + (size_t)m * 512 + c), vv); unpack8(*(const v4u*)(G + (size_t)m * 512 + c), g);
        const float dt = DOT[(size_t)m * 8 + (lane >> 3)] + DOT[(size_t)NTOK * 8 + (size_t)m * 8 + (lane >> 3)];
#pragma unroll
        for (int e = 0; e < 8; ++e) a[e] = (a[e] * rstd * lg[e] + lb[e] + dt * vv[e]) * g[e];
        store8bf(RC + (size_t)m * 1024 + c, a);
    }
}
__device__ __forceinline__ bf16x8v p2_vfrag(const bf16* vt, int s2, int hf, int d) {
    v4u w;
    if (d == 0) { const v2u lo = *(const v2u*)(vt + 16 * s2 + 4 * hf), hi = *(const v2u*)(vt + 16 * s2 + 8 + 4 * hf); w.x = lo.x; w.y = lo.y; w.z = hi.x; w.w = hi.y; }
    else { const v2u lo = *(const v2u*)(vt + 28 - 16 * s2 - 4 * hf), hi = *(const v2u*)(vt + 20 - 16 * s2 - 4 * hf);
        w.x = __builtin_amdgcn_alignbit(lo.y, lo.y, 16); w.y = __builtin_amdgcn_alignbit(lo.x, lo.x, 16); w.z = __builtin_amdgcn_alignbit(hi.y, hi.y, 16); w.w = __builtin_amdgcn_alignbit(hi.x, hi.x, 16); }
    return __builtin_bit_cast(bf16x8v, w);
}
__device__ __forceinline__ void p5_pass2_wave(KPtr p, int X) {
    int lane; PG8_LANE(lane);
    const int r = lane & 31, hf = lane >> 5;
    const int chain = X >> 1, wq = X & 1;
    int b, h, d, m0, T, tbase; const float* s0 = nullptr; float* sfin = nullptr;
    if (chain < 32) { b = chain >> 4; h = (chain >> 1) & 7; d = chain & 1; m0 = NCTX + b * 2048; T = 2048; tbase = 1024 + (b * 8 + h) * 64; s0 = (d == 0 ? p->in[I_SF] : p->in[I_SB]) + (size_t)(b * 8 + h) * 4096; }
    else { const int cc = chain - 32; b = cc >> 4; h = (cc >> 1) & 7; d = cc & 1; m0 = b * 256; T = 256; tbase = (b * 8 + h) * 8; sfin = p->out + (size_t)NTOK * DM + (size_t)d * 524288 + (size_t)(b * 8 + h) * 4096; }
    const int nc = T / 32, vcol = 32 * wq + r;
    const bf16* VT = (const bf16*)((const unsigned char*)p->out + DO_VT) + (size_t)m0 * 512 + (size_t)h * 64 * T + (size_t)vcol * T;
    float* Y = (float*)(p->ws + (d == 0 ? WS_YF : WS_YB)) + (size_t)m0 * 512 + h * 64 + vcol;
    const float* GC = (const float*)(p->ws + WS_GC);
    f32x16 S0t, S1t;
    if (s0) {
#pragma unroll
        for (int g = 0; g < 4; ++g) { const f32x4 x0 = *(const f32x4*)(s0 + (size_t)vcol * 64 + 8 * g + 4 * hf), x1 = *(const f32x4*)(s0 + (size_t)vcol * 64 + 32 + 8 * g + 4 * hf);
#pragma unroll
            for (int e = 0; e < 4; ++e) { S0t[4 * g + e] = x0[e]; S1t[4 * g + e] = x1[e]; } }
    } else {
#pragma unroll
        for (int e = 0; e < 16; ++e) { S0t[e] = 0.f; S1t[e] = 0.f; }
    }
    bf16x8v fGP[2][4], fKP[2][2], fRP[4], fPP[2], fV[2]; f32x4 gam[2][4];
#define P2_REC(n_) (p->ws + ((((tbase + (n_)) * 2 + d) < 2048) ? WS_RECA + (size_t)((tbase + (n_)) * 2 + d) * REC_BYTES : WS_RECB + (size_t)((tbase + (n_)) * 2 + d - 2048) * REC_BYTES) + lane * 16)
#define P2_LOAD_Y(n_) do { const unsigned char* rb_ = P2_REC(n_); _Pragma("unroll") for (int s4 = 0; s4 < 4; ++s4) fRP[s4] = *(const bf16x8v*)(rb_ + (12 + s4) * 1024); \
        _Pragma("unroll") for (int s2 = 0; s2 < 2; ++s2) fPP[s2] = *(const bf16x8v*)(rb_ + (16 + s2) * 1024); } while (0)
#define P2_LOAD_S(n_) do { const unsigned char* rb_ = P2_REC(n_); const float* gc_ = GC + (size_t)((tbase + (n_)) * 2 + d) * 64 + 4 * hf; \
        _Pragma("unroll") for (int a = 0; a < 2; ++a) { _Pragma("unroll") for (int s4 = 0; s4 < 4; ++s4) fGP[a][s4] = *(const bf16x8v*)(rb_ + (a * 4 + s4) * 1024); \
            _Pragma("unroll") for (int s2 = 0; s2 < 2; ++s2) fKP[a][s2] = *(const bf16x8v*)(rb_ + (8 + a * 2 + s2) * 1024); \
            _Pragma("unroll") for (int g = 0; g < 4; ++g) gam[a][g] = *(const f32x4*)(gc_ + 32 * a + 8 * g); } \
        _Pragma("unroll") for (int s2 = 0; s2 < 2; ++s2) fV[s2] = p2_vfrag(VT + 32 * (n_), s2, hf, d); } while (0)
    { const int n0 = d ? nc - 1 : 0; P2_LOAD_Y(n0); P2_LOAD_S(n0); }
    for (int ci = 0; ci < nc; ++ci) {
        const int n = d ? nc - 1 - ci : ci, nn = d ? n - 1 : n + 1; const bool more = ci + 1 < nc;
        bf16x8v sb[4]; sb[0] = pack_acc(S0t, 0); sb[1] = pack_acc(S0t, 1); sb[2] = pack_acc(S1t, 0); sb[3] = pack_acc(S1t, 1);
        f32x16 y;
#pragma unroll
        for (int e = 0; e < 16; ++e) y[e] = 0.f;
#pragma unroll
        for (int s4 = 0; s4 < 4; ++s4) y = MFMA32(fRP[s4], sb[s4], y);
#pragma unroll
        for (int s2 = 0; s2 < 2; ++s2) y = MFMA32(fPP[s2], fV[s2], y);
        if (more) P2_LOAD_Y(nn);
        { float* yo = Y + (size_t)(32 * n) * 512;
#pragma unroll
            for (int e = 0; e < 16; ++e) yo[(size_t)(d ? 31 - trow(e, hf) : trow(e, hf)) * 512] = y[e]; }
        f32x16 n0t, n1t;
#pragma unroll
        for (int g = 0; g < 4; ++g)
#pragma unroll
            for (int e = 0; e < 4; ++e) { n0t[4 * g + e] = S0t[4 * g + e] * gam[0][g][e]; n1t[4 * g + e] = S1t[4 * g + e] * gam[1][g][e]; }
#pragma unroll
        for (int s4 = 0; s4 < 4; ++s4) { n0t = MFMA32(fGP[0][s4], sb[s4], n0t); n1t = MFMA32(fGP[1][s4], sb[s4], n1t); }
#pragma unroll
        for (int s2 = 0; s2 < 2; ++s2) { n0t = MFMA32(fKP[0][s2], fV[s2], n0t); n1t = MFMA32(fKP[1][s2], fV[s2], n1t); }
        S0t = n0t; S1t = n1t;
        if (more) P2_LOAD_S(nn);
    }
    if (sfin) {
#pragma unroll
        for (int g = 0; g < 4; ++g) { *(f32x4*)(sfin + (size_t)vcol * 64 + 8 * g + 4 * hf) = (f32x4){S0t[4 * g], S0t[4 * g + 1], S0t[4 * g + 2], S0t[4 * g + 3]};
            *(f32x4*)(sfin + (size_t)vcol * 64 + 32 + 8 * g + 4 * hf) = (f32x4){S1t[4 * g], S1t[4 * g + 1], S1t[4 * g + 2], S1t[4 * g + 3]}; }
    }
#undef P2_REC
#undef P2_LOAD_Y
#undef P2_LOAD_S
}

constexpr int P2R_NS = 5, P2R_SLOT = 25600, P2R_GAM = 18432, P2R_V = 19456, P2R_SB = 21504, P2R_FLAGS = P2R_NS * P2R_SLOT, P2R_NH = 6;
__device__ __forceinline__ void p2_chain_decode(int chain, KPtr p, int& b, int& h, int& d, int& m0, int& T, int& tbase) {
    if (chain < 32) { b = chain >> 4; h = (chain >> 1) & 7; d = chain & 1; m0 = NCTX + b * 2048; T = 2048; tbase = 1024 + (b * 8 + h) * 64; }
    else { const int cc = chain - 32; b = cc >> 4; h = (cc >> 1) & 7; d = cc & 1; m0 = b * 256; T = 256; tbase = (b * 8 + h) * 8; }
}
__device__ __forceinline__ void p5_ring_helper(KPtr p, LAS unsigned char* lds, int X, int hidx) {
    int lane; PG8_LANE(lane);
    const int r = lane & 31, hf = lane >> 5, chain = X >> 1, wq = X & 1;
    int b, h, d, m0, T, tbase; p2_chain_decode(chain, p, b, h, d, m0, T, tbase);
    const int nc = T / 32, vcol = 32 * wq + r;
    const bf16* VT = (const bf16*)((const unsigned char*)p->out + DO_VT) + (size_t)m0 * 512 + (size_t)h * 64 * T + (size_t)vcol * T;
    const float* GC = (const float*)(p->ws + WS_GC);
    volatile LAS unsigned* flags = (volatile LAS unsigned*)(lds + P2R_FLAGS);
    for (int m = hidx; m < nc; m += P2R_NH) {
        const int n = d ? nc - 1 - m : m, wt = (tbase + n) * 2 + d, slot = m % P2R_NS;
        const unsigned char* rb = p->ws + (wt < 2048 ? WS_RECA + (size_t)wt * REC_BYTES : WS_RECB + (size_t)(wt - 2048) * REC_BYTES) + lane * 16;
        bf16x8v f[18];
#pragma unroll
        for (int i = 0; i < 18; ++i) f[i] = *(const bf16x8v*)(rb + i * 1024);
        const float gv = GC[(size_t)wt * 64 + lane];
        const bf16x8v v0 = p2_vfrag(VT + 32 * n, 0, hf, d), v1 = p2_vfrag(VT + 32 * n, 1, hf, d);
        while ((int)flags[5] < m - P2R_NS + 1 || (int)flags[13] < m - P2R_NS + 1) __builtin_amdgcn_s_sleep(2);
        LAS unsigned char* sl = lds + slot * P2R_SLOT;
#pragma unroll
        for (int i = 0; i < 18; ++i) *(LAS bf16x8v*)(sl + i * 1024 + lane * 16) = f[i];
        ((LAS float*)(sl + P2R_GAM))[lane] = gv;
        *(LAS bf16x8v*)(sl + P2R_V + lane * 16) = v0; *(LAS bf16x8v*)(sl + P2R_V + 1024 + lane * 16) = v1;
        asm volatile("s_waitcnt lgkmcnt(0)" ::: "memory");
        if (lane == 0) flags[slot] = (unsigned)(m + 1);
    }
}
__device__ __forceinline__ void p5_ring_ywave(KPtr p, LAS unsigned char* lds, int X) {
    int lane; PG8_LANE(lane);
    const int r = lane & 31, hf = lane >> 5, chain = X >> 1, wq = X & 1;
    int b, h, d, m0, T, tbase; p2_chain_decode(chain, p, b, h, d, m0, T, tbase);
    const int nc = T / 32, vcol = 32 * wq + r;
    float* Y = (float*)(p->ws + (d == 0 ? WS_YF : WS_YB)) + (size_t)m0 * 512 + h * 64 + vcol;
    volatile LAS unsigned* flags = (volatile LAS unsigned*)(lds + P2R_FLAGS);
    for (int m = 0; m < nc; ++m) {
        const int n = d ? nc - 1 - m : m, slot = m % P2R_NS;
        while (flags[8 + slot] != (unsigned)(m + 1)) __builtin_amdgcn_s_sleep(1);
        asm volatile("" ::: "memory");
        const LAS unsigned char* sl = lds + slot * P2R_SLOT + lane * 16;
        f32x16 y;
#pragma unroll
        for (int e = 0; e < 16; ++e) y[e] = 0.f;
#pragma unroll
        for (int s4 = 0; s4 < 4; ++s4) y = MFMA32(*(const LAS bf16x8v*)(sl + (12 + s4) * 1024), *(const LAS bf16x8v*)(sl + P2R_SB + s4 * 1024), y);
        y = MFMA32(*(const LAS bf16x8v*)(sl + 16 * 1024), *(const LAS bf16x8v*)(sl + P2R_V), y); y = MFMA32(*(const LAS bf16x8v*)(sl + 17 * 1024), *(const LAS bf16x8v*)(sl + P2R_V + 1024), y);
        asm volatile("s_waitcnt lgkmcnt(0)" ::: "memory");
        if (lane == 0) flags[13] = (unsigned)(m + 1);
        { float* yo = Y + (size_t)(32 * n) * 512;
#pragma unroll
            for (int e = 0; e < 16; ++e) yo[(size_t)(d ? 31 - trow(e, hf) : trow(e, hf)) * 512] = y[e]; }
    }
}
__device__ __forceinline__ void p5_ring_consumer(KPtr p, LAS unsigned char* lds, int X) {
    int lane; PG8_LANE(lane);
    const int r = lane & 31, hf = lane >> 5, chain = X >> 1, wq = X & 1;
    int b, h, d, m0, T, tbase; p2_chain_decode(chain, p, b, h, d, m0, T, tbase);
    const float* s0 = (chain < 32) ? (d == 0 ? p->in[I_SF] : p->in[I_SB]) + (size_t)(b * 8 + h) * 4096 : nullptr;
    float* sfin = (chain < 32) ? nullptr : p->out + (size_t)NTOK * DM + (size_t)d * 524288 + (size_t)(b * 8 + h) * 4096;
    const int nc = T / 32, vcol = 32 * wq + r;
    volatile LAS unsigned* flags = (volatile LAS unsigned*)(lds + P2R_FLAGS);
    f32x16 S0t, S1t;
    if (s0) {
#pragma unroll
        for (int g = 0; g < 4; ++g) { const f32x4 x0 = *(const f32x4*)(s0 + (size_t)vcol * 64 + 8 * g + 4 * hf), x1 = *(const f32x4*)(s0 + (size_t)vcol * 64 + 32 + 8 * g + 4 * hf);
#pragma unroll
            for (int e = 0; e < 4; ++e) { S0t[4 * g + e] = x0[e]; S1t[4 * g + e] = x1[e]; } }
    } else {
#pragma unroll
        for (int e = 0; e < 16; ++e) { S0t[e] = 0.f; S1t[e] = 0.f; }
    }
    bf16x8v gpA[8], kpA[4], v0A, v1A, gpB[8], kpB[4], v0B, v1B;
#define C_WAIT(m_) do { while (flags[(m_) % P2R_NS] != (unsigned)((m_) + 1)) __builtin_amdgcn_s_sleep(1); asm volatile("" ::: "memory"); } while (0)
#define C_LOAD(m_, GP_, KP_, V0_, V1_) do { const LAS unsigned char* sl_ = lds + ((m_) % P2R_NS) * P2R_SLOT + lane * 16; \
        _Pragma("unroll") for (int i_ = 0; i_ < 8; ++i_) GP_[i_] = *(const LAS bf16x8v*)(sl_ + i_ * 1024); \
        _Pragma("unroll") for (int i_ = 0; i_ < 4; ++i_) KP_[i_] = *(const LAS bf16x8v*)(sl_ + (8 + i_) * 1024); \
        V0_ = *(const LAS bf16x8v*)(sl_ + P2R_V); V1_ = *(const LAS bf16x8v*)(sl_ + P2R_V + 1024); } while (0)
#define C_STEP(m_, GP_, KP_, V0_, V1_, NGP_, NKP_, NV0_, NV1_) do { const int slot_ = (m_) % P2R_NS; \
        bf16x8v sb_[4]; sb_[0] = pack_acc(S0t, 0); sb_[1] = pack_acc(S0t, 1); sb_[2] = pack_acc(S1t, 0); sb_[3] = pack_acc(S1t, 1); \
        { LAS unsigned char* slw_ = lds + slot_ * P2R_SLOT + P2R_SB + lane * 16; _Pragma("unroll") for (int s4 = 0; s4 < 4; ++s4) *(LAS bf16x8v*)(slw_ + s4 * 1024) = sb_[s4]; } \
        asm volatile("" ::: "memory"); if (lane == 0) flags[8 + slot_] = (unsigned)((m_) + 1); \
        f32x16 n0_, n1_; { const LAS float* gl_ = (const LAS float*)(lds + slot_ * P2R_SLOT + P2R_GAM) + 4 * hf; \
            _Pragma("unroll") for (int g = 0; g < 4; ++g) { const f32x4 g0 = *(const LAS f32x4*)(gl_ + 8 * g), g1 = *(const LAS f32x4*)(gl_ + 32 + 8 * g); \
                _Pragma("unroll") for (int e = 0; e < 4; ++e) { n0_[4 * g + e] = S0t[4 * g + e] * g0[e]; n1_[4 * g + e] = S1t[4 * g + e] * g1[e]; } } } \
        asm volatile("s_waitcnt lgkmcnt(0)" ::: "memory"); if (lane == 0) flags[5] = (unsigned)((m_) + 1);     \
        _Pragma("unroll") for (int s4 = 0; s4 < 4; ++s4) { n0_ = MFMA32(GP_[s4], sb_[s4], n0_); n1_ = MFMA32(GP_[4 + s4], sb_[s4], n1_); } \
        if ((m_) + 1 < nc) { C_WAIT((m_) + 1); C_LOAD((m_) + 1, NGP_, NKP_, NV0_, NV1_); }     \
        n0_ = MFMA32(KP_[0], V0_, n0_); n0_ = MFMA32(KP_[1], V1_, n0_); n1_ = MFMA32(KP_[2], V0_, n1_); n1_ = MFMA32(KP_[3], V1_, n1_); \
        S0t = n0_; S1t = n1_; } while (0)
    C_WAIT(0); C_LOAD(0, gpA, kpA, v0A, v1A);
    for (int m = 0; m < nc; m += 2) {
        C_STEP(m, gpA, kpA, v0A, v1A, gpB, kpB, v0B, v1B);
        C_STEP(m + 1, gpB, kpB, v0B, v1B, gpA, kpA, v0A, v1A);
    }
#undef C_WAIT
#undef C_LOAD
#undef C_STEP
    if (sfin) {
#pragma unroll
        for (int g = 0; g < 4; ++g) { *(f32x4*)(sfin + (size_t)vcol * 64 + 8 * g + 4 * hf) = (f32x4){S0t[4 * g], S0t[4 * g + 1], S0t[4 * g + 2], S0t[4 * g + 3]};
            *(f32x4*)(sfin + (size_t)vcol * 64 + 32 + 8 * g + 4 * hf) = (f32x4){S1t[4 * g], S1t[4 * g + 1], S1t[4 * g + 2], S1t[4 * g + 3]}; }
    }
}
__global__ void __launch_bounds__(NWAVES * 64, 2) fwd_kernel(Params p_unused) {
    extern __shared__ __attribute__((aligned(16))) unsigned char lds_raw[];
    LAS unsigned char* lds = (LAS unsigned char*)lds_raw;
    volatile LAS unsigned* MISC = (volatile LAS unsigned*)(lds + MISC_OFF);
    const int G = gridDim.x, bx = blockIdx.x, vcu = (G % 8 == 0) ? (bx % 8) * (G / 8) + bx / 8 : bx;
    const int NGW = G * NWAVES;
    const int wave0 = __builtin_amdgcn_readfirstlane(threadIdx.x >> 6);
    for (int u = threadIdx.x; u < (LDS_BYTES - LDSCTL_OFF) / 4; u += NWAVES * 64) ((LAS unsigned*)(lds + LDSCTL_OFF))[u] = 0u;
#define TID_VARS KPtr p = kp0; asm volatile("" : "+s"(p)); unsigned char* ws = p->ws; (void)ws; int lane; PG8_LANE(lane); const int wave = wave0, tid = wave0 * 64 + lane, gw = vcu * NWAVES + wave; (void)tid; (void)gw;
    __syncthreads();
    const KPtr kp0 = (KPtr)__builtin_amdgcn_kernarg_segment_ptr();
    const int lo = kp0->ph_lo, hi = kp0->ph_hi, dupm = kp0->dupmask;
    const bool multi = (hi - lo) > 1;
    XcdBarrier bar; bar.bar = (unsigned*)(kp0->ws + WS_CTL) + CW_BAR; bar.x = 0; bar.st = nullptr;
    if (multi) bar = xcd_barrier_post((unsigned*)(kp0->ws + WS_CTL) + CW_BAR, MISC + 8);
#ifndef PHMASK
#define PHMASK 0xffff
#endif
#define IN(k) (((PHMASK >> (k)) & 1) && lo <= (k) && (k) < hi)
#ifndef DUPMASK
#define DUPMASK 0
#endif
#define REP(k) for (int rep_ = 0; rep_ < 1 + ((dupm >> (k)) & 1); ++rep_)
#ifndef BARDUP
#define BARDUP 0
#endif
#define SEAM(k) do { if (IN(k) && IN((k) + 1)) { xcd_barrier(bar, wave0); if (BARDUP) xcd_barrier(bar, wave0); } } while (0)
    if (IN(0)) REP(0) { TID_VARS p0_prologue(p, lds, vcu, G, tid); }
    if (IN(1)) REP(1) { TID_VARS
        if (IN(0)) {
            if (tid == 0) { unsigned* cnt = (unsigned*)(ws + WS_CTL) + CW_MODCNT; unsigned sp = 0;
                while (__hip_atomic_load(cnt, __ATOMIC_RELAXED, __HIP_MEMORY_SCOPE_AGENT) < 192u * (1u + ((dupm >> 0) & 1))) { __builtin_amdgcn_s_sleep(2); if (++sp > (1u << 22)) break; }
                __builtin_amdgcn_fence(__ATOMIC_ACQUIRE, "agent"); asm volatile("s_waitcnt vmcnt(0)" ::: "memory"); }
            __syncthreads();
        }
        p1_norm1(p, gw, NGW, lane); } SEAM(1);
    if (IN(2)) REP(2) {
        KPtr p = kp0; asm volatile("" : "+s"(p)); unsigned char* ws = p->ws;
        typedef pg8::Gemm<1024, 1024, 1024, 1 << 20, 0, 1 << 20, 0> GT; GT g{(const bf16*)(ws + WS_XN), (const bf16*)(ws + WS_WIN)};
        pg8::StaticOrder S; S.init(NTOK, N_IN, G, bx);
        EpiG1 E{(bf16*)(ws + WS_RKV), (bf16*)(ws + WS_PB), (bf16*)(ws + WS_A2)};
        pg8::gemm_phase<EpiG1, pg8::StaticOrder, GT, true, true>(lds, g, S, E, wave0);
    } SEAM(2);
    if (IN(4)) REP(4) { TID_VARS
        const int q4 = wave & 3, half = wave >> 2; LAS unsigned char* wl = lds + q4 * P1_WAVE_LDS;
        if (half == 0 && lane < 2) ((volatile LAS unsigned*)(wl + P1_SYNC))[lane] = 0u;
        __syncthreads();
        unsigned phase = 0u;
        for (int W = vcu * 4 + q4; W < 4096; W += G * 4) { if (W & 1) p4_pass1<1>(p, wl, W >> 1, half, phase); else p4_pass1<0>(p, wl, W >> 1, half, phase); }
        __syncthreads();
    } SEAM(4);
    if (IN(5)) REP(5) { KPtr p = kp0; asm volatile("" : "+s"(p));
        if (G == 256) {
            if (vcu < 64) {
                if (wave0 == 0) { int l_; PG8_LANE(l_); if (l_ < 16) ((volatile LAS unsigned*)(lds + P2R_FLAGS))[l_] = 0u; }
                __syncthreads();
                if (wave0 == 0) p5_ring_consumer(p, lds, vcu); else if (wave0 == 1) p5_ring_ywave(p, lds, vcu); else p5_ring_helper(p, lds, vcu, wave0 - 2);
                __syncthreads();
            } else {
                if (wave0 < 3) { const int Xc = (vcu - 64) * 3 + wave0; if (Xc < 512) p5_pass2_wave(p, 64 + Xc); }
                else { int lane; PG8_LANE(lane); LAS float* scr = (LAS float*)(lds + wave0 * 16384);
                    bf16* W1 = (bf16*)(p->ws + WS_W1); bf16* W2 = (bf16*)(p->ws + WS_W2);
                    for (int it = (vcu - 64) * 5 + (wave0 - 3); it < 4096; it += 192 * 5) { if (it < 2048) p0_transpose_item(p->in[I_W1], DFF, W1, 1024, 0, scr, it, lane); else p0_transpose_item(p->in[I_W2], DM, W2, 4096, 0, scr, it - 2048, lane); } }
            }
        } else {
            for (int X = wave0 * G + vcu; X < 576; X += NWAVES * G) p5_pass2_wave(p, X);
            { int lane; PG8_LANE(lane); LAS float* scr = (LAS float*)(lds + wave0 * 16384); bf16* W1 = (bf16*)(p->ws + WS_W1); bf16* W2 = (bf16*)(p->ws + WS_W2);
              for (int it = vcu * NWAVES + wave0; it < 4096; it += G * NWAVES) { if (it < 2048) p0_transpose_item(p->in[I_W1], DFF, W1, 1024, 0, scr, it, lane); else p0_transpose_item(p->in[I_W2], DM, W2, 4096, 0, scr, it - 2048, lane); } }
        }
    } SEAM(5);
    if (IN(6)) REP(6) { TID_VARS for (int it = vcu; it < NTOK / 32; it += G) p4_conv_item(p, lds, it, tid); p6_post(p, gw, NGW, lane); } SEAM(6);
    if (IN(7)) REP(7) {
        KPtr p = kp0; asm volatile("" : "+s"(p)); unsigned char* ws = p->ws;
        typedef pg8::Gemm<1024, 512, 512, 4, 512, 1 << 20, 0> GT; GT g{(const bf16*)(ws + WS_RC), (const bf16*)(ws + WS_WOUT)};
        pg8::StaticOrder S; S.init(NTOK, 2048, G, bx);
        EpiG3 E{(const bf16*)(ws + WS_PB), (bf16*)(ws + WS_GM)};
        pg8::gemm_phase<EpiG3, pg8::StaticOrder, GT, true, true>(lds, g, S, E, wave0);
    } SEAM(7);
    if (IN(8)) REP(8) {
        KPtr p = kp0; asm volatile("" : "+s"(p)); unsigned char* ws = p->ws;
        typedef pg8::Gemm<2048, 1024, 1024, 4, 1024, 4, 0> GT; GT g{(const bf16*)(ws + WS_GM), (const bf16*)(ws + WS_WO)};
        pg8::StaticOrder S; S.init(NTOK, 2048, G, bx);
        EpiPart E{(bf16*)(ws + WS_PART)};
        pg8::gemm_phase<EpiPart, pg8::StaticOrder, GT, true, true>(lds, g, S, E, wave0);
    } SEAM(8);
    if (IN(9)) REP(9) { TID_VARS p7_res_norm2(p, gw, NGW, lane); } SEAM(9);
    if (IN(10)) REP(10) {
        KPtr p = kp0; asm volatile("" : "+s"(p)); unsigned char* ws = p->ws;
        typedef pg8::Gemm<1024, 1024, 1024, 1 << 20, 0, 1 << 20, 0> GT; GT g{(const bf16*)(ws + WS_XN), (const bf16*)(ws + WS_W1)};
        pg8::StaticOrder S; S.init(NTOK, DFF, G, bx);
        EpiG5 E{(bf16*)(ws + WS_H)};
        pg8::gemm_phase<EpiG5, pg8::StaticOrder, GT, true, true>(lds, g, S, E, wave0);
    } SEAM(10);
    if (IN(11)) REP(11) {
        KPtr p = kp0; asm volatile("" : "+s"(p)); unsigned char* ws = p->ws;
        typedef pg8::Gemm<4096, 4096, 2048, 4, 2048, 4, 2048> GT; GT g{(const bf16*)(ws + WS_H), (const bf16*)(ws + WS_W2)};
        pg8::StaticOrder S; S.init(NTOK, 2048, G, bx);
        EpiPart E{(bf16*)(ws + WS_PART)};
        pg8::gemm_phase<EpiPart, pg8::StaticOrder, GT, true, true>(lds, g, S, E, wave0);
    } SEAM(11);
    if (IN(12)) REP(12) { TID_VARS p12_final(p, gw, NGW, lane); }
#undef IN
#undef SEAM
}

extern "C" void kernel_launch(void* const* d_in, const int* in_sizes, int n_in, void* d_out, int out_size, void* d_ws, size_t ws_size, hipStream_t stream) {
    static int grid = 0;
    if (grid == 0) {
        if (n_in != 36 || ws_size < WS_END) { fprintf(stderr, "kernel_launch: unexpected n_in %d / ws %zu\n", n_in, ws_size); grid = -1; return; }
        int dev = 0, cus = 0, per_cu = 0;
        if (hipGetDevice(&dev) != hipSuccess || hipDeviceGetAttribute(&cus, hipDeviceAttributeMultiprocessorCount, dev) != hipSuccess) { grid = -1; return; }
        if (hipFuncSetAttribute((const void*)fwd_kernel, hipFuncAttributeMaxDynamicSharedMemorySize, LDS_BYTES) != hipSuccess) { fprintf(stderr, "kernel_launch: hipFuncSetAttribute failed\n"); grid = -1; return; }
        if (hipOccupancyMaxActiveBlocksPerMultiprocessor(&per_cu, (const void*)fwd_kernel, NWAVES * 64, LDS_BYTES) != hipSuccess || per_cu < 1)
            fprintf(stderr, "kernel_launch: occupancy query reports %d\n", per_cu);
        (void)hipGetLastError();
        grid = cus;
    }
    if (grid < 0) return;
    if (hipMemsetAsync((char*)d_ws + WS_CTL, 0, CTL_ZERO_BYTES, stream) != hipSuccess) { fprintf(stderr, "kernel_launch: memset failed\n"); return; }
    Params a{};
    for (int i = 0; i < 36; ++i) a.in[i] = (const float*)d_in[i];
    a.out = (float*)d_out; a.ws = (unsigned char*)d_ws; a.dupmask = DUPMASK;
#if MK_ONE_LAUNCH
    a.ph_lo = 0; a.ph_hi = NPH;
    hipLaunchKernelGGL(fwd_kernel, dim3(grid), dim3(NWAVES * 64), LDS_BYTES, stream, a);
#else
    for (int ph = 0; ph < NPH; ++ph) { a.ph_lo = ph; a.ph_hi = ph + 1; hipLaunchKernelGGL(fwd_kernel, dim3(grid), dim3(NWAVES * 64), LDS_BYTES, stream, a); }
#endif
    const hipError_t le = hipPeekAtLastError();
    if (le != hipSuccess) fprintf(stderr, "kernel_launch: launch failed: %s\n", hipGetErrorName(le));
}
```

```cpp
#include <hip/hip_runtime.h>
#include <cstdio>
#include <cstdint>
namespace pg8 {
#define PG8_LAS __attribute__((address_space(3)))
typedef unsigned short bf16_t;
typedef short bf16x8 __attribute__((ext_vector_type(8)));
typedef float f32x4 __attribute__((ext_vector_type(4)));
typedef unsigned u32x4 __attribute__((ext_vector_type(4)));
constexpr int BM = 256, BK = 64, HALF = 128, HTB = HALF * BK * 2  , STAGE_BYTES = 8 * HTB, NXCD = 8, WGM = 8;

__host__ __device__ __forceinline__ int lds_byte(int r, int c) { const int st = (r >> 4) * 2 + (c >> 5), rr = r & 15, cc = c & 31, ob = rr * 64 + cc * 2; return st * 1024 + (ob ^ (((ob >> 9) & 1) << 5)); }
__host__ __device__ __forceinline__ void stage_rc(int b, int& R, int& C) { const int st = b / 1024, sb = b % 1024, swz = sb ^ (((sb >> 9) & 1) << 5); R = (st >> 1) * 16 + swz / 64; C = (st & 1) * 32 + (swz % 64) / 2; }
__host__ __device__ __forceinline__ int perm32(int rho) { const int n = rho >> 4, i = rho & 15; return 8 * (i >> 2) + 4 * n + (i & 3); }

struct Unit { int pm, pn; };
template <int LDA, int LDB, int KK, int GA, int ACOFF, int GB, int BCOFF>
struct Gemm { const bf16_t* A; const bf16_t* Bt;
    static constexpr int lda = LDA, ldb = LDB, K = KK;
    __device__ __forceinline__ const char* aptr(const Unit& u) const { return (const char*)(A + (size_t)u.pm * BM * LDA + (size_t)(u.pn / GA) * ACOFF); }
    __device__ __forceinline__ const char* bptr(const Unit& u) const { return (const char*)(Bt + (size_t)(u.pn % GB) * BM * LDB + (size_t)(u.pn / GB) * BCOFF); }
};

struct StaticOrder {
    int nM, nN, nwg, G, c;
    __host__ __device__ void init(int M, int N, int G_, int c_) { nM = M / BM; nN = N / BM; nwg = nM * nN; G = G_; c = c_; }
    __host__ __device__ bool next(int i, Unit& u) const {
        const long L = (long)i * G + c; if (L >= nwg) return false;
        int wgid = (int)L; { const int q = nwg / NXCD, r = nwg % NXCD, xcd = wgid % NXCD, off = wgid / NXCD; wgid = (xcd < r ? xcd * (q + 1) : r * (q + 1) + (xcd - r) * q) + off; }
        const int nig = WGM * nN, gid = wgid / nig, fm = gid * WGM, gsz = (nM - fm) < WGM ? (nM - fm) : WGM;
        u.pm = fm + ((wgid % nig) % gsz); u.pn = (wgid % nig) / gsz; return true;
    }
    __device__ __forceinline__ void a_ready(const Unit&) const {}
    __device__ __forceinline__ void done(const Unit&) const {}
};
#define PG8_LANE(x) asm volatile("v_mbcnt_lo_u32_b32 %0, -1, 0\n\tv_mbcnt_hi_u32_b32 %0, -1, %0" : "=v"(x))
typedef __bf16 bf16n2 __attribute__((ext_vector_type(2)));
typedef float f32n2 __attribute__((ext_vector_type(2)));
__device__ __forceinline__ unsigned cvt_pk_bf16(float lo, float hi) { const f32n2 v = {lo, hi}; const bf16n2 b = __builtin_convertvector(v, bf16n2); return __builtin_bit_cast(unsigned, b); }

template <class Epi, class Sched, class GemmT, bool ALIGN_EPI = false, bool SP2 = false>
__device__ __forceinline__ void gemm_phase(PG8_LAS unsigned char* lds, const GemmT g, const Sched& S, const Epi& E, const int wid) {
    int lane; PG8_LANE(lane);
    const int tid = wid * 64 + lane, wr = wid >> 2, wc = wid & 3, fr = lane & 15, fq = lane >> 4;
    const int K = g.K, nt = K / BK;
    unsigned voffA[2], voffB[2];
#pragma unroll
    for (int i = 0; i < 2; ++i) { int R, C; stage_rc(tid * 16 + i * 8192, R, C); const int Rb = Epi::PERM ? ((R & ~31) + perm32(R & 31)) : R;
        voffA[i] = (unsigned)(R * g.lda + C) * 2u; voffB[i] = (unsigned)(Rb * g.ldb + C) * 2u; }
    const size_t kstep = (size_t)(BK * 2);
    const size_t hstepA = (size_t)HALF * g.lda * 2, hstepB = (size_t)HALF * g.ldb * 2;
    const unsigned ldsw = (unsigned)wid * 1024u;
    const int aoff = lds_byte(wr * 64 + fr, fq * 8), boff = lds_byte(wc * 32 + fr, fq * 8);
#define PG8_SA(b, h) (((b) * 2 + (h)) * HTB)
#define PG8_SB(b, h) ((4 + (b) * 2 + (h)) * HTB)
#define PG8_STAGE(bufoff, gbase, voff) do { _Pragma("unroll") for (int _i = 0; _i < 2; ++_i) \
        __builtin_amdgcn_global_load_lds((const unsigned*)((const char*)(gbase) + (voff)[_i]), (PG8_LAS unsigned*)(lds + (bufoff) + ldsw + _i * 8192), 16, 0, 0); } while (0)
#define PG8_LDA(dst, b, h) do { _Pragma("unroll") for (int m = 0; m < 4; ++m) _Pragma("unroll") for (int k = 0; k < 2; ++k) dst[m][k] = *(const PG8_LAS bf16x8*)(lds + PG8_SA(b, h) + aoff + m * 2048 + k * 1024); } while (0)
#define PG8_LDB(dst, b, h) do { _Pragma("unroll") for (int n = 0; n < 2; ++n) _Pragma("unroll") for (int k = 0; k < 2; ++k) dst[n][k] = *(const PG8_LAS bf16x8*)(lds + PG8_SB(b, h) + boff + n * 2048 + k * 1024); } while (0)
#define PG8_MMA(ai, bj, At, Bt) do { __builtin_amdgcn_s_setprio(1); _Pragma("unroll") for (int m = 0; m < 4; ++m) _Pragma("unroll") for (int n = 0; n < 2; ++n) _Pragma("unroll") for (int k = 0; k < 2; ++k) \
        acc[ai][bj][m][n] = __builtin_amdgcn_mfma_f32_16x16x32_bf16(Bt[n][k], At[m][k], acc[ai][bj][m][n], 0, 0, 0); __builtin_amdgcn_s_setprio(0); } while (0)
#define PG8_WAIT_V(n) asm volatile("s_waitcnt vmcnt(" #n ")" ::: "memory")
#define PG8_WAIT_L(n) asm volatile("s_waitcnt lgkmcnt(" #n ")" ::: "memory")
#define PG8_BAR __builtin_amdgcn_s_barrier()
#define PG8_SCHED __builtin_amdgcn_sched_barrier(0)
    Unit cur, nxt; int ui = 0;
    if (!S.next(0, cur)) return;
    f32x4 acc[2][2][4][2];
#pragma unroll
    for (int a = 0; a < 2; ++a)
#pragma unroll
        for (int b = 0; b < 2; ++b)
#pragma unroll
            for (int m = 0; m < 4; ++m)
#pragma unroll
                for (int n = 0; n < 2; ++n) acc[a][b][m][n] = (f32x4){0.f, 0.f, 0.f, 0.f};
    bf16x8 At[4][2], B0[2][2], B1[2][2];
    const char* cA = g.aptr(cur); const char* cB = g.bptr(cur);
    S.a_ready(cur);
    if constexpr (SP2) {
        PG8_STAGE(PG8_SB(0, 0), cB, voffB); PG8_STAGE(PG8_SB(0, 1), cB + hstepB, voffB); PG8_STAGE(PG8_SA(0, 0), cA, voffA); PG8_STAGE(PG8_SA(0, 1), cA + hstepA, voffA);
        if (wr == 1) PG8_BAR;
        PG8_WAIT_V(2); PG8_BAR;
        PG8_STAGE(PG8_SB(1, 0), cB + kstep, voffB); PG8_STAGE(PG8_SA(1, 0), cA + kstep, voffA); PG8_STAGE(PG8_SB(1, 1), cB + hstepB + kstep, voffB);
        PG8_WAIT_V(6); PG8_BAR;
    } else {
        PG8_STAGE(PG8_SB(0, 0), cB, voffB); PG8_STAGE(PG8_SA(0, 0), cA, voffA); PG8_STAGE(PG8_SB(0, 1), cB + hstepB, voffB); PG8_STAGE(PG8_SA(0, 1), cA + hstepA, voffA);
        if (wr == 1) PG8_BAR;
        PG8_WAIT_V(4); PG8_BAR;
        PG8_STAGE(PG8_SB(1, 0), cB + kstep, voffB); PG8_STAGE(PG8_SA(1, 0), cA + kstep, voffA); PG8_STAGE(PG8_SB(1, 1), cB + hstepB + kstep, voffB);
        PG8_WAIT_V(6); PG8_BAR;
    }
    for (;;) {
        const bool has_next = S.next(ui + 1, nxt);
        const char* nA = has_next ? g.aptr(nxt) : cA; const char* nB = has_next ? g.bptr(nxt) : cB;
        for (int t = 0; t < nt; t += 2) {
            const bool last = (t == nt - 2);
            const char* a1 = cA + (size_t)(t + 1) * kstep;
            const char* a2 = last ? nA : cA + (size_t)(t + 2) * kstep; const char* b2 = last ? nB : cB + (size_t)(t + 2) * kstep;
            const char* a3 = a2 + kstep; const char* b3 = b2 + kstep;
            if (last && has_next) S.a_ready(nxt);
            if constexpr (SP2) {
            PG8_LDB(B0, 0, 0); PG8_LDB(B1, 0, 1); PG8_SCHED; PG8_LDA(At, 0, 0); PG8_STAGE(PG8_SA(1, 1), a1 + hstepA, voffA);
            PG8_WAIT_V(8); PG8_WAIT_L(0); PG8_BAR; PG8_MMA(0, 0, At, B0); PG8_MMA(0, 1, At, B1); PG8_BAR; PG8_SCHED;
            PG8_LDA(At, 0, 1); PG8_STAGE(PG8_SB(0, 0), b2, voffB); PG8_STAGE(PG8_SB(0, 1), b2 + hstepB, voffB); PG8_STAGE(PG8_SA(0, 0), a2, voffA);
            PG8_WAIT_V(8); PG8_WAIT_L(0); PG8_BAR; PG8_MMA(1, 0, At, B0); PG8_MMA(1, 1, At, B1); PG8_BAR; PG8_SCHED;
            PG8_LDB(B0, 1, 0); PG8_LDB(B1, 1, 1); PG8_SCHED; PG8_LDA(At, 1, 0); PG8_STAGE(PG8_SA(0, 1), a2 + hstepA, voffA);
            PG8_WAIT_V(8); PG8_WAIT_L(0); PG8_BAR; PG8_MMA(0, 0, At, B0); PG8_MMA(0, 1, At, B1); PG8_BAR; PG8_SCHED;
            PG8_LDA(At, 1, 1); PG8_STAGE(PG8_SB(1, 0), b3, voffB); PG8_STAGE(PG8_SB(1, 1), b3 + hstepB, voffB); PG8_STAGE(PG8_SA(1, 0), a3, voffA);
            PG8_WAIT_V(8); PG8_WAIT_L(0); PG8_BAR; PG8_MMA(1, 0, At, B0); PG8_MMA(1, 1, At, B1); PG8_BAR; PG8_SCHED;
            } else {
            PG8_LDB(B0, 0, 0); PG8_SCHED; PG8_LDA(At, 0, 0); PG8_STAGE(PG8_SA(1, 1), a1 + hstepA, voffA);
            PG8_WAIT_L(8); PG8_BAR; PG8_WAIT_L(0); PG8_MMA(0, 0, At, B0); PG8_BAR; PG8_SCHED;
            PG8_LDB(B1, 0, 1); PG8_STAGE(PG8_SB(0, 0), b2, voffB);
            PG8_BAR; PG8_WAIT_L(0); PG8_MMA(0, 1, At, B1); PG8_BAR;
            PG8_LDA(At, 0, 1); PG8_STAGE(PG8_SA(0, 0), a2, voffA);
            PG8_BAR; PG8_WAIT_L(0); PG8_MMA(1, 0, At, B0); PG8_BAR; PG8_SCHED;
            PG8_STAGE(PG8_SB(0, 1), b2 + hstepB, voffB);
            PG8_WAIT_V(6); PG8_BAR; PG8_MMA(1, 1, At, B1); PG8_BAR;
            PG8_LDB(B0, 1, 0); PG8_SCHED; PG8_LDA(At, 1, 0); PG8_STAGE(PG8_SA(0, 1), a2 + hstepA, voffA);
            PG8_WAIT_L(8); PG8_BAR; PG8_WAIT_L(0); PG8_MMA(0, 0, At, B0); PG8_BAR; PG8_SCHED;
            PG8_LDB(B1, 1, 1); PG8_STAGE(PG8_SB(1, 0), b3, voffB);
            PG8_BAR; PG8_WAIT_L(0); PG8_MMA(0, 1, At, B1); PG8_BAR;
            PG8_LDA(At, 1, 1); PG8_STAGE(PG8_SA(1, 0), a3, voffA);
            PG8_BAR; PG8_WAIT_L(0); PG8_MMA(1, 0, At, B0); PG8_BAR; PG8_SCHED;
            PG8_STAGE(PG8_SB(1, 1), b3 + hstepB, voffB);
            PG8_WAIT_V(6); PG8_BAR; PG8_MMA(1, 1, At, B1); PG8_BAR;
            }
        }
        if constexpr (ALIGN_EPI) { if (wr == 0) PG8_BAR; }
        if constexpr (!Epi::AFTER_DRAIN) { int el; PG8_LANE(el); E(acc, cur, wr, wc, el & 15, el >> 4); S.done(cur); }
        if (!has_next) break;
#pragma unroll
        for (int a = 0; a < 2; ++a)
#pragma unroll
            for (int b = 0; b < 2; ++b)
#pragma unroll
                for (int m = 0; m < 4; ++m)
#pragma unroll
                    for (int n = 0; n < 2; ++n) acc[a][b][m][n] = (f32x4){0.f, 0.f, 0.f, 0.f};
        cur = nxt; cA = nA; cB = nB; ++ui;
        if constexpr (ALIGN_EPI) { if (wr == 1) PG8_BAR; }
    }
    PG8_WAIT_V(0);
    if constexpr (!ALIGN_EPI) { if (wr == 0) PG8_BAR; }
    PG8_BAR;
    if constexpr (Epi::AFTER_DRAIN) { E.fused(acc, cur, wr, wc, fr, fq, lds, wid, lane); S.done(cur); }
#undef PG8_SA
#undef PG8_SB
#undef PG8_STAGE
#undef PG8_LDA
#undef PG8_LDB
#undef PG8_MMA
#undef PG8_WAIT_V
#undef PG8_WAIT_L
#undef PG8_BAR
#undef PG8_SCHED
}
}

constexpr int NWAVES = 8;
constexpr int NTOK = 8192, NCTX = 4096, DM = 1024, RW = 512, NH = 8, HD = 64, DFF = 4096;
constexpr int N_IN = 5888;
constexpr int NPH = 13;
#ifndef MK_ONE_LAUNCH
#define MK_ONE_LAUNCH 1
#endif
constexpr size_t MiB = 1u << 20;
constexpr size_t WS_CTL = 0, CTL_ZERO_BYTES = 64 * 1024;
constexpr size_t WS_MOD = 1 * MiB;
constexpr size_t WS_WIN = 2 * MiB;
constexpr size_t WS_B2 = 14 * MiB;
constexpr size_t WS_WOUT = 16 * MiB;
constexpr size_t WS_WO = 18 * MiB;
constexpr size_t WS_W1 = 20 * MiB;
constexpr size_t WS_W2 = 28 * MiB;
constexpr size_t WS_XN = 36 * MiB;
constexpr size_t WS_A2 = 52 * MiB;
constexpr size_t WS_RKV = 72 * MiB;
constexpr size_t WS_PB = 120 * MiB;
constexpr size_t WS_WD = 168 * MiB;
constexpr size_t WS_AL = 200 * MiB;
constexpr size_t WS_RECB = 216 * MiB;
constexpr size_t WS_GC = 252 * MiB;
constexpr size_t WS_END = 256 * MiB;
constexpr size_t WS_RECA = 168 * MiB;
constexpr size_t REC_BYTES = 18432;
constexpr size_t WS_YF = WS_RKV, WS_YB = WS_RKV + 16 * MiB, WS_RC = WS_RKV + 32 * MiB;
constexpr size_t WS_GM = WS_RKV, WS_H = WS_RKV;
constexpr size_t WS_PART = 168 * MiB;
constexpr size_t DO_G = 0, DO_V = 8 * MiB, DO_VT = 16 * MiB, DO_DOT = 24 * MiB;
constexpr int CW_MODCNT = 512;
constexpr int CW_BAR = 1024;
constexpr int RING_BYTES = 131072;
constexpr int LDSCTL_OFF = RING_BYTES, MISC_OFF = LDSCTL_OFF + 320;
constexpr int LDS_BYTES = 147456;

#define GAS __attribute__((address_space(1)))
#define LAS __attribute__((address_space(3)))
typedef unsigned short bf16;
typedef unsigned v4u __attribute__((ext_vector_type(4)));
typedef unsigned v2u __attribute__((ext_vector_type(2)));
typedef float f32x4 __attribute__((ext_vector_type(4)));
#define LDS_WAIT() asm volatile("s_waitcnt lgkmcnt(0)" ::: "memory")
#define VM_WAIT() asm volatile("s_waitcnt vmcnt(0)" ::: "memory")
__device__ __forceinline__ unsigned pk2(float lo, float hi) { return pg8::cvt_pk_bf16(lo, hi); }
__device__ __forceinline__ float bflo(unsigned u) { return __uint_as_float(u << 16); }
__device__ __forceinline__ float bfhi(unsigned u) { return __uint_as_float(u & 0xffff0000u); }
__device__ __forceinline__ float bf1(bf16 u) { return __uint_as_float((unsigned)u << 16); }
__device__ __forceinline__ float sigm(float x) { return __builtin_amdgcn_rcpf(1.0f + __expf(-x)); }
__device__ __forceinline__ float tanh_fast(float x) { const float t = __expf(2.0f * x); return 1.0f - 2.0f * __builtin_amdgcn_rcpf(t + 1.0f); }
__device__ __forceinline__ v4u pack8(const f32x4 a, const f32x4 b) { v4u w; w.x = pk2(a[0], a[1]); w.y = pk2(a[2], a[3]); w.z = pk2(b[0], b[1]); w.w = pk2(b[2], b[3]); return w; }
__device__ __forceinline__ void unpack8(const v4u w, float (&o)[8]) { o[0] = bflo(w.x); o[1] = bfhi(w.x); o[2] = bflo(w.y); o[3] = bfhi(w.y); o[4] = bflo(w.z); o[5] = bfhi(w.z); o[6] = bflo(w.w); o[7] = bfhi(w.w); }
__device__ __forceinline__ float wave_sum(float v) {
#pragma unroll
    for (int o = 1; o < 64; o <<= 1) v += __shfl_xor(v, o);
    return v;
}
__device__ __forceinline__ float oct_sum(float v) { v += __shfl_xor(v, 1); v += __shfl_xor(v, 2); v += __shfl_xor(v, 4); return v; }

#define XB_TMO      128
#define XB_XCNT(j)  (256  + 64 * (j))
#define XB_XSUB(j)  (1280 + 64 * (j))
#define XB_XGEN(j)  (2304 + 64 * (j))
#define XB_TOP      3328
#define XB_TOPGEN   3392
#define XCD_BAR_WORDS 3456
#define XB_SPIN_CAP (1u << 18)
__device__ __forceinline__ unsigned xb_ld(unsigned* p)              { return __hip_atomic_load(p, __ATOMIC_RELAXED, __HIP_MEMORY_SCOPE_AGENT); }
__device__ __forceinline__ unsigned xb_add(unsigned* p, unsigned v) { return __hip_atomic_fetch_add(p, v, __ATOMIC_RELAXED, __HIP_MEMORY_SCOPE_AGENT); }
__device__ __forceinline__ unsigned xb_xcc_id() { return (unsigned)__builtin_amdgcn_s_getreg((3 << 11) | 20) & 0xFu; }
#define XB_SPIN(cond, bar) do { unsigned _sp = 0; while (cond) { __builtin_amdgcn_s_sleep(1); \
    if ((++_sp & 255u) == 0u) { if (xb_ld(&(bar)[XB_TMO])) break; if (_sp > XB_SPIN_CAP) { atomicAdd(&(bar)[XB_TMO], 1u); break; } } } } while (0)
struct XcdBarrier { unsigned* bar; unsigned x; volatile LAS unsigned* st; };
__device__ __forceinline__ XcdBarrier xcd_barrier_post(unsigned* bar, volatile LAS unsigned* st) {
    XcdBarrier b; b.bar = bar; b.x = xb_xcc_id(); b.st = st;
    if (threadIdx.x == 0) (void)xb_add(&bar[XB_XCNT(b.x)], 1u);
    return b;
}
__device__ __forceinline__ void xcd_barrier_complete(unsigned* bar, unsigned x, unsigned& nloc, unsigned& nx) {
    const unsigned G = gridDim.x * gridDim.y * gridDim.z;
    unsigned sum, cnt, mine, sp = 0u;
    for (;;) {
        sum = 0u; cnt = 0u; mine = 0u;
#pragma unroll
        for (unsigned j = 0; j < 16; ++j) { const unsigned c = xb_ld(&bar[XB_XCNT(j)]); sum += c; cnt += (c > 0u) ? 1u : 0u; mine = (j == x) ? c : mine; }
        if (sum == G) break;
        __builtin_amdgcn_s_sleep(1);
        if ((++sp & 255u) == 0u) { if (xb_ld(&bar[XB_TMO])) break; if (sp > XB_SPIN_CAP) { atomicAdd(&bar[XB_TMO], 1u); break; } }
    }
    nloc = mine > 0u ? mine : 1u; nx = cnt > 0u ? cnt : 1u;
}
__device__ __forceinline__ void xcd_barrier(const XcdBarrier& b, const int wave0) {
    asm volatile("s_waitcnt vmcnt(0)" ::: "memory");
    __syncthreads();
    int l_; PG8_LANE(l_);
    if (wave0 == 0 && l_ == 0) {
        unsigned* bar = b.bar;
        __builtin_amdgcn_s_waitcnt(0);
        unsigned nloc = b.st[0], nx = b.st[1];
        if (nloc == 0u) { xcd_barrier_complete(bar, b.x, nloc, nx); b.st[0] = nloc; b.st[1] = nx; }
        const unsigned old = xb_add(&bar[XB_XSUB(b.x)], 1u);
        const unsigned gen = old / nloc;
        if (old + 1u == (gen + 1u) * nloc) {
            __builtin_amdgcn_fence(__ATOMIC_RELEASE, "agent");
            asm volatile("s_waitcnt vmcnt(0)" ::: "memory");
            const unsigned og = xb_add(&bar[XB_TOP], 1u);
            const unsigned tg = og / nx;
            if (og + 1u == (tg + 1u) * nx) xb_add(&bar[XB_TOPGEN], 1u);
            else XB_SPIN(xb_ld(&bar[XB_TOPGEN]) == tg, bar);
            __builtin_amdgcn_fence(__ATOMIC_ACQUIRE, "agent");
            xb_add(&bar[XB_XGEN(b.x)], 1u);
            asm volatile("s_waitcnt vmcnt(0)" ::: "memory");
        } else {
            XB_SPIN(xb_ld(&bar[XB_XGEN(b.x)]) == gen, bar);
            __builtin_amdgcn_fence(__ATOMIC_ACQUIRE, "agent");
            asm volatile("s_waitcnt vmcnt(0)" ::: "memory");
        }
    }
    __syncthreads();
}

struct Params { const float* in[36]; float* out; unsigned char* ws; int ph_lo, ph_hi, dupmask, pad; };
enum { I_XP = 0, I_XS, I_SF, I_SB, I_C, I_CCTX, I_ADAW, I_ADAB, I_N1G, I_N2G, I_WIN, I_MUP, I_MUN, I_DW0, I_DW1, I_DW2, I_IA0, I_IA1, I_IA2, I_GG1, I_GG2,
       I_KK, I_KA, I_RK, I_LNXG, I_LNXB, I_WOR, I_CW, I_CB, I_CLG, I_CLB, I_WOC, I_WO, I_W1, I_W2, I_FG };

typedef const __attribute__((address_space(4))) Params* KPtr;
__device__ __forceinline__ int cond_of(int m) { return m < NCTX ? 0 : 1 + ((m - NCTX) >> 11); }

struct EpiG1 {
    static constexpr bool PERM = true, AFTER_DRAIN = false;
    bf16* RKV; bf16* PB; bf16* A2;
    __device__ __forceinline__ void operator()(const f32x4 (&acc)[2][2][4][2], const pg8::Unit& u, int wr, int wc, int fr, int fq) const {
        const int row0 = u.pm * 256 + wr * 64 + fr, colt = wc * 32 + 8 * fq;
        if (u.pn < 6) {
#pragma unroll
            for (int ai = 0; ai < 2; ++ai)
#pragma unroll
                for (int m = 0; m < 4; ++m) { bf16* rp = RKV + (size_t)(row0 + ai * 128 + m * 16) * 1536 + u.pn * 256 + colt;
#pragma unroll
                    for (int bj = 0; bj < 2; ++bj) *(v4u*)(rp + bj * 128) = pack8(acc[ai][bj][m][0], acc[ai][bj][m][1]); }
        } else if (u.pn < 18) {
#pragma unroll
            for (int ai = 0; ai < 2; ++ai)
#pragma unroll
                for (int m = 0; m < 4; ++m) { bf16* rp = PB + (size_t)(row0 + ai * 128 + m * 16) * 3072 + (u.pn - 6) * 256 + colt;
#pragma unroll
                    for (int bj = 0; bj < 2; ++bj) *(v4u*)(rp + bj * 128) = pack8(acc[ai][bj][m][0], acc[ai][bj][m][1]); }
        } else {
            const int l = u.pn - 18;
#pragma unroll
            for (int ai = 0; ai < 2; ++ai)
#pragma unroll
                for (int m = 0; m < 4; ++m) { bf16* rp = A2 + (size_t)(row0 + ai * 128 + m * 16) * 1280 + l * 256 + colt;
#pragma unroll
                    for (int bj = 0; bj < 2; ++bj) { f32x4 a = acc[ai][bj][m][0], b = acc[ai][bj][m][1];
                        if (l == 0) {
#pragma unroll
                            for (int e = 0; e < 4; ++e) { a[e] = sigm(a[e]); b[e] = sigm(b[e]); }
                        } else if (l <= 2) {
#pragma unroll
                            for (int e = 0; e < 4; ++e) { a[e] = tanh_fast(a[e]); b[e] = tanh_fast(b[e]); }
                        }
                        *(v4u*)(rp + bj * 128) = pack8(a, b); } }
        }
    }
};
struct EpiG2 {
    static constexpr bool PERM = true, AFTER_DRAIN = false;
    bf16* G; float* WD; bf16* AL; const float* w0; const float* a0;
    __device__ __forceinline__ void operator()(const f32x4 (&acc)[2][2][4][2], const pg8::Unit& u, int wr, int wc, int fr, int fq) const {
        const int row0 = u.pm * 256 + wr * 64 + fr, l = u.pn >> 1, cb = (u.pn & 1) * 256 + wc * 32 + 8 * fq;
#pragma unroll
        for (int bj = 0; bj < 2; ++bj) {
            const int c0 = cb + bj * 128;
            f32x4 o0 = (f32x4){0.f, 0.f, 0.f, 0.f}, o1 = o0;
            if (l >= 1 && l <= 2) { o0 = *(const f32x4*)(w0 + (l - 1) * 512 + c0); o1 = *(const f32x4*)(w0 + (l - 1) * 512 + c0 + 4); }
            if (l >= 3) { o0 = *(const f32x4*)(a0 + (l - 3) * 512 + c0); o1 = *(const f32x4*)(a0 + (l - 3) * 512 + c0 + 4); }
#pragma unroll
            for (int ai = 0; ai < 2; ++ai)
#pragma unroll
                for (int m = 0; m < 4; ++m) { const size_t ro = (size_t)(row0 + ai * 128 + m * 16) * 512 + c0;
                    f32x4 a = acc[ai][bj][m][0] + o0, b = acc[ai][bj][m][1] + o1;
                    if (l == 0) { *(v4u*)(G + ro) = pack8(a, b); }
                    else if (l <= 2) {
#pragma unroll
                        for (int e = 0; e < 4; ++e) { a[e] = -0.6065306597126334f * sigm(a[e]); b[e] = -0.6065306597126334f * sigm(b[e]); }
                        float* wp = WD + (size_t)(l - 1) * NTOK * 512 + ro; *(f32x4*)wp = a; *(f32x4*)(wp + 4) = b;
                    } else {
#pragma unroll
                        for (int e = 0; e < 4; ++e) { a[e] = sigm(a[e]); b[e] = sigm(b[e]); }
                        *(v4u*)(AL + (size_t)(l - 3) * NTOK * 512 + ro) = pack8(a, b);
                    } }
        }
    }
};
struct EpiG3 {
    static constexpr bool PERM = true, AFTER_DRAIN = false;
    const bf16* PB; bf16* GM;
    __device__ __forceinline__ void operator()(const f32x4 (&acc)[2][2][4][2], const pg8::Unit& u, int wr, int wc, int fr, int fq) const {
        const int row0 = u.pm * 256 + wr * 64 + fr, cb = u.pn * 256 + wc * 32 + 8 * fq;
#pragma unroll
        for (int ai = 0; ai < 2; ++ai)
#pragma unroll
            for (int m = 0; m < 4; ++m) { const int row = row0 + ai * 128 + m * 16;
#pragma unroll
                for (int bj = 0; bj < 2; ++bj) { const int c0 = cb + bj * 128;
                    const v4u gw = *(const v4u*)(PB + (size_t)row * 3072 + 1024 + c0); float g[8]; unpack8(gw, g);
                    f32x4 a = acc[ai][bj][m][0], b = acc[ai][bj][m][1];
#pragma unroll
                    for (int e = 0; e < 4; ++e) { a[e] *= sigm(g[e]); b[e] *= sigm(g[4 + e]); }
                    *(v4u*)(GM + (size_t)row * 2048 + c0) = pack8(a, b); } }
    }
};
struct EpiPart {
    static constexpr bool PERM = true, AFTER_DRAIN = false;
    bf16* PART;
    __device__ __forceinline__ void operator()(const f32x4 (&acc)[2][2][4][2], const pg8::Unit& u, int wr, int wc, int fr, int fq) const {
        const int row0 = u.pm * 256 + wr * 64 + fr, cb = (u.pn & 3) * 256 + wc * 32 + 8 * fq;
        bf16* base = PART + (size_t)(u.pn >> 2) * NTOK * 1024;
#pragma unroll
        for (int ai = 0; ai < 2; ++ai)
#pragma unroll
            for (int m = 0; m < 4; ++m) { bf16* rp = base + (size_t)(row0 + ai * 128 + m * 16) * 1024 + cb;
#pragma unroll
                for (int bj = 0; bj < 2; ++bj) *(v4u*)(rp + bj * 128) = pack8(acc[ai][bj][m][0], acc[ai][bj][m][1]); }
    }
};
struct EpiG5 {
    static constexpr bool PERM = true, AFTER_DRAIN = false;
    bf16* H;
    __device__ __forceinline__ void operator()(const f32x4 (&acc)[2][2][4][2], const pg8::Unit& u, int wr, int wc, int fr, int fq) const {
        const int row0 = u.pm * 256 + wr * 64 + fr, cb = u.pn * 256 + wc * 32 + 8 * fq;
#pragma unroll
        for (int ai = 0; ai < 2; ++ai)
#pragma unroll
            for (int m = 0; m < 4; ++m) { bf16* rp = H + (size_t)(row0 + ai * 128 + m * 16) * DFF + cb;
#pragma unroll
                for (int bj = 0; bj < 2; ++bj) { f32x4 a = acc[ai][bj][m][0], b = acc[ai][bj][m][1];
#pragma unroll
                    for (int e = 0; e < 4; ++e) { const float x = fmaxf(a[e], 0.f), y = fmaxf(b[e], 0.f); a[e] = x * x; b[e] = y * y; }
                    *(v4u*)(rp + bj * 128) = pack8(a, b); } }
    }
};

__device__ __forceinline__ void p0_transpose_item(const float* W, int N, bf16* WT, int ldt, int row_off, LAS float* scr, int item, int lane) {
    const int nblk = N / 32, kb = item / nblk, nb = item % nblk, k0 = 64 * kb, n0 = 32 * nb;
    float tv[32];
#pragma unroll
    for (int i = 0; i < 32; ++i) { const int kk = 2 * i + (lane >> 5); tv[i] = W[(size_t)(k0 + kk) * N + n0 + (lane & 31)]; }
#pragma unroll
    for (int i = 0; i < 32; ++i) { const int kk = 2 * i + (lane >> 5); scr[kk * 33 + (lane & 31)] = tv[i]; }
    LDS_WAIT(); asm volatile("" ::: "memory");
    const int c = lane & 7;
#pragma unroll
    for (int j = 0; j < 4; ++j) { const int n = (lane >> 3) + 8 * j; const LAS float* s = scr + (8 * c) * 33 + n;
        v4u o; o.x = pk2(s[0 * 33], s[1 * 33]); o.y = pk2(s[2 * 33], s[3 * 33]); o.z = pk2(s[4 * 33], s[5 * 33]); o.w = pk2(s[6 * 33], s[7 * 33]);
        *(GAS v4u*)(WT + (size_t)(row_off + n0 + n) * ldt + k0 + 8 * c) = o; }
    LDS_WAIT(); asm volatile("" ::: "memory");
}
__device__ __forceinline__ void p0_mod_item(KPtr p, LAS unsigned char* lds, int item, int tid) {
    const int wave = tid >> 6, lane = tid & 63, kk = lane >> 3, c4 = lane & 7;
    const float* ada_w = p->in[I_ADAW]; const float* cc = p->in[I_C]; const float* cx = p->in[I_CCTX];
    f32x4 a0 = (f32x4){0.f, 0.f, 0.f, 0.f}, a1 = a0, a2 = a0;
#pragma unroll
    for (int i = 0; i < 16; ++i) {
        const int k = wave * 128 + i * 8 + kk;
        const f32x4 w = *(const f32x4*)(ada_w + (size_t)k * 6144 + item * 32 + c4 * 4);
        const float c0 = cx[k], c1 = cc[k], c2 = cc[1024 + k];
        a0 += w * (c0 * sigm(c0)); a1 += w * (c1 * sigm(c1)); a2 += w * (c2 * sigm(c2));
    }
#pragma unroll
    for (int e = 0; e < 4; ++e) {
#pragma unroll
        for (int o = 8; o < 64; o <<= 1) { a0[e] += __shfl_xor(a0[e], o); a1[e] += __shfl_xor(a1[e], o); a2[e] += __shfl_xor(a2[e], o); }
    }
    LAS float* red = (LAS float*)lds;
    if (lane < 8) {
#pragma unroll
        for (int e = 0; e < 4; ++e) { red[(wave * 3 + 0) * 32 + c4 * 4 + e] = a0[e]; red[(wave * 3 + 1) * 32 + c4 * 4 + e] = a1[e]; red[(wave * 3 + 2) * 32 + c4 * 4 + e] = a2[e]; }
    }
    __syncthreads();
    if (tid < 96) { const int j = tid >> 5, c = tid & 31; float s = p->in[I_ADAB][item * 32 + c];
#pragma unroll
        for (int w = 0; w < 8; ++w) s += red[(w * 3 + j) * 32 + c];
        __hip_atomic_store((float*)(p->ws + WS_MOD) + j * 6144 + item * 32 + c, s, __ATOMIC_RELAXED, __HIP_MEMORY_SCOPE_AGENT); }
    asm volatile("s_waitcnt vmcnt(0)" ::: "memory");
    __syncthreads();
    if (tid == 0) {
        __hip_atomic_fetch_add((unsigned*)(p->ws + WS_CTL) + CW_MODCNT, 1u, __ATOMIC_RELAXED, __HIP_MEMORY_SCOPE_AGENT); }
}
__device__ __forceinline__ void p0_prologue(KPtr p, LAS unsigned char* lds, int vcu, int G, int tid) {
    const int wave = __builtin_amdgcn_readfirstlane(tid >> 6), lane = tid & 63;
    for (int it = vcu; it < 192; it += G) p0_mod_item(p, lds, it, tid);
    LAS float* scr = (LAS float*)(lds + wave * 16384);
    const int gw = vcu * NWAVES + wave, NGW = G * NWAVES;
    bf16* Win = (bf16*)(p->ws + WS_WIN); bf16* B2 = (bf16*)(p->ws + WS_B2); bf16* Wout = (bf16*)(p->ws + WS_WOUT);
    bf16* Wo = (bf16*)(p->ws + WS_WO); bf16* W1 = (bf16*)(p->ws + WS_W1); bf16* W2 = (bf16*)(p->ws + WS_W2);
    constexpr int T_WIN = 16 * 144, T_GG1 = 16 * 4, T_L1 = 16 * 2, T_GG2 = 2 * 16, T_L2 = 16, T_WOUT = 8 * 32, T_WO = 16 * 32, T_W1 = 16 * 128, T_W2 = 64 * 32;
    constexpr int NITEMS = T_WIN + T_GG1 + 4 * T_L1 + T_GG2 + 4 * T_L2 + 2 * T_WOUT + T_WO;
    for (int it = gw; it < NITEMS; it += NGW) {
        int r = it;
        if (r < T_WIN) { p0_transpose_item(p->in[I_WIN], 4608, Win, 1024, 0, scr, r, lane); continue; } r -= T_WIN;
        if (r < T_WO) { p0_transpose_item(p->in[I_WO], DM, Wo, 1024, 0, scr, r, lane); continue; } r -= T_WO;
        if (r < T_WOUT) { p0_transpose_item(p->in[I_WOR], DM, Wout, 512, 0, scr, r, lane); continue; } r -= T_WOUT;
        if (r < T_WOUT) { p0_transpose_item(p->in[I_WOC], DM, Wout, 512, 1024, scr, r, lane); continue; } r -= T_WOUT;
        if (r < T_GG1) { p0_transpose_item(p->in[I_GG1], 128, Win, 1024, 4608, scr, r, lane); continue; } r -= T_GG1;
        if (r < 4 * T_L1) { const int q = r / T_L1; r -= q * T_L1;
            const float* src = (q < 2 ? p->in[I_DW1] : p->in[I_IA1]) + (size_t)(q & 1) * 1024 * 64;
            p0_transpose_item(src, 64, Win, 1024, 4608 + 256 * (q + 1), scr, r, lane); continue; } r -= 4 * T_L1;
        if (r < T_GG2) { p0_transpose_item(p->in[I_GG2], 512, B2, 256, 0, scr, r, lane); continue; } r -= T_GG2;
        { const int q = r / T_L2; r -= q * T_L2;
            const float* src = (q < 2 ? p->in[I_DW2] : p->in[I_IA2]) + (size_t)(q & 1) * 64 * 512;
            p0_transpose_item(src, 512, B2, 256, 512 * (q + 1), scr, r, lane); }
    }
    const v4u z = (v4u){0u, 0u, 0u, 0u};
    for (int it = gw; it < 5 * 256; it += NGW) { const int l = it >> 8, rr = it & 255; const int real = (l == 0) ? 128 : 64;
        if (rr >= real) { GAS v4u* dst = (GAS v4u*)(Win + (size_t)(4608 + l * 256 + rr) * 1024); dst[lane] = z; dst[64 + lane] = z; } }
    for (int it = gw; it < 2560; it += NGW) { const int real = (it < 512) ? 128 : 64;
        if (lane * 4 >= real) *(GAS v2u*)(B2 + (size_t)it * 256 + lane * 4) = (v2u){0u, 0u}; }
}

__device__ __forceinline__ void p1_norm1(KPtr p, int gw, int NGW, int lane) {
    const float* MOD = (const float*)(p->ws + WS_MOD); bf16* XN = (bf16*)(p->ws + WS_XN); const float* ng = p->in[I_N1G];
    for (int mi = gw; mi < NTOK; mi += NGW) { const int m = (NGW == 2048) ? ((mi & 255) + 1024 * ((mi >> 8) & 7) + 256 * (mi >> 11)) : mi;

        const float* xr = (m < NCTX) ? p->in[I_XP] + (size_t)m * DM : p->in[I_XS] + (size_t)(m - NCTX) * DM;
        const float* md = MOD + cond_of(m) * 6144;
        f32x4 v[4]; float s = 0.f;
#pragma unroll
        for (int j = 0; j < 4; ++j) { v[j] = ((const f32x4*)xr)[lane + 64 * j]; s += (v[j][0] * v[j][0] + v[j][1] * v[j][1]) + (v[j][2] * v[j][2] + v[j][3] * v[j][3]); }
        const float rstd = rsqrtf(wave_sum(s) * (1.f / DM) + 1e-6f);
        GAS v2u* o8 = (GAS v2u*)(XN + (size_t)m * DM) + lane;
#pragma unroll
        for (int j = 0; j < 4; ++j) { const int c = 4 * (lane + 64 * j);
            const f32x4 g = *(const f32x4*)(ng + c), sh = *(const f32x4*)(md + c), sc = *(const f32x4*)(md + 1024 + c);
            const f32x4 y = v[j] * rstd * g * (sc + 1.0f) + sh;
            o8[64 * j] = (v2u){pk2(y[0], y[1]), pk2(y[2], y[3])}; }
    }
}
__device__ __forceinline__ void p7_res_norm2(KPtr p, int gw, int NGW, int lane) {
    const float* MOD = (const float*)(p->ws + WS_MOD); bf16* XN = (bf16*)(p->ws + WS_XN); const float* ng = p->in[I_N2G];
    const bf16* P0 = (const bf16*)(p->ws + WS_PART); const bf16* P1 = P0 + (size_t)NTOK * DM;
    for (int mi = gw; mi < NTOK; mi += NGW) { const int m = (NGW == 2048) ? ((mi & 255) + 1024 * ((mi >> 8) & 7) + 256 * (mi >> 11)) : mi;

        const float* xr = (m < NCTX) ? p->in[I_XP] + (size_t)m * DM : p->in[I_XS] + (size_t)(m - NCTX) * DM;
        const float* md = MOD + cond_of(m) * 6144;
        f32x4 v[4]; float s = 0.f;
#pragma unroll
        for (int j = 0; j < 4; ++j) { const int c = 4 * (lane + 64 * j);
            const f32x4 x = *(const f32x4*)(xr + c), g1 = *(const f32x4*)(md + 2048 + c); const v2u aw = *(const v2u*)(P0 + (size_t)m * DM + c), bw = *(const v2u*)(P1 + (size_t)m * DM + c);
            const f32x4 a = (f32x4){bflo(aw.x), bfhi(aw.x), bflo(aw.y), bfhi(aw.y)}, b = (f32x4){bflo(bw.x), bfhi(bw.x), bflo(bw.y), bfhi(bw.y)};
            v[j] = x + g1 * (a + b);
            *(f32x4*)(p->out + (size_t)m * DM + c) = v[j];
            s += (v[j][0] * v[j][0] + v[j][1] * v[j][1]) + (v[j][2] * v[j][2] + v[j][3] * v[j][3]); }
        const float rstd = rsqrtf(wave_sum(s) * (1.f / DM) + 1e-6f);
        GAS v2u* o8 = (GAS v2u*)(XN + (size_t)m * DM) + lane;
#pragma unroll
        for (int j = 0; j < 4; ++j) { const int c = 4 * (lane + 64 * j);
            const f32x4 g = *(const f32x4*)(ng + c), sh = *(const f32x4*)(md + 3072 + c), sc = *(const f32x4*)(md + 4096 + c);
            const f32x4 y = v[j] * rstd * g * (sc + 1.0f) + sh;
            o8[64 * j] = (v2u){pk2(y[0], y[1]), pk2(y[2], y[3])}; }
    }
}
__device__ __forceinline__ void p12_final(KPtr p, int gw, int NGW, int lane) {
    const float* MOD = (const float*)(p->ws + WS_MOD); const float* fg = p->in[I_FG];
    const bf16* P0 = (const bf16*)(p->ws + WS_PART); const bf16* P1 = P0 + (size_t)NTOK * DM;
    for (int mi = gw; mi < NTOK; mi += NGW) { const int m = (NGW == 2048) ? ((mi & 255) + 1024 * ((mi >> 8) & 7) + 256 * (mi >> 11)) : mi;

        const float* md = MOD + cond_of(m) * 6144;
        f32x4 v[4]; float s = 0.f;
#pragma unroll
        for (int j = 0; j < 4; ++j) { const int c = 4 * (lane + 64 * j);
            const f32x4 x = *(const f32x4*)(p->out + (size_t)m * DM + c), g2 = *(const f32x4*)(md + 5120 + c); const v2u aw = *(const v2u*)(P0 + (size_t)m * DM + c), bw = *(const v2u*)(P1 + (size_t)m * DM + c);
            const f32x4 a = (f32x4){bflo(aw.x), bfhi(aw.x), bflo(aw.y), bfhi(aw.y)}, b = (f32x4){bflo(bw.x), bfhi(bw.x), bflo(bw.y), bfhi(bw.y)};
            v[j] = x + g2 * (a + b);
            s += (v[j][0] * v[j][0] + v[j][1] * v[j][1]) + (v[j][2] * v[j][2] + v[j][3] * v[j][3]); }
        const float rstd = rsqrtf(wave_sum(s) * (1.f / DM) + 1e-6f);
#pragma unroll
        for (int j = 0; j < 4; ++j) { const int c = 4 * (lane + 64 * j);
            *(f32x4*)(p->out + (size_t)m * DM + c) = v[j] * rstd * *(const f32x4*)(fg + c); }
    }
}
__device__ __forceinline__ void load8(const float* p, float (&o)[8]) { const f32x4 a = *(const f32x4*)p, b = *(const f32x4*)(p + 4); o[0] = a[0]; o[1] = a[1]; o[2] = a[2]; o[3] = a[3]; o[4] = b[0]; o[5] = b[1]; o[6] = b[2]; o[7] = b[3]; }
__device__ __forceinline__ void store8bf(bf16* p, const float (&v)[8]) { v4u w; w.x = pk2(v[0], v[1]); w.y = pk2(v[2], v[3]); w.z = pk2(v[4], v[5]); w.w = pk2(v[6], v[7]); *(GAS v4u*)p = w; }
typedef short bf16x8v __attribute__((ext_vector_type(8)));
typedef float f32x16 __attribute__((ext_vector_type(16)));
#define MFMA32(a, b, c) __builtin_amdgcn_mfma_f32_32x32x16_bf16(a, b, c, 0, 0, 0)
__device__ __forceinline__ bf16x8v ldfrag(const LAS unsigned char* base, int row_stride, int row, int col) { return *(const LAS bf16x8v*)(base + row * row_stride + col * 2); }
__device__ __forceinline__ int trow(int reg, int half) { return (reg & 3) + 8 * (reg >> 2) + 4 * half; }
__device__ __forceinline__ bf16x8v pack_acc(const f32x16& x, int s) {
    v4u w; w.x = pk2(x[8 * s], x[8 * s + 1]); w.y = pk2(x[8 * s + 2], x[8 * s + 3]); w.z = pk2(x[8 * s + 4], x[8 * s + 5]); w.w = pk2(x[8 * s + 6], x[8 * s + 7]);
    return __builtin_bit_cast(bf16x8v, w);
}
__device__ __forceinline__ int rec_off_s(int fbase, int rr, int cc) { const int s = cc >> 4, o = cc & 15, hh = (o >> 2) & 1, j = 4 * (o >> 3) + (o & 3); return (fbase + s) * 1024 + (32 * hh + rr) * 16 + j * 2; }
__device__ __forceinline__ int rec_off_n(int fbase, int rr, int ii) { const int s = ii >> 4, o = ii & 15, hh = o >> 3, j = o & 7; return (fbase + s) * 1024 + (32 * hh + rr) * 16 + j * 2; }
constexpr int P1_WAVE_LDS = 32768;
constexpr int P1_AT = 0, P1_BT = 4608, P1_RT = 9216, P1_KT = 13824, P1_BTT = 18432, P1_NBR = 23552, P1_WT = 26112, P1_GCL = 31232, P1_RN = 32256;
constexpr int P1_L = 4608, P1_NKA = 26112, P1_ZT = 4608, P1_RED0 = 0, P1_RED1 = 23552;

__device__ __forceinline__ void p4_decode(int task, int& b, int& h, int& n, int& m0, int& T) {
    if (task < 1024) { b = task >> 6; h = (task >> 3) & 7; n = task & 7; m0 = b * 256; T = 256; }
    else { const int t2 = task - 1024; b = t2 >> 9; h = (t2 >> 6) & 7; n = t2 & 63; m0 = NCTX + b * 2048; T = 2048; }
}
template <int D>
__device__ __forceinline__ void p4_pass1(KPtr p, LAS unsigned char* wl, int task) {
    int lane; PG8_LANE(lane);
    int b, h, n, m0, T; p4_decode(task, b, h, n, m0, T);
    const bf16* RKV = (const bf16*)(p->ws + WS_RKV);
    const int c = h * 64 + lane, mb = m0 + 32 * n;
    const bool has_prev = n > 0, has_next = (32 * n + 32) < T;
    float kraw[34];
    {   const bf16* srck = RKV + (size_t)mb * 1536 + 512 + c;
        kraw[0] = has_prev ? bf1(srck[-1536]) : 0.f;
        int eo = 0;
#pragma unroll
        for (int i = 0; i < 32; ++i) { kraw[i + 1] = bf1(srck[eo]); eo += 1536; asm volatile("" : "+v"(eo)); }
        kraw[33] = has_next ? bf1(srck[eo]) : 0.f; }
    __builtin_amdgcn_sched_barrier(0);
    float lw[32], al[32];
    {   const int fr0 = lane & 31, fh0 = lane >> 5;
        const bf16* A2p = (const bf16*)(p->ws + WS_A2) + (size_t)(mb + fr0) * 1280 + 8 * fh0;
        const bf16* B2p = (const bf16*)(p->ws + WS_B2) + (size_t)(h * 64 + fr0) * 256 + 8 * fh0;
        const float w0c = p->in[I_DW0][D * 512 + c], a0c = p->in[I_IA0][D * 512 + c];
#pragma unroll
        for (int which = 0; which < (D == 0 ? 3 : 2); ++which) {
            const int l = (which == 0) ? 1 + D : (which == 1) ? 3 + D : 0, nk = (which == 2) ? 8 : 4;
            f32x16 c0, c1;
#pragma unroll
            for (int e = 0; e < 16; ++e) { c0[e] = 0.f; c1[e] = 0.f; }
#pragma unroll
            for (int s4 = 0; s4 < nk; ++s4) { const bf16x8v a = *(const bf16x8v*)(A2p + 256 * l + 16 * s4);
                const bf16x8v b0 = *(const bf16x8v*)(B2p + (size_t)(l * 512) * 256 + 16 * s4), b1 = *(const bf16x8v*)(B2p + (size_t)(l * 512 + 32) * 256 + 16 * s4);
                c0 = MFMA32(a, b0, c0); c1 = MFMA32(a, b1, c1); }
#pragma unroll
            for (int e = 0; e < 16; ++e) {
                const auto sw = __builtin_amdgcn_permlane32_swap(__float_as_uint(c0[e]), __float_as_uint(c1[e]), false, false);
                const float x0 = __uint_as_float(sw[0]), x1 = __uint_as_float(sw[1]);
                const int t0 = trow(e, 0), t1 = trow(e, 1);
                if (which == 0) { lw[t0] = -0.6065306597126334f * sigm(w0c + x0); lw[t1] = -0.6065306597126334f * sigm(w0c + x1); }
                else if (which == 1) { al[t0] = sigm(a0c + x0); al[t1] = sigm(a0c + x1); }
                else { bf16* Gp = (bf16*)((unsigned char*)p->out + DO_G) + (size_t)mb * 512 + c; Gp[(size_t)t0 * 512] = (bf16)(pk2(x0, 0.f) & 0xffffu); Gp[(size_t)t1 * 512] = (bf16)(pk2(x1, 0.f) & 0xffffu); }
            }
        }
    }
    __builtin_amdgcn_sched_barrier(0);
    {   const float mp = p->in[I_MUP][512 + c], mn = p->in[I_MUN][512 + c], kkw = p->in[I_KK][c];
        LAS float* red = (LAS float*)(wl + P1_RED0);
#pragma unroll
        for (int i = 0; i < 32; ++i) { const float u = (kraw[i + 1] + (kraw[i] - kraw[i + 1]) * mp + (kraw[i + 2] - kraw[i + 1]) * mn) * kkw; red[i * 68 + lane] = u * u; }
        asm volatile("" ::: "memory");
        const int ri = lane & 31, hf = lane >> 5; float ssum = 0.f;
#pragma unroll
        for (int q = 0; q < 8; ++q) { const f32x4 x = *(const LAS f32x4*)(red + ri * 68 + hf * 32 + 4 * q); ssum += (x[0] + x[1]) + (x[2] + x[3]); }
        ssum += __int_as_float(__builtin_amdgcn_ds_bpermute((lane ^ 32) << 2, __float_as_int(ssum)));
        if (lane < 32) ((LAS float*)(wl + P1_RN))[lane] = rsqrtf(fmaxf(ssum, 1e-24f));
    }
    asm volatile("" ::: "memory");
    float gC;
    {   const float kaw = p->in[I_KA][c], rkw = p->in[I_RK][c], kkw = p->in[I_KK][c];
        const float mpr = p->in[I_MUP][c], mnr = p->in[I_MUN][c], mpk = p->in[I_MUP][512 + c], mnk = p->in[I_MUN][512 + c], mpv = p->in[I_MUP][1024 + c], mnv = p->in[I_MUN][1024 + c];
        LAS bf16* lAT = (LAS bf16*)(wl + P1_AT); LAS bf16* lBT = (LAS bf16*)(wl + P1_BT); LAS bf16* lRT = (LAS bf16*)(wl + P1_RT); LAS bf16* lKT = (LAS bf16*)(wl + P1_KT);
        LAS float* red1 = (LAS float*)(wl + P1_RED1); const LAS float* rnl = (const LAS float*)(wl + P1_RN);
        const int j0 = D ? 31 : 0;
        const bf16* src = RKV + (size_t)(mb + j0) * 1536 + c; const bf16* srcv = src + 1024;
        bf16* VN = (bf16*)((unsigned char*)p->out + DO_V) + (size_t)mb * 512 + c;
        bf16* VT = (bf16*)((unsigned char*)p->out + DO_VT) + (size_t)m0 * 512 + (size_t)h * 64 * T + (size_t)lane * T + 32 * n;
        const bool has_behind = D ? has_next : has_prev, has_ahead = D ? has_prev : has_next;
        constexpr int stp = D ? -1536 : 1536;
        float rb = has_behind ? bf1(src[-stp]) : 0.f, kb = has_behind ? bf1(src[-stp + 512]) : 0.f, vb = has_behind ? bf1(srcv[-stp]) : 0.f;
        float rc = bf1(src[0]), kc = bf1(src[512]), vc = bf1(srcv[0]);
        float Lc = 0.f, gprev = 1.f; float btp[8], vtp[8];
        int eo = 0, vo = 0;
        float nra[8], nka[8], nva[8];
#define P1_LOAD_GROUP(g_) do { _Pragma("unroll") for (int u_ = 0; u_ < 8; ++u_) { const int s_ = 8 * (g_) + u_; \
            eo += stp; asm volatile("" : "+v"(eo)); const bool ha_ = (s_ < 31) || has_ahead; \
            nra[u_] = ha_ ? bf1(src[eo]) : 0.f; nka[u_] = ha_ ? bf1(src[eo + 512]) : 0.f; nva[u_] = ha_ ? bf1(srcv[eo]) : 0.f; } } while (0)
        P1_LOAD_GROUP(0);
#pragma unroll
        for (int g8 = 0; g8 < 4; ++g8) {
            float cra[8], cka[8], cva[8];
#pragma unroll
            for (int u = 0; u < 8; ++u) { cra[u] = nra[u]; cka[u] = nka[u]; cva[u] = nva[u]; }
            if (g8 < 3) P1_LOAD_GROUP(g8 + 1);
#pragma unroll
            for (int u = 0; u < 8; ++u) {
                const int s = 8 * g8 + u, j = D ? 31 - s : s;
                const float lwj = lw[j], alj = al[j], ra = cra[u], ka = cka[u], va = cva[u];
                const float rp_ = D ? ra : rb, rn_ = D ? rb : ra, kp_ = D ? ka : kb, kn_ = D ? kb : ka, vp_ = D ? va : vb, vn_ = D ? vb : va;
                const float rj = rc + (rp_ - rc) * mpr + (rn_ - rc) * mnr, kj = kc + (kp_ - kc) * mpk + (kn_ - kc) * mnk, vj = vc + (vp_ - vc) * mpv + (vn_ - vc) * mnv;
                const float kkj = kj * kkw * rnl[j];
                Lc += lwj;
                const float g = __expf(Lc), gi = __expf(-Lc);
                const float kd = kj * (1.f + (alj - 1.f) * kaw), bb = kkj * alj;
                const float at = -kkj * gprev;
                const float rt = rj * g, bt = bb * gi, kt = kd * gi;
                lAT[s * 72 + lane] = (bf16)(pk2(at, 0.f) & 0xffffu); lBT[s * 72 + lane] = (bf16)(pk2(bt, 0.f) & 0xffffu);
                lRT[s * 72 + lane] = (bf16)(pk2(rt, 0.f) & 0xffffu); lKT[s * 72 + lane] = (bf16)(pk2(kt, 0.f) & 0xffffu);
                btp[u] = bt;
                red1[j * 68 + lane] = rj * kd * rkw;
                if (D == 0) { VN[vo] = (bf16)(pk2(vj, 0.f) & 0xffffu); vo += 512; asm volatile("" : "+v"(vo)); vtp[u] = vj; }
                gprev = g; rb = rc; kb = kc; vb = vc; rc = ra; kc = ka; vc = va;
            }
            { v4u w; w.x = pk2(btp[0], btp[1]); w.y = pk2(btp[2], btp[3]); w.z = pk2(btp[4], btp[5]); w.w = pk2(btp[6], btp[7]); *(LAS v4u*)(wl + P1_BTT + lane * 80 + g8 * 16) = w; }
            if (D == 0) { v4u w; w.x = pk2(vtp[0], vtp[1]); w.y = pk2(vtp[2], vtp[3]); w.z = pk2(vtp[4], vtp[5]); w.w = pk2(vtp[6], vtp[7]); *(GAS v4u*)(VT + 8 * g8) = w; }
            __builtin_amdgcn_sched_barrier(0);
        }
#undef P1_LOAD_GROUP
        gC = gprev;
    }
    asm volatile("" ::: "memory");
    {   LAS float* red = (LAS float*)(wl + P1_RED1);
        const int ri = lane & 31, hf = lane >> 5; float ssum = 0.f;
#pragma unroll
        for (int q = 0; q < 8; ++q) { const f32x4 x = *(const LAS f32x4*)(red + ri * 68 + hf * 32 + 4 * q); ssum += (x[0] + x[1]) + (x[2] + x[3]); }
        ssum += __int_as_float(__builtin_amdgcn_ds_bpermute((lane ^ 32) << 2, __float_as_int(ssum)));
        if (lane < 32) ((float*)((unsigned char*)p->out + DO_DOT))[(size_t)D * NTOK * 8 + (size_t)(mb + lane) * 8 + h] = ssum;
    }
    asm volatile("" ::: "memory");
    const int fr = lane & 31, fh = lane >> 5;
    f32x16 nab, nka, nbr, nkr;
#pragma unroll
    for (int e = 0; e < 16; ++e) { nab[e] = 0.f; nka[e] = 0.f; nbr[e] = 0.f; nkr[e] = 0.f; }
    { bf16x8v fa[4], fb[4], fR[4], fk[4];
#pragma unroll
        for (int s4 = 0; s4 < 4; ++s4) { fa[s4] = ldfrag(wl + P1_AT, 144, fr, 16 * s4 + 8 * fh); fb[s4] = ldfrag(wl + P1_BT, 144, fr, 16 * s4 + 8 * fh);
            fR[s4] = ldfrag(wl + P1_RT, 144, fr, 16 * s4 + 8 * fh); fk[s4] = ldfrag(wl + P1_KT, 144, fr, 16 * s4 + 8 * fh); }
#pragma unroll
        for (int s4 = 0; s4 < 4; ++s4) { nab = MFMA32(fa[s4], fb[s4], nab); nka = MFMA32(fa[s4], fk[s4], nka); nbr = MFMA32(fR[s4], fb[s4], nbr); nkr = MFMA32(fk[s4], fR[s4], nkr); }
    }
    { LAS float* lL = (LAS float*)(wl + P1_L); LAS float* lN = (LAS float*)(wl + P1_NKA); LAS bf16* lB = (LAS bf16*)(wl + P1_NBR);
#pragma unroll
        for (int e = 0; e < 16; ++e) { const int t = trow(e, fh), i = fr;
            const float vab = (i < t) ? nab[e] : 0.f, vka = (i < t) ? nka[e] : 0.f, vbr = (i <= t) ? nbr[e] : 0.f; nkr[e] = (t <= i) ? nkr[e] : 0.f;
            lL[t * 32 + i] = vab; lN[t * 33 + i] = vka; lB[t * 40 + i] = (bf16)(pk2(vbr, 0.f) & 0xffffu); } }
    asm volatile("" ::: "memory");
    float W[32], Z[32];
    { int dep = 0; asm volatile("" : "+v"(dep));
#pragma unroll
        for (int t = 0; t < 32; ++t) {
            if (t >= 2) asm volatile("" : "+v"(dep) : "v"(W[t - 2]), "v"(Z[t - 2]));
            const LAS float* lL = (const LAS float*)(wl + P1_L) + dep; const LAS float* lN = (const LAS float*)(wl + P1_NKA) + dep; const LAS bf16* lAT = (const LAS bf16*)(wl + P1_AT) + dep;
            float aw = bf1(lAT[t * 72 + lane]), az = lN[t * 33 + fr], aw2 = 0.f, az2 = 0.f;
#pragma unroll
            for (int i4 = 0; i4 * 4 < t; ++i4) { const f32x4 l4 = *(const LAS f32x4*)(lL + t * 32 + 4 * i4);
#pragma unroll
                for (int e = 0; e < 4; ++e) { const int i = 4 * i4 + e; if (i < t) { if (e & 1) { aw2 += l4[e] * W[i]; az2 += l4[e] * Z[i]; } else { aw += l4[e] * W[i]; az += l4[e] * Z[i]; } } } }
            W[t] = aw + aw2; Z[t] = az + az2;
        } }
    asm volatile("" ::: "memory");
#pragma unroll
    for (int q = 0; q < 4; ++q) { v4u w; w.x = pk2(W[8 * q], W[8 * q + 1]); w.y = pk2(W[8 * q + 2], W[8 * q + 3]); w.z = pk2(W[8 * q + 4], W[8 * q + 5]); w.w = pk2(W[8 * q + 6], W[8 * q + 7]); *(LAS v4u*)(wl + P1_WT + lane * 80 + 16 * q) = w; }
    if (lane < 32) {
#pragma unroll
        for (int q = 0; q < 4; ++q) { v4u w; w.x = pk2(Z[8 * q], Z[8 * q + 1]); w.y = pk2(Z[8 * q + 2], Z[8 * q + 3]); w.z = pk2(Z[8 * q + 4], Z[8 * q + 5]); w.w = pk2(Z[8 * q + 6], Z[8 * q + 7]); *(LAS v4u*)(wl + P1_ZT + lane * 80 + 16 * q) = w; } }
    ((LAS float*)(wl + P1_GCL))[lane] = gC;
    asm volatile("" ::: "memory");
    const int wt = task * 2 + D;
    unsigned char* rec = p->ws + (wt < 2048 ? WS_RECA + (size_t)wt * REC_BYTES : WS_RECB + (size_t)(wt - 2048) * REC_BYTES);
    ((float*)(p->ws + WS_GC))[(size_t)wt * 64 + lane] = gC;
    const LAS float* lG = (const LAS float*)(wl + P1_GCL);
    bf16x8v fnb[2], fzt[2];
#pragma unroll
    for (int s2 = 0; s2 < 2; ++s2) { fnb[s2] = ldfrag(wl + P1_NBR, 80, fr, 16 * s2 + 8 * fh); fzt[s2] = ldfrag(wl + P1_ZT, 80, fr, 16 * s2 + 8 * fh); }
    unsigned char* recl = rec + lane * 16;
    __builtin_amdgcn_sched_barrier(0);
    { f32x16 acc = nkr;
#pragma unroll
        for (int s2 = 0; s2 < 2; ++s2) acc = MFMA32(fzt[s2], fnb[s2], acc);
        *(GAS bf16x8v*)(recl + 16 * 1024) = pack_acc(acc, 0); *(GAS bf16x8v*)(recl + 17 * 1024) = pack_acc(acc, 1); }
#pragma unroll
    for (int a2 = 0; a2 < 2; ++a2) {
        __builtin_amdgcn_sched_barrier(0);
        bf16x8v fbt[2];
#pragma unroll
        for (int s2 = 0; s2 < 2; ++s2) fbt[s2] = ldfrag(wl + P1_BTT, 80, 32 * a2 + fr, 16 * s2 + 8 * fh);
        const float gcl = lG[32 * a2 + fr];
        { f32x16 acc; const LAS bf16* lKT = (const LAS bf16*)(wl + P1_KT);
#pragma unroll
            for (int e = 0; e < 16; ++e) acc[e] = bf1(lKT[trow(e, fh) * 72 + 32 * a2 + fr]);
#pragma unroll
            for (int s2 = 0; s2 < 2; ++s2) acc = MFMA32(fzt[s2], fbt[s2], acc);
#pragma unroll
            for (int e = 0; e < 16; ++e) acc[e] *= gcl;
            *(GAS bf16x8v*)(recl + (8 + 2 * a2) * 1024) = pack_acc(acc, 0); *(GAS bf16x8v*)(recl + (9 + 2 * a2) * 1024) = pack_acc(acc, 1); }
#pragma unroll
        for (int kt = 0; kt < 2; ++kt) { __builtin_amdgcn_sched_barrier(0); f32x16 acc;
#pragma unroll
            for (int e = 0; e < 16; ++e) acc[e] = 0.f;
#pragma unroll
            for (int s2 = 0; s2 < 2; ++s2) acc = MFMA32(ldfrag(wl + P1_WT, 80, 32 * kt + fr, 16 * s2 + 8 * fh), fbt[s2], acc);
#pragma unroll
            for (int e = 0; e < 16; ++e) acc[e] *= gcl;
            *(GAS bf16x8v*)(recl + (a2 * 4 + 2 * kt) * 1024) = pack_acc(acc, 0); *(GAS bf16x8v*)(recl + (a2 * 4 + 2 * kt + 1) * 1024) = pack_acc(acc, 1); }
    }
#pragma unroll
    for (int kt = 0; kt < 2; ++kt) { __builtin_amdgcn_sched_barrier(0); f32x16 acc; const LAS bf16* lRT = (const LAS bf16*)(wl + P1_RT);
#pragma unroll
        for (int e = 0; e < 16; ++e) acc[e] = bf1(lRT[fr * 72 + 32 * kt + trow(e, fh)]);
#pragma unroll
        for (int s2 = 0; s2 < 2; ++s2) acc = MFMA32(ldfrag(wl + P1_WT, 80, 32 * kt + fr, 16 * s2 + 8 * fh), fnb[s2], acc);
        *(GAS bf16x8v*)(recl + (12 + 2 * kt) * 1024) = pack_acc(acc, 0); *(GAS bf16x8v*)(recl + (13 + 2 * kt) * 1024) = pack_acc(acc, 1); }
    asm volatile("" ::: "memory");
}
__device__ __forceinline__ void p4_conv_item(KPtr p, LAS unsigned char* lds, int item, int tid) {
    const int wave = __builtin_amdgcn_readfirstlane(tid >> 6), lane = tid & 63;
    const bf16* PB = (const bf16*)(p->ws + WS_PB); bf16* RC = (bf16*)(p->ws + WS_RC);
    const int t0 = item * 32;
    int lo, hi; if (t0 < NCTX) { lo = t0 & ~255; hi = lo + 256; } else { lo = t0 & ~63; hi = lo + 64; }
    LAS bf16* U = (LAS bf16*)lds;
    LAS float* CWL = (LAS float*)(lds + 62 * 1024);
    for (int e = tid; e < 62 * 64; e += 512) {
        const int r = e >> 6, ch = (e & 63) * 8, tok = t0 - 15 + r;
        v4u w = (v4u){0u, 0u, 0u, 0u};
        if (tok >= lo && tok < hi) { float a[8], g[8]; unpack8(*(const v4u*)(PB + (size_t)tok * 3072 + ch), a); unpack8(*(const v4u*)(PB + (size_t)tok * 3072 + 512 + ch), g);
#pragma unroll
            for (int i = 0; i < 8; ++i) a[i] *= sigm(g[i]);
            w.x = pk2(a[0], a[1]); w.y = pk2(a[2], a[3]); w.z = pk2(a[4], a[5]); w.w = pk2(a[6], a[7]); }
        *(LAS v4u*)(U + r * 512 + ch) = w;
    }
    for (int e = tid; e < 31 * 128; e += 512) ((LAS f32x4*)CWL)[e] = ((const f32x4*)p->in[I_CW])[e];
    __syncthreads();
    const int c = 8 * lane;
    float cb[8], lg[8], lb[8]; load8(p->in[I_CB] + c, cb); load8(p->in[I_CLG] + c, lg); load8(p->in[I_CLB] + c, lb);
    {
        float acc[4][8];
#pragma unroll
        for (int tt = 0; tt < 4; ++tt)
#pragma unroll
            for (int e = 0; e < 8; ++e) acc[tt][e] = cb[e];
#pragma unroll 2
        for (int j = 0; j < 31; ++j) {
            const f32x4 w0 = *(const LAS f32x4*)(CWL + j * 512 + c), w1 = *(const LAS f32x4*)(CWL + j * 512 + c + 4);
#pragma unroll
            for (int tt = 0; tt < 4; ++tt) { float uv[8]; unpack8(*(const LAS v4u*)(U + (wave * 4 + tt + j) * 512 + c), uv);
#pragma unroll
                for (int e = 0; e < 4; ++e) { acc[tt][e] += uv[e] * w0[e]; acc[tt][4 + e] += uv[4 + e] * w1[e]; } }
        }
#pragma unroll
        for (int tt = 0; tt < 4; ++tt) {
            float s = 0.f;
#pragma unroll
            for (int e = 0; e < 8; ++e) s += acc[tt][e];
            const float mean = wave_sum(s) * (1.f / 512.f); float q = 0.f;
#pragma unroll
            for (int e = 0; e < 8; ++e) { acc[tt][e] -= mean; q += acc[tt][e] * acc[tt][e]; }
            const float rstd = rsqrtf(wave_sum(q) * (1.f / 512.f) + 1e-5f);
            float o[8];
#pragma unroll
            for (int e = 0; e < 8; ++e) { const float un = acc[tt][e] * rstd * lg[e] + lb[e]; o[e] = un * sigm(un); }
            store8bf(RC + (size_t)(t0 + wave * 4 + tt) * 1024 + 512 + c, o);
        }
    }
    __syncthreads();
}
__device__ __forceinline__ void p6_post(KPtr p, int gw, int NGW, int lane) {
    const float* YF = (const float*)(p->ws + WS_YF); const float* YB = (const float*)(p->ws + WS_YB);
    const bf16* VN = (const bf16*)((const unsigned char*)p->out + DO_V); const float* DOT = (const float*)((const unsigned char*)p->out + DO_DOT); const bf16* G = (const bf16*)((const unsigned char*)p->out + DO_G); bf16* RC = (bf16*)(p->ws + WS_RC);
    const int c = 8 * lane;
    float lg[8], lb[8]; load8(p->in[I_LNXG] + c, lg); load8(p->in[I_LNXB] + c, lb);
    for (int mi = gw; mi < NTOK; mi += NGW) { const int m = (NGW == 2048) ? ((mi & 255) + 1024 * ((mi >> 8) & 7) + 256 * (mi >> 11)) : mi;

        float a[8], b[8]; load8(YF + (size_t)m * 512 + c, a); load8(YB + (size_t)m * 512 + c, b);
        float s = 0.f;
#pragma unroll
        for (int e = 0; e < 8; ++e) { a[e] += b[e]; s += a[e]; }
        const float mu = oct_sum(s) * (1.f / 64.f); float q = 0.f;
#pragma unroll
        for (int e = 0; e < 8; ++e) { a[e] -= mu; q += a[e] * a[e]; }
        const float rstd = rsqrtf(oct_sum(q) * (1.f / 64.f) + 64e-5f);
        float vv[8], g[8]; unpack8(*(const v4u*)(VN + (size_t)m * 512 + c), vv); unpack8(*(const v4u*)(G + (size_t)m * 512 + c), g);
        const float dt = DOT[(size_t)m * 8 + (lane >> 3)] + DOT[(size_t)NTOK * 8 + (size_t)m * 8 + (lane >> 3)];
#pragma unroll
        for (int e = 0; e < 8; ++e) a[e] = (a[e] * rstd * lg[e] + lb[e] + dt * vv[e]) * g[e];
        store8bf(RC + (size_t)m * 1024 + c, a);
    }
}
__device__ __forceinline__ bf16x8v p2_vfrag(const bf16* vt, int s2, int hf, int d) {
    v4u w;
    if (d == 0) { const v2u lo = *(const v2u*)(vt + 16 * s2 + 4 * hf), hi = *(const v2u*)(vt + 16 * s2 + 8 + 4 * hf); w.x = lo.x; w.y = lo.y; w.z = hi.x; w.w = hi.y; }
    else { const v2u lo = *(const v2u*)(vt + 28 - 16 * s2 - 4 * hf), hi = *(const v2u*)(vt + 20 - 16 * s2 - 4 * hf);
        w.x = __builtin_amdgcn_alignbit(lo.y, lo.y, 16); w.y = __builtin_amdgcn_alignbit(lo.x, lo.x, 16); w.z = __builtin_amdgcn_alignbit(hi.y, hi.y, 16); w.w = __builtin_amdgcn_alignbit(hi.x, hi.x, 16); }
    return __builtin_bit_cast(bf16x8v, w);
}
__device__ __forceinline__ void p5_pass2_wave(KPtr p, int X) {
    int lane; PG8_LANE(lane);
    const int r = lane & 31, hf = lane >> 5;
    const int chain = X >> 1, wq = X & 1;
    int b, h, d, m0, T, tbase; const float* s0 = nullptr; float* sfin = nullptr;
    if (chain < 32) { b = chain >> 4; h = (chain >> 1) & 7; d = chain & 1; m0 = NCTX + b * 2048; T = 2048; tbase = 1024 + (b * 8 + h) * 64; s0 = (d == 0 ? p->in[I_SF] : p->in[I_SB]) + (size_t)(b * 8 + h) * 4096; }
    else { const int cc = chain - 32; b = cc >> 4; h = (cc >> 1) & 7; d = cc & 1; m0 = b * 256; T = 256; tbase = (b * 8 + h) * 8; sfin = p->out + (size_t)NTOK * DM + (size_t)d * 524288 + (size_t)(b * 8 + h) * 4096; }
    const int nc = T / 32, vcol = 32 * wq + r;
    const bf16* VT = (const bf16*)((const unsigned char*)p->out + DO_VT) + (size_t)m0 * 512 + (size_t)h * 64 * T + (size_t)vcol * T;
    float* Y = (float*)(p->ws + (d == 0 ? WS_YF : WS_YB)) + (size_t)m0 * 512 + h * 64 + vcol;
    const float* GC = (const float*)(p->ws + WS_GC);
    f32x16 S0t, S1t;
    if (s0) {
#pragma unroll
        for (int g = 0; g < 4; ++g) { const f32x4 x0 = *(const f32x4*)(s0 + (size_t)vcol * 64 + 8 * g + 4 * hf), x1 = *(const f32x4*)(s0 + (size_t)vcol * 64 + 32 + 8 * g + 4 * hf);
#pragma unroll
            for (int e = 0; e < 4; ++e) { S0t[4 * g + e] = x0[e]; S1t[4 * g + e] = x1[e]; } }
    } else {
#pragma unroll
        for (int e = 0; e < 16; ++e) { S0t[e] = 0.f; S1t[e] = 0.f; }
    }
    bf16x8v fGP[2][4], fKP[2][2], fRP[4], fPP[2], fV[2]; f32x4 gam[2][4];
#define P2_REC(n_) (p->ws + ((((tbase + (n_)) * 2 + d) < 2048) ? WS_RECA + (size_t)((tbase + (n_)) * 2 + d) * REC_BYTES : WS_RECB + (size_t)((tbase + (n_)) * 2 + d - 2048) * REC_BYTES) + lane * 16)
#define P2_LOAD_Y(n_) do { const unsigned char* rb_ = P2_REC(n_); _Pragma("unroll") for (int s4 = 0; s4 < 4; ++s4) fRP[s4] = *(const bf16x8v*)(rb_ + (12 + s4) * 1024); \
        _Pragma("unroll") for (int s2 = 0; s2 < 2; ++s2) fPP[s2] = *(const bf16x8v*)(rb_ + (16 + s2) * 1024); } while (0)
#define P2_LOAD_S(n_) do { const unsigned char* rb_ = P2_REC(n_); const float* gc_ = GC + (size_t)((tbase + (n_)) * 2 + d) * 64 + 4 * hf; \
        _Pragma("unroll") for (int a = 0; a < 2; ++a) { _Pragma("unroll") for (int s4 = 0; s4 < 4; ++s4) fGP[a][s4] = *(const bf16x8v*)(rb_ + (a * 4 + s4) * 1024); \
            _Pragma("unroll") for (int s2 = 0; s2 < 2; ++s2) fKP[a][s2] = *(const bf16x8v*)(rb_ + (8 + a * 2 + s2) * 1024); \
            _Pragma("unroll") for (int g = 0; g < 4; ++g) gam[a][g] = *(const f32x4*)(gc_ + 32 * a + 8 * g); } \
        _Pragma("unroll") for (int s2 = 0; s2 < 2; ++s2) fV[s2] = p2_vfrag(VT + 32 * (n_), s2, hf, d); } while (0)
    { const int n0 = d ? nc - 1 : 0; P2_LOAD_Y(n0); P2_LOAD_S(n0); }
    for (int ci = 0; ci < nc; ++ci) {
        const int n = d ? nc - 1 - ci : ci, nn = d ? n - 1 : n + 1; const bool more = ci + 1 < nc;
        bf16x8v sb[4]; sb[0] = pack_acc(S0t, 0); sb[1] = pack_acc(S0t, 1); sb[2] = pack_acc(S1t, 0); sb[3] = pack_acc(S1t, 1);
        f32x16 y;
#pragma unroll
        for (int e = 0; e < 16; ++e) y[e] = 0.f;
#pragma unroll
        for (int s4 = 0; s4 < 4; ++s4) y = MFMA32(fRP[s4], sb[s4], y);
#pragma unroll
        for (int s2 = 0; s2 < 2; ++s2) y = MFMA32(fPP[s2], fV[s2], y);
        if (more) P2_LOAD_Y(nn);
        { float* yo = Y + (size_t)(32 * n) * 512;
#pragma unroll
            for (int e = 0; e < 16; ++e) yo[(size_t)(d ? 31 - trow(e, hf) : trow(e, hf)) * 512] = y[e]; }
        f32x16 n0t, n1t;
#pragma unroll
        for (int g = 0; g < 4; ++g)
#pragma unroll
            for (int e = 0; e < 4; ++e) { n0t[4 * g + e] = S0t[4 * g + e] * gam[0][g][e]; n1t[4 * g + e] = S1t[4 * g + e] * gam[1][g][e]; }
#pragma unroll
        for (int s4 = 0; s4 < 4; ++s4) { n0t = MFMA32(fGP[0][s4], sb[s4], n0t); n1t = MFMA32(fGP[1][s4], sb[s4], n1t); }
#pragma unroll
        for (int s2 = 0; s2 < 2; ++s2) { n0t = MFMA32(fKP[0][s2], fV[s2], n0t); n1t = MFMA32(fKP[1][s2], fV[s2], n1t); }
        S0t = n0t; S1t = n1t;
        if (more) P2_LOAD_S(nn);
    }
    if (sfin) {
#pragma unroll
        for (int g = 0; g < 4; ++g) { *(f32x4*)(sfin + (size_t)vcol * 64 + 8 * g + 4 * hf) = (f32x4){S0t[4 * g], S0t[4 * g + 1], S0t[4 * g + 2], S0t[4 * g + 3]};
            *(f32x4*)(sfin + (size_t)vcol * 64 + 32 + 8 * g + 4 * hf) = (f32x4){S1t[4 * g], S1t[4 * g + 1], S1t[4 * g + 2], S1t[4 * g + 3]}; }
    }
#undef P2_REC
#undef P2_LOAD_Y
#undef P2_LOAD_S
}

constexpr int P2R_NS = 5, P2R_SLOT = 25600, P2R_GAM = 18432, P2R_V = 19456, P2R_SB = 21504, P2R_FLAGS = P2R_NS * P2R_SLOT, P2R_NH = 6;
__device__ __forceinline__ void p2_chain_decode(int chain, KPtr p, int& b, int& h, int& d, int& m0, int& T, int& tbase) {
    if (chain < 32) { b = chain >> 4; h = (chain >> 1) & 7; d = chain & 1; m0 = NCTX + b * 2048; T = 2048; tbase = 1024 + (b * 8 + h) * 64; }
    else { const int cc = chain - 32; b = cc >> 4; h = (cc >> 1) & 7; d = cc & 1; m0 = b * 256; T = 256; tbase = (b * 8 + h) * 8; }
}
__device__ __forceinline__ void p5_ring_helper(KPtr p, LAS unsigned char* lds, int X, int hidx) {
    int lane; PG8_LANE(lane);
    const int r = lane & 31, hf = lane >> 5, chain = X >> 1, wq = X & 1;
    int b, h, d, m0, T, tbase; p2_chain_decode(chain, p, b, h, d, m0, T, tbase);
    const int nc = T / 32, vcol = 32 * wq + r;
    const bf16* VT = (const bf16*)((const unsigned char*)p->out + DO_VT) + (size_t)m0 * 512 + (size_t)h * 64 * T + (size_t)vcol * T;
    const float* GC = (const float*)(p->ws + WS_GC);
    volatile LAS unsigned* flags = (volatile LAS unsigned*)(lds + P2R_FLAGS);
    for (int m = hidx; m < nc; m += P2R_NH) {
        const int n = d ? nc - 1 - m : m, wt = (tbase + n) * 2 + d, slot = m % P2R_NS;
        const unsigned char* rb = p->ws + (wt < 2048 ? WS_RECA + (size_t)wt * REC_BYTES : WS_RECB + (size_t)(wt - 2048) * REC_BYTES) + lane * 16;
        bf16x8v f[18];
#pragma unroll
        for (int i = 0; i < 18; ++i) f[i] = *(const bf16x8v*)(rb + i * 1024);
        const float gv = GC[(size_t)wt * 64 + lane];
        const bf16x8v v0 = p2_vfrag(VT + 32 * n, 0, hf, d), v1 = p2_vfrag(VT + 32 * n, 1, hf, d);
        while ((int)flags[5] < m - P2R_NS + 1 || (int)flags[13] < m - P2R_NS + 1) __builtin_amdgcn_s_sleep(2);
        LAS unsigned char* sl = lds + slot * P2R_SLOT;
#pragma unroll
        for (int i = 0; i < 18; ++i) *(LAS bf16x8v*)(sl + i * 1024 + lane * 16) = f[i];
        ((LAS float*)(sl + P2R_GAM))[lane] = gv;
        *(LAS bf16x8v*)(sl + P2R_V + lane * 16) = v0; *(LAS bf16x8v*)(sl + P2R_V + 1024 + lane * 16) = v1;
        asm volatile("s_waitcnt lgkmcnt(0)" ::: "memory");
        if (lane == 0) flags[slot] = (unsigned)(m + 1);
    }
}
__device__ __forceinline__ void p5_ring_ywave(KPtr p, LAS unsigned char* lds, int X) {
    int lane; PG8_LANE(lane);
    const int r = lane & 31, hf = lane >> 5, chain = X >> 1, wq = X & 1;
    int b, h, d, m0, T, tbase; p2_chain_decode(chain, p, b, h, d, m0, T, tbase);
    const int nc = T / 32, vcol = 32 * wq + r;
    float* Y = (float*)(p->ws + (d == 0 ? WS_YF : WS_YB)) + (size_t)m0 * 512 + h * 64 + vcol;
    volatile LAS unsigned* flags = (volatile LAS unsigned*)(lds + P2R_FLAGS);
    for (int m = 0; m < nc; ++m) {
        const int n = d ? nc - 1 - m : m, slot = m % P2R_NS;
        while (flags[8 + slot] != (unsigned)(m + 1)) __builtin_amdgcn_s_sleep(1);
        asm volatile("" ::: "memory");
        const LAS unsigned char* sl = lds + slot * P2R_SLOT + lane * 16;
        f32x16 y;
#pragma unroll
        for (int e = 0; e < 16; ++e) y[e] = 0.f;
#pragma unroll
        for (int s4 = 0; s4 < 4; ++s4) y = MFMA32(*(const LAS bf16x8v*)(sl + (12 + s4) * 1024), *(const LAS bf16x8v*)(sl + P2R_SB + s4 * 1024), y);
        y = MFMA32(*(const LAS bf16x8v*)(sl + 16 * 1024), *(const LAS bf16x8v*)(sl + P2R_V), y); y = MFMA32(*(const LAS bf16x8v*)(sl + 17 * 1024), *(const LAS bf16x8v*)(sl + P2R_V + 1024), y);
        asm volatile("s_waitcnt lgkmcnt(0)" ::: "memory");
        if (lane == 0) flags[13] = (unsigned)(m + 1);
        { float* yo = Y + (size_t)(32 * n) * 512;
#pragma unroll
            for (int e = 0; e < 16; ++e) yo[(size_t)(d ? 31 - trow(e, hf) : trow(e, hf)) * 512] = y[e]; }
    }
}
__device__ __forceinline__ void p5_ring_consumer(KPtr p, LAS unsigned char* lds, int X) {
    int lane; PG8_LANE(lane);
    const int r = lane & 31, hf = lane >> 5, chain = X >> 1, wq = X & 1;
    int b, h, d, m0, T, tbase; p2_chain_decode(chain, p, b, h, d, m0, T, tbase);
    const float* s0 = (chain < 32) ? (d == 0 ? p->in[I_SF] : p->in[I_SB]) + (size_t)(b * 8 + h) * 4096 : nullptr;
    float* sfin = (chain < 32) ? nullptr : p->out + (size_t)NTOK * DM + (size_t)d * 524288 + (size_t)(b * 8 + h) * 4096;
    const int nc = T / 32, vcol = 32 * wq + r;
    volatile LAS unsigned* flags = (volatile LAS unsigned*)(lds + P2R_FLAGS);
    f32x16 S0t, S1t;
    if (s0) {
#pragma unroll
        for (int g = 0; g < 4; ++g) { const f32x4 x0 = *(const f32x4*)(s0 + (size_t)vcol * 64 + 8 * g + 4 * hf), x1 = *(const f32x4*)(s0 + (size_t)vcol * 64 + 32 + 8 * g + 4 * hf);
#pragma unroll
            for (int e = 0; e < 4; ++e) { S0t[4 * g + e] = x0[e]; S1t[4 * g + e] = x1[e]; } }
    } else {
#pragma unroll
        for (int e = 0; e < 16; ++e) { S0t[e] = 0.f; S1t[e] = 0.f; }
    }
    bf16x8v gpA[8], kpA[4], v0A, v1A, gpB[8], kpB[4], v0B, v1B;
#define C_WAIT(m_) do { while (flags[(m_) % P2R_NS] != (unsigned)((m_) + 1)) __builtin_amdgcn_s_sleep(1); asm volatile("" ::: "memory"); } while (0)
#define C_LOAD(m_, GP_, KP_, V0_, V1_) do { const LAS unsigned char* sl_ = lds + ((m_) % P2R_NS) * P2R_SLOT + lane * 16; \
        _Pragma("unroll") for (int i_ = 0; i_ < 8; ++i_) GP_[i_] = *(const LAS bf16x8v*)(sl_ + i_ * 1024); \
        _Pragma("unroll") for (int i_ = 0; i_ < 4; ++i_) KP_[i_] = *(const LAS bf16x8v*)(sl_ + (8 + i_) * 1024); \
        V0_ = *(const LAS bf16x8v*)(sl_ + P2R_V); V1_ = *(const LAS bf16x8v*)(sl_ + P2R_V + 1024); } while (0)
#define C_STEP(m_, GP_, KP_, V0_, V1_, NGP_, NKP_, NV0_, NV1_) do { const int slot_ = (m_) % P2R_NS; \
        bf16x8v sb_[4]; sb_[0] = pack_acc(S0t, 0); sb_[1] = pack_acc(S0t, 1); sb_[2] = pack_acc(S1t, 0); sb_[3] = pack_acc(S1t, 1); \
        { LAS unsigned char* slw_ = lds + slot_ * P2R_SLOT + P2R_SB + lane * 16; _Pragma("unroll") for (int s4 = 0; s4 < 4; ++s4) *(LAS bf16x8v*)(slw_ + s4 * 1024) = sb_[s4]; } \
        asm volatile("" ::: "memory"); if (lane == 0) flags[8 + slot_] = (unsigned)((m_) + 1); \
        f32x16 n0_, n1_; { const LAS float* gl_ = (const LAS float*)(lds + slot_ * P2R_SLOT + P2R_GAM) + 4 * hf; \
            _Pragma("unroll") for (int g = 0; g < 4; ++g) { const f32x4 g0 = *(const LAS f32x4*)(gl_ + 8 * g), g1 = *(const LAS f32x4*)(gl_ + 32 + 8 * g); \
                _Pragma("unroll") for (int e = 0; e < 4; ++e) { n0_[4 * g + e] = S0t[4 * g + e] * g0[e]; n1_[4 * g + e] = S1t[4 * g + e] * g1[e]; } } } \
        asm volatile("s_waitcnt lgkmcnt(0)" ::: "memory"); if (lane == 0) flags[5] = (unsigned)((m_) + 1);     \
        _Pragma("unroll") for (int s4 = 0; s4 < 4; ++s4) { n0_ = MFMA32(GP_[s4], sb_[s4], n0_); n1_ = MFMA32(GP_[4 + s4], sb_[s4], n1_); } \
        if ((m_) + 1 < nc) { C_WAIT((m_) + 1); C_LOAD((m_) + 1, NGP_, NKP_, NV0_, NV1_); }     \
        n0_ = MFMA32(KP_[0], V0_, n0_); n0_ = MFMA32(KP_[1], V1_, n0_); n1_ = MFMA32(KP_[2], V0_, n1_); n1_ = MFMA32(KP_[3], V1_, n1_); \
        S0t = n0_; S1t = n1_; } while (0)
    C_WAIT(0); C_LOAD(0, gpA, kpA, v0A, v1A);
    for (int m = 0; m < nc; m += 2) {
        C_STEP(m, gpA, kpA, v0A, v1A, gpB, kpB, v0B, v1B);
        C_STEP(m + 1, gpB, kpB, v0B, v1B, gpA, kpA, v0A, v1A);
    }
#undef C_WAIT
#undef C_LOAD
#undef C_STEP
    if (sfin) {
#pragma unroll
        for (int g = 0; g < 4; ++g) { *(f32x4*)(sfin + (size_t)vcol * 64 + 8 * g + 4 * hf) = (f32x4){S0t[4 * g], S0t[4 * g + 1], S0t[4 * g + 2], S0t[4 * g + 3]};
            *(f32x4*)(sfin + (size_t)vcol * 64 + 32 + 8 * g + 4 * hf) = (f32x4){S1t[4 * g], S1t[4 * g + 1], S1t[4 * g + 2], S1t[4 * g + 3]}; }
    }
}
__global__ void __launch_bounds__(NWAVES * 64, 2) fwd_kernel(Params p_unused) {
    extern __shared__ __attribute__((aligned(16))) unsigned char lds_raw[];
    LAS unsigned char* lds = (LAS unsigned char*)lds_raw;
    volatile LAS unsigned* MISC = (volatile LAS unsigned*)(lds + MISC_OFF);
    const int G = gridDim.x, bx = blockIdx.x, vcu = (G % 8 == 0) ? (bx % 8) * (G / 8) + bx / 8 : bx;
    const int NGW = G * NWAVES;
    const int wave0 = __builtin_amdgcn_readfirstlane(threadIdx.x >> 6);
    for (int u = threadIdx.x; u < (LDS_BYTES - LDSCTL_OFF) / 4; u += NWAVES * 64) ((LAS unsigned*)(lds + LDSCTL_OFF))[u] = 0u;
#define TID_VARS KPtr p = kp0; asm volatile("" : "+s"(p)); unsigned char* ws = p->ws; (void)ws; int lane; PG8_LANE(lane); const int wave = wave0, tid = wave0 * 64 + lane, gw = vcu * NWAVES + wave; (void)tid; (void)gw;
    __syncthreads();
    const KPtr kp0 = (KPtr)__builtin_amdgcn_kernarg_segment_ptr();
    const int lo = kp0->ph_lo, hi = kp0->ph_hi, dupm = kp0->dupmask;
    const bool multi = (hi - lo) > 1;
    XcdBarrier bar; bar.bar = (unsigned*)(kp0->ws + WS_CTL) + CW_BAR; bar.x = 0; bar.st = nullptr;
    if (multi) bar = xcd_barrier_post((unsigned*)(kp0->ws + WS_CTL) + CW_BAR, MISC + 8);
#ifndef PHMASK
#define PHMASK 0xffff
#endif
#define IN(k) (((PHMASK >> (k)) & 1) && lo <= (k) && (k) < hi)
#ifndef DUPMASK
#define DUPMASK 0
#endif
#define REP(k) for (int rep_ = 0; rep_ < 1 + ((dupm >> (k)) & 1); ++rep_)
#ifndef BARDUP
#define BARDUP 0
#endif
#define SEAM(k) do { if (IN(k) && IN((k) + 1)) { xcd_barrier(bar, wave0); if (BARDUP) xcd_barrier(bar, wave0); } } while (0)
    if (IN(0)) REP(0) { TID_VARS p0_prologue(p, lds, vcu, G, tid); }
    if (IN(1)) REP(1) { TID_VARS
        if (IN(0)) {
            if (tid == 0) { unsigned* cnt = (unsigned*)(ws + WS_CTL) + CW_MODCNT; unsigned sp = 0;
                while (__hip_atomic_load(cnt, __ATOMIC_RELAXED, __HIP_MEMORY_SCOPE_AGENT) < 192u * (1u + ((dupm >> 0) & 1))) { __builtin_amdgcn_s_sleep(2); if (++sp > (1u << 22)) break; }
                __builtin_amdgcn_fence(__ATOMIC_ACQUIRE, "agent"); asm volatile("s_waitcnt vmcnt(0)" ::: "memory"); }
            __syncthreads();
        }
        p1_norm1(p, gw, NGW, lane); } SEAM(1);
    if (IN(2)) REP(2) {
        KPtr p = kp0; asm volatile("" : "+s"(p)); unsigned char* ws = p->ws;
        typedef pg8::Gemm<1024, 1024, 1024, 1 << 20, 0, 1 << 20, 0> GT; GT g{(const bf16*)(ws + WS_XN), (const bf16*)(ws + WS_WIN)};
        pg8::StaticOrder S; S.init(NTOK, N_IN, G, bx);
        EpiG1 E{(bf16*)(ws + WS_RKV), (bf16*)(ws + WS_PB), (bf16*)(ws + WS_A2)};
        pg8::gemm_phase<EpiG1, pg8::StaticOrder, GT, true, true>(lds, g, S, E, wave0);
    } SEAM(2);
    if (IN(4)) REP(4) { TID_VARS
        if (wave < 4) { LAS unsigned char* wl = lds + wave * P1_WAVE_LDS;
            for (int W = vcu * 4 + wave; W < 4096; W += G * 4) { if (W & 1) p4_pass1<1>(p, wl, W >> 1); else p4_pass1<0>(p, wl, W >> 1); } }
        __syncthreads();
    } SEAM(4);
    if (IN(5)) REP(5) { KPtr p = kp0; asm volatile("" : "+s"(p));
        if (G == 256) {
            if (vcu < 64) {
                if (wave0 == 0) { int l_; PG8_LANE(l_); if (l_ < 16) ((volatile LAS unsigned*)(lds + P2R_FLAGS))[l_] = 0u; }
                __syncthreads();
                if (wave0 == 0) p5_ring_consumer(p, lds, vcu); else if (wave0 == 1) p5_ring_ywave(p, lds, vcu); else p5_ring_helper(p, lds, vcu, wave0 - 2);
                __syncthreads();
            } else {
                if (wave0 < 3) { const int Xc = (vcu - 64) * 3 + wave0; if (Xc < 512) p5_pass2_wave(p, 64 + Xc); }
                else { int lane; PG8_LANE(lane); LAS float* scr = (LAS float*)(lds + wave0 * 16384);
                    bf16* W1 = (bf16*)(p->ws + WS_W1); bf16* W2 = (bf16*)(p->ws + WS_W2);
                    for (int it = (vcu - 64) * 5 + (wave0 - 3); it < 4096; it += 192 * 5) { if (it < 2048) p0_transpose_item(p->in[I_W1], DFF, W1, 1024, 0, scr, it, lane); else p0_transpose_item(p->in[I_W2], DM, W2, 4096, 0, scr, it - 2048, lane); } }
            }
        } else {
            for (int X = wave0 * G + vcu; X < 576; X += NWAVES * G) p5_pass2_wave(p, X);
            { int lane; PG8_LANE(lane); LAS float* scr = (LAS float*)(lds + wave0 * 16384); bf16* W1 = (bf16*)(p->ws + WS_W1); bf16* W2 = (bf16*)(p->ws + WS_W2);
              for (int it = vcu * NWAVES + wave0; it < 4096; it += G * NWAVES) { if (it < 2048) p0_transpose_item(p->in[I_W1], DFF, W1, 1024, 0, scr, it, lane); else p0_transpose_item(p->in[I_W2], DM, W2, 4096, 0, scr, it - 2048, lane); } }
        }
    } SEAM(5);
    if (IN(6)) REP(6) { TID_VARS for (int it = vcu; it < NTOK / 32; it += G) p4_conv_item(p, lds, it, tid); p6_post(p, gw, NGW, lane); } SEAM(6);
    if (IN(7)) REP(7) {
        KPtr p = kp0; asm volatile("" : "+s"(p)); unsigned char* ws = p->ws;
        typedef pg8::Gemm<1024, 512, 512, 4, 512, 1 << 20, 0> GT; GT g{(const bf16*)(ws + WS_RC), (const bf16*)(ws + WS_WOUT)};
        pg8::StaticOrder S; S.init(NTOK, 2048, G, bx);
        EpiG3 E{(const bf16*)(ws + WS_PB), (bf16*)(ws + WS_GM)};
        pg8::gemm_phase<EpiG3, pg8::StaticOrder, GT, true, true>(lds, g, S, E, wave0);
    } SEAM(7);
    if (IN(8)) REP(8) {
        KPtr p = kp0; asm volatile("" : "+s"(p)); unsigned char* ws = p->ws;
        typedef pg8::Gemm<2048, 1024, 1024, 4, 1024, 4, 0> GT; GT g{(const bf16*)(ws + WS_GM), (const bf16*)(ws + WS_WO)};
        pg8::StaticOrder S; S.init(NTOK, 2048, G, bx);
        EpiPart E{(bf16*)(ws + WS_PART)};
        pg8::gemm_phase<EpiPart, pg8::StaticOrder, GT, true, true>(lds, g, S, E, wave0);
    } SEAM(8);
    if (IN(9)) REP(9) { TID_VARS p7_res_norm2(p, gw, NGW, lane); } SEAM(9);
    if (IN(10)) REP(10) {
        KPtr p = kp0; asm volatile("" : "+s"(p)); unsigned char* ws = p->ws;
        typedef pg8::Gemm<1024, 1024, 1024, 1 << 20, 0, 1 << 20, 0> GT; GT g{(const bf16*)(ws + WS_XN), (const bf16*)(ws + WS_W1)};
        pg8::StaticOrder S; S.init(NTOK, DFF, G, bx);
        EpiG5 E{(bf16*)(ws + WS_H)};
        pg8::gemm_phase<EpiG5, pg8::StaticOrder, GT, true, true>(lds, g, S, E, wave0);
    } SEAM(10);
    if (IN(11)) REP(11) {
        KPtr p = kp0; asm volatile("" : "+s"(p)); unsigned char* ws = p->ws;
        typedef pg8::Gemm<4096, 4096, 2048, 4, 2048, 4, 2048> GT; GT g{(const bf16*)(ws + WS_H), (const bf16*)(ws + WS_W2)};
        pg8::StaticOrder S; S.init(NTOK, 2048, G, bx);
        EpiPart E{(bf16*)(ws + WS_PART)};
        pg8::gemm_phase<EpiPart, pg8::StaticOrder, GT, true, true>(lds, g, S, E, wave0);
    } SEAM(11);
    if (IN(12)) REP(12) { TID_VARS p12_final(p, gw, NGW, lane); }
#undef IN
#undef SEAM
}

extern "C" void kernel_launch(void* const* d_in, const int* in_sizes, int n_in, void* d_out, int out_size, void* d_ws, size_t ws_size, hipStream_t stream) {
    static int grid = 0;
    if (grid == 0) {
        if (n_in != 36 || ws_size < WS_END) { fprintf(stderr, "kernel_launch: unexpected n_in %d / ws %zu\n", n_in, ws_size); grid = -1; return; }
        int dev = 0, cus = 0, per_cu = 0;
        if (hipGetDevice(&dev) != hipSuccess || hipDeviceGetAttribute(&cus, hipDeviceAttributeMultiprocessorCount, dev) != hipSuccess) { grid = -1; return; }
        if (hipFuncSetAttribute((const void*)fwd_kernel, hipFuncAttributeMaxDynamicSharedMemorySize, LDS_BYTES) != hipSuccess) { fprintf(stderr, "kernel_launch: hipFuncSetAttribute failed\n"); grid = -1; return; }
        if (hipOccupancyMaxActiveBlocksPerMultiprocessor(&per_cu, (const void*)fwd_kernel, NWAVES * 64, LDS_BYTES) != hipSuccess || per_cu < 1)
            fprintf(stderr, "kernel_launch: occupancy query reports %d\n", per_cu);
        (void)hipGetLastError();
        grid = cus;
    }
    if (grid < 0) return;
    if (hipMemsetAsync((char*)d_ws + WS_CTL, 0, CTL_ZERO_BYTES, stream) != hipSuccess) { fprintf(stderr, "kernel_launch: memset failed\n"); return; }
    Params a{};
    for (int i = 0; i < 36; ++i) a.in[i] = (const float*)d_in[i];
    a.out = (float*)d_out; a.ws = (unsigned char*)d_ws; a.dupmask = DUPMASK;
#if MK_ONE_LAUNCH
    a.ph_lo = 0; a.ph_hi = NPH;
    hipLaunchKernelGGL(fwd_kernel, dim3(grid), dim3(NWAVES * 64), LDS_BYTES, stream, a);
#else
    for (int ph = 0; ph < NPH; ++ph) { a.ph_lo = ph; a.ph_hi = ph + 1; hipLaunchKernelGGL(fwd_kernel, dim3(grid), dim3(NWAVES * 64), LDS_BYTES, stream, a); }
#endif
    const hipError_t le = hipPeekAtLastError();
    if (le != hipSuccess) fprintf(stderr, "kernel_launch: launch failed: %s\n", hipGetErrorName(le));
}
```

```cpp
#include <hip/hip_runtime.h>
#include <cstdio>
#include <cstdint>
namespace pg8 {
#define PG8_LAS __attribute__((address_space(3)))
typedef unsigned short bf16_t;
typedef short bf16x8 __attribute__((ext_vector_type(8)));
typedef float f32x4 __attribute__((ext_vector_type(4)));
typedef unsigned u32x4 __attribute__((ext_vector_type(4)));
constexpr int BM = 256, BK = 64, HALF = 128, HTB = HALF * BK * 2  , STAGE_BYTES = 8 * HTB, NXCD = 8, WGM = 8;

__host__ __device__ __forceinline__ int lds_byte(int r, int c) { const int st = (r >> 4) * 2 + (c >> 5), rr = r & 15, cc = c & 31, ob = rr * 64 + cc * 2; return st * 1024 + (ob ^ (((ob >> 9) & 1) << 5)); }
__host__ __device__ __forceinline__ void stage_rc(int b, int& R, int& C) { const int st = b / 1024, sb = b % 1024, swz = sb ^ (((sb >> 9) & 1) << 5); R = (st >> 1) * 16 + swz / 64; C = (st & 1) * 32 + (swz % 64) / 2; }
__host__ __device__ __forceinline__ int perm32(int rho) { const int n = rho >> 4, i = rho & 15; return 8 * (i >> 2) + 4 * n + (i & 3); }

struct Unit { int pm, pn; };
template <int LDA, int LDB, int KK, int GA, int ACOFF, int GB, int BCOFF>
struct Gemm { const bf16_t* A; const bf16_t* Bt;
    static constexpr int lda = LDA, ldb = LDB, K = KK;
    __device__ __forceinline__ const char* aptr(const Unit& u) const { return (const char*)(A + (size_t)u.pm * BM * LDA + (size_t)(u.pn / GA) * ACOFF); }
    __device__ __forceinline__ const char* bptr(const Unit& u) const { return (const char*)(Bt + (size_t)(u.pn % GB) * BM * LDB + (size_t)(u.pn / GB) * BCOFF); }
};

struct StaticOrder {
    int nM, nN, nwg, G, c;
    __host__ __device__ void init(int M, int N, int G_, int c_) { nM = M / BM; nN = N / BM; nwg = nM * nN; G = G_; c = c_; }
    __host__ __device__ bool next(int i, Unit& u) const {
        const long L = (long)i * G + c; if (L >= nwg) return false;
        int wgid = (int)L; { const int q = nwg / NXCD, r = nwg % NXCD, xcd = wgid % NXCD, off = wgid / NXCD; wgid = (xcd < r ? xcd * (q + 1) : r * (q + 1) + (xcd - r) * q) + off; }
        const int nig = WGM * nN, gid = wgid / nig, fm = gid * WGM, gsz = (nM - fm) < WGM ? (nM - fm) : WGM;
        u.pm = fm + ((wgid % nig) % gsz); u.pn = (wgid % nig) / gsz; return true;
    }
    __device__ __forceinline__ void a_ready(const Unit&) const {}
    __device__ __forceinline__ void done(const Unit&) const {}
};
#define PG8_LANE(x) asm volatile("v_mbcnt_lo_u32_b32 %0, -1, 0\n\tv_mbcnt_hi_u32_b32 %0, -1, %0" : "=v"(x))
typedef __bf16 bf16n2 __attribute__((ext_vector_type(2)));
typedef float f32n2 __attribute__((ext_vector_type(2)));
__device__ __forceinline__ unsigned cvt_pk_bf16(float lo, float hi) { const f32n2 v = {lo, hi}; const bf16n2 b = __builtin_convertvector(v, bf16n2); return __builtin_bit_cast(unsigned, b); }

template <class Epi, class Sched, class GemmT, bool ALIGN_EPI = false, bool SP2 = false>
__device__ __forceinline__ void gemm_phase(PG8_LAS unsigned char* lds, const GemmT g, const Sched& S, const Epi& E, const int wid) {
    int lane; PG8_LANE(lane);
    const int tid = wid * 64 + lane, wr = wid >> 2, wc = wid & 3, fr = lane & 15, fq = lane >> 4;
    const int K = g.K, nt = K / BK;
    unsigned voffA[2], voffB[2];
#pragma unroll
    for (int i = 0; i < 2; ++i) { int R, C; stage_rc(tid * 16 + i * 8192, R, C); const int Rb = Epi::PERM ? ((R & ~31) + perm32(R & 31)) : R;
        voffA[i] = (unsigned)(R * g.lda + C) * 2u; voffB[i] = (unsigned)(Rb * g.ldb + C) * 2u; }
    const size_t kstep = (size_t)(BK * 2);
    const size_t hstepA = (size_t)HALF * g.lda * 2, hstepB = (size_t)HALF * g.ldb * 2;
    const unsigned ldsw = (unsigned)wid * 1024u;
    const int aoff = lds_byte(wr * 64 + fr, fq * 8), boff = lds_byte(wc * 32 + fr, fq * 8);
#define PG8_SA(b, h) (((b) * 2 + (h)) * HTB)
#define PG8_SB(b, h) ((4 + (b) * 2 + (h)) * HTB)
#define PG8_STAGE(bufoff, gbase, voff) do { _Pragma("unroll") for (int _i = 0; _i < 2; ++_i) \
        __builtin_amdgcn_global_load_lds((const unsigned*)((const char*)(gbase) + (voff)[_i]), (PG8_LAS unsigned*)(lds + (bufoff) + ldsw + _i * 8192), 16, 0, 0); } while (0)
#define PG8_LDA(dst, b, h) do { _Pragma("unroll") for (int m = 0; m < 4; ++m) _Pragma("unroll") for (int k = 0; k < 2; ++k) dst[m][k] = *(const PG8_LAS bf16x8*)(lds + PG8_SA(b, h) + aoff + m * 2048 + k * 1024); } while (0)
#define PG8_LDB(dst, b, h) do { _Pragma("unroll") for (int n = 0; n < 2; ++n) _Pragma("unroll") for (int k = 0; k < 2; ++k) dst[n][k] = *(const PG8_LAS bf16x8*)(lds + PG8_SB(b, h) + boff + n * 2048 + k * 1024); } while (0)
#define PG8_MMA(ai, bj, At, Bt) do { __builtin_amdgcn_s_setprio(1); _Pragma("unroll") for (int m = 0; m < 4; ++m) _Pragma("unroll") for (int n = 0; n < 2; ++n) _Pragma("unroll") for (int k = 0; k < 2; ++k) \
        acc[ai][bj][m][n] = __builtin_amdgcn_mfma_f32_16x16x32_bf16(Bt[n][k], At[m][k], acc[ai][bj][m][n], 0, 0, 0); __builtin_amdgcn_s_setprio(0); } while (0)
#define PG8_WAIT_V(n) asm volatile("s_waitcnt vmcnt(" #n ")" ::: "memory")
#define PG8_WAIT_L(n) asm volatile("s_waitcnt lgkmcnt(" #n ")" ::: "memory")
#define PG8_BAR __builtin_amdgcn_s_barrier()
#define PG8_SCHED __builtin_amdgcn_sched_barrier(0)
    Unit cur, nxt; int ui = 0;
    if (!S.next(0, cur)) return;
    f32x4 acc[2][2][4][2];
#pragma unroll
    for (int a = 0; a < 2; ++a)
#pragma unroll
        for (int b = 0; b < 2; ++b)
#pragma unroll
            for (int m = 0; m < 4; ++m)
#pragma unroll
                for (int n = 0; n < 2; ++n) acc[a][b][m][n] = (f32x4){0.f, 0.f, 0.f, 0.f};
    bf16x8 At[4][2], B0[2][2], B1[2][2];
    const char* cA = g.aptr(cur); const char* cB = g.bptr(cur);
    S.a_ready(cur);
    if constexpr (SP2) {
        PG8_STAGE(PG8_SB(0, 0), cB, voffB); PG8_STAGE(PG8_SB(0, 1), cB + hstepB, voffB); PG8_STAGE(PG8_SA(0, 0), cA, voffA); PG8_STAGE(PG8_SA(0, 1), cA + hstepA, voffA);
        if (wr == 1) PG8_BAR;
        PG8_WAIT_V(2); PG8_BAR;
        PG8_STAGE(PG8_SB(1, 0), cB + kstep, voffB); PG8_STAGE(PG8_SA(1, 0), cA + kstep, voffA); PG8_STAGE(PG8_SB(1, 1), cB + hstepB + kstep, voffB);
        PG8_WAIT_V(6); PG8_BAR;
    } else {
        PG8_STAGE(PG8_SB(0, 0), cB, voffB); PG8_STAGE(PG8_SA(0, 0), cA, voffA); PG8_STAGE(PG8_SB(0, 1), cB + hstepB, voffB); PG8_STAGE(PG8_SA(0, 1), cA + hstepA, voffA);
        if (wr == 1) PG8_BAR;
        PG8_WAIT_V(4); PG8_BAR;
        PG8_STAGE(PG8_SB(1, 0), cB + kstep, voffB); PG8_STAGE(PG8_SA(1, 0), cA + kstep, voffA); PG8_STAGE(PG8_SB(1, 1), cB + hstepB + kstep, voffB);
        PG8_WAIT_V(6); PG8_BAR;
    }
    for (;;) {
        const bool has_next = S.next(ui + 1, nxt);
        const char* nA = has_next ? g.aptr(nxt) : cA; const char* nB = has_next ? g.bptr(nxt) : cB;
        for (int t = 0; t < nt; t += 2) {
            const bool last = (t == nt - 2);
            const char* a1 = cA + (size_t)(t + 1) * kstep;
            const char* a2 = last ? nA : cA + (size_t)(t + 2) * kstep; const char* b2 = last ? nB : cB + (size_t)(t + 2) * kstep;
            const char* a3 = a2 + kstep; const char* b3 = b2 + kstep;
            if (last && has_next) S.a_ready(nxt);
            if constexpr (SP2) {
            PG8_LDB(B0, 0, 0); PG8_LDB(B1, 0, 1); PG8_SCHED; PG8_LDA(At, 0, 0); PG8_STAGE(PG8_SA(1, 1), a1 + hstepA, voffA);
            PG8_WAIT_V(8); PG8_WAIT_L(0); PG8_BAR; PG8_MMA(0, 0, At, B0); PG8_MMA(0, 1, At, B1); PG8_BAR; PG8_SCHED;
            PG8_LDA(At, 0, 1); PG8_STAGE(PG8_SB(0, 0), b2, voffB); PG8_STAGE(PG8_SB(0, 1), b2 + hstepB, voffB); PG8_STAGE(PG8_SA(0, 0), a2, voffA);
            PG8_WAIT_V(8); PG8_WAIT_L(0); PG8_BAR; PG8_MMA(1, 0, At, B0); PG8_MMA(1, 1, At, B1); PG8_BAR; PG8_SCHED;
            PG8_LDB(B0, 1, 0); PG8_LDB(B1, 1, 1); PG8_SCHED; PG8_LDA(At, 1, 0); PG8_STAGE(PG8_SA(0, 1), a2 + hstepA, voffA);
            PG8_WAIT_V(8); PG8_WAIT_L(0); PG8_BAR; PG8_MMA(0, 0, At, B0); PG8_MMA(0, 1, At, B1); PG8_BAR; PG8_SCHED;
            PG8_LDA(At, 1, 1); PG8_STAGE(PG8_SB(1, 0), b3, voffB); PG8_STAGE(PG8_SB(1, 1), b3 + hstepB, voffB); PG8_STAGE(PG8_SA(1, 0), a3, voffA);
            PG8_WAIT_V(8); PG8_WAIT_L(0); PG8_BAR; PG8_MMA(1, 0, At, B0); PG8_MMA(1, 1, At, B1); PG8_BAR; PG8_SCHED;
            } else {
            PG8_LDB(B0, 0, 0); PG8_SCHED; PG8_LDA(At, 0, 0); PG8_STAGE(PG8_SA(1, 1), a1 + hstepA, voffA);
            PG8_WAIT_L(8); PG8_BAR; PG8_WAIT_L(0); PG8_MMA(0, 0, At, B0); PG8_BAR; PG8_SCHED;
            PG8_LDB(B1, 0, 1); PG8_STAGE(PG8_SB(0, 0), b2, voffB);
            PG8_BAR; PG8_WAIT_L(0); PG8_MMA(0, 1, At, B1); PG8_BAR;
            PG8_LDA(At, 0, 1); PG8_STAGE(PG8_SA(0, 0), a2, voffA);
            PG8_BAR; PG8_WAIT_L(0); PG8_MMA(1, 0, At, B0); PG8_BAR; PG8_SCHED;
            PG8_STAGE(PG8_SB(0, 1), b2 + hstepB, voffB);
            PG8_WAIT_V(6); PG8_BAR; PG8_MMA(1, 1, At, B1); PG8_BAR;
            PG8_LDB(B0, 1, 0); PG8_SCHED; PG8_LDA(At, 1, 0); PG8_STAGE(PG8_SA(0, 1), a2 + hstepA, voffA);
            PG8_WAIT_L(8); PG8_BAR; PG8_WAIT_L(0); PG8_MMA(0, 0, At, B0); PG8_BAR; PG8_SCHED;
            PG8_LDB(B1, 1, 1); PG8_STAGE(PG8_SB(1, 0), b3, voffB);
            PG8_BAR; PG8_WAIT_L(0); PG8_MMA(0, 1, At, B1); PG8_BAR;
            PG8_LDA(At, 1, 1); PG8_STAGE(PG8_SA(1, 0), a3, voffA);
            PG8_BAR; PG8_WAIT_L(0); PG8_MMA(1, 0, At, B0); PG8_BAR; PG8_SCHED;
            PG8_STAGE(PG8_SB(1, 1), b3 + hstepB, voffB);
            PG8_WAIT_V(6); PG8_BAR; PG8_MMA(1, 1, At, B1); PG8_BAR;
            }
        }
        if constexpr (ALIGN_EPI) { if (wr == 0) PG8_BAR; }
        if constexpr (!Epi::AFTER_DRAIN) { int el; PG8_LANE(el); E(acc, cur, wr, wc, el & 15, el >> 4); S.done(cur); }
        if (!has_next) break;
#pragma unroll
        for (int a = 0; a < 2; ++a)
#pragma unroll
            for (int b = 0; b < 2; ++b)
#pragma unroll
                for (int m = 0; m < 4; ++m)
#pragma unroll
                    for (int n = 0; n < 2; ++n) acc[a][b][m][n] = (f32x4){0.f, 0.f, 0.f, 0.f};
        cur = nxt; cA = nA; cB = nB; ++ui;
        if constexpr (ALIGN_EPI) { if (wr == 1) PG8_BAR; }
    }
    PG8_WAIT_V(0);
    if constexpr (!ALIGN_EPI) { if (wr == 0) PG8_BAR; }
    PG8_BAR;
    if constexpr (Epi::AFTER_DRAIN) { E.fused(acc, cur, wr, wc, fr, fq, lds, wid, lane); S.done(cur); }
#undef PG8_SA
#undef PG8_SB
#undef PG8_STAGE
#undef PG8_LDA
#undef PG8_LDB
#undef PG8_MMA
#undef PG8_WAIT_V
#undef PG8_WAIT_L
#undef PG8_BAR
#undef PG8_SCHED
}
}

constexpr int NWAVES = 8;
constexpr int NTOK = 8192, NCTX = 4096, DM = 1024, RW = 512, NH = 8, HD = 64, DFF = 4096;
constexpr int N_IN = 5888;
constexpr int NPH = 13;
#ifndef MK_ONE_LAUNCH
#define MK_ONE_LAUNCH 1
#endif
constexpr size_t MiB = 1u << 20;
constexpr size_t WS_CTL = 0, CTL_ZERO_BYTES = 64 * 1024;
constexpr size_t WS_MOD = 1 * MiB;
constexpr size_t WS_WIN = 2 * MiB;
constexpr size_t WS_B2 = 14 * MiB;
constexpr size_t WS_WOUT = 16 * MiB;
constexpr size_t WS_WO = 18 * MiB;
constexpr size_t WS_W1 = 20 * MiB;
constexpr size_t WS_W2 = 28 * MiB;
constexpr size_t WS_XN = 36 * MiB;
constexpr size_t WS_A2 = 52 * MiB;
constexpr size_t WS_RKV = 72 * MiB;
constexpr size_t WS_PB = 120 * MiB;
constexpr size_t WS_WD = 168 * MiB;
constexpr size_t WS_AL = 200 * MiB;
constexpr size_t WS_RECB = 216 * MiB;
constexpr size_t WS_GC = 252 * MiB;
constexpr size_t WS_END = 256 * MiB;
constexpr size_t WS_RECA = 168 * MiB;
constexpr size_t REC_BYTES = 18432;
constexpr size_t WS_YF = WS_RKV, WS_YB = WS_RKV + 16 * MiB, WS_RC = WS_RKV + 32 * MiB;
constexpr size_t WS_GM = WS_RKV, WS_H = WS_RKV;
constexpr size_t WS_PART = 168 * MiB;
constexpr size_t DO_G = 0, DO_V = 8 * MiB, DO_VT = 16 * MiB, DO_DOT = 24 * MiB;
constexpr int CW_MODCNT = 512;
constexpr int CW_G3FLAG = 5120;
constexpr int CW_BAR = 1024;
constexpr int RING_BYTES = 131072;
constexpr int LDSCTL_OFF = RING_BYTES, MISC_OFF = LDSCTL_OFF + 320;
constexpr int LDS_BYTES = 147456;

#define GAS __attribute__((address_space(1)))
#define LAS __attribute__((address_space(3)))
typedef unsigned short bf16;
typedef unsigned v4u __attribute__((ext_vector_type(4)));
typedef unsigned v2u __attribute__((ext_vector_type(2)));
typedef float f32x4 __attribute__((ext_vector_type(4)));
#define LDS_WAIT() asm volatile("s_waitcnt lgkmcnt(0)" ::: "memory")
#define VM_WAIT() asm volatile("s_waitcnt vmcnt(0)" ::: "memory")
__device__ __forceinline__ unsigned pk2(float lo, float hi) { return pg8::cvt_pk_bf16(lo, hi); }
__device__ __forceinline__ float bflo(unsigned u) { return __uint_as_float(u << 16); }
__device__ __forceinline__ float bfhi(unsigned u) { return __uint_as_float(u & 0xffff0000u); }
__device__ __forceinline__ float bf1(bf16 u) { return __uint_as_float((unsigned)u << 16); }
__device__ __forceinline__ float sigm(float x) { return __builtin_amdgcn_rcpf(1.0f + __expf(-x)); }
__device__ __forceinline__ float tanh_fast(float x) { const float t = __expf(2.0f * x); return 1.0f - 2.0f * __builtin_amdgcn_rcpf(t + 1.0f); }
__device__ __forceinline__ v4u pack8(const f32x4 a, const f32x4 b) { v4u w; w.x = pk2(a[0], a[1]); w.y = pk2(a[2], a[3]); w.z = pk2(b[0], b[1]); w.w = pk2(b[2], b[3]); return w; }
__device__ __forceinline__ void unpack8(const v4u w, float (&o)[8]) { o[0] = bflo(w.x); o[1] = bfhi(w.x); o[2] = bflo(w.y); o[3] = bfhi(w.y); o[4] = bflo(w.z); o[5] = bfhi(w.z); o[6] = bflo(w.w); o[7] = bfhi(w.w); }
__device__ __forceinline__ float wave_sum(float v) {
#pragma unroll
    for (int o = 1; o < 64; o <<= 1) v += __shfl_xor(v, o);
    return v;
}
__device__ __forceinline__ float oct_sum(float v) { v += __shfl_xor(v, 1); v += __shfl_xor(v, 2); v += __shfl_xor(v, 4); return v; }

#define XB_TMO      128
#define XB_XCNT(j)  (256  + 64 * (j))
#define XB_XSUB(j)  (1280 + 64 * (j))
#define XB_XGEN(j)  (2304 + 64 * (j))
#define XB_TOP      3328
#define XB_TOPGEN   3392
#define XCD_BAR_WORDS 3456
#define XB_SPIN_CAP (1u << 18)
__device__ __forceinline__ unsigned xb_ld(unsigned* p)              { return __hip_atomic_load(p, __ATOMIC_RELAXED, __HIP_MEMORY_SCOPE_AGENT); }
__device__ __forceinline__ unsigned xb_add(unsigned* p, unsigned v) { return __hip_atomic_fetch_add(p, v, __ATOMIC_RELAXED, __HIP_MEMORY_SCOPE_AGENT); }
__device__ __forceinline__ unsigned xb_xcc_id() { return (unsigned)__builtin_amdgcn_s_getreg((3 << 11) | 20) & 0xFu; }
#define XB_SPIN(cond, bar) do { unsigned _sp = 0; while (cond) { __builtin_amdgcn_s_sleep(1); \
    if ((++_sp & 255u) == 0u) { if (xb_ld(&(bar)[XB_TMO])) break; if (_sp > XB_SPIN_CAP) { atomicAdd(&(bar)[XB_TMO], 1u); break; } } } } while (0)
struct XcdBarrier { unsigned* bar; unsigned x; volatile LAS unsigned* st; };
__device__ __forceinline__ XcdBarrier xcd_barrier_post(unsigned* bar, volatile LAS unsigned* st) {
    XcdBarrier b; b.bar = bar; b.x = xb_xcc_id(); b.st = st;
    if (threadIdx.x == 0) (void)xb_add(&bar[XB_XCNT(b.x)], 1u);
    return b;
}
__device__ __forceinline__ void xcd_barrier_complete(unsigned* bar, unsigned x, unsigned& nloc, unsigned& nx) {
    const unsigned G = gridDim.x * gridDim.y * gridDim.z;
    unsigned sum, cnt, mine, sp = 0u;
    for (;;) {
        sum = 0u; cnt = 0u; mine = 0u;
#pragma unroll
        for (unsigned j = 0; j < 16; ++j) { const unsigned c = xb_ld(&bar[XB_XCNT(j)]); sum += c; cnt += (c > 0u) ? 1u : 0u; mine = (j == x) ? c : mine; }
        if (sum == G) break;
        __builtin_amdgcn_s_sleep(1);
        if ((++sp & 255u) == 0u) { if (xb_ld(&bar[XB_TMO])) break; if (sp > XB_SPIN_CAP) { atomicAdd(&bar[XB_TMO], 1u); break; } }
    }
    nloc = mine > 0u ? mine : 1u; nx = cnt > 0u ? cnt : 1u;
}
__device__ __forceinline__ void xcd_barrier(const XcdBarrier& b, const int wave0) {
    asm volatile("s_waitcnt vmcnt(0)" ::: "memory");
    __syncthreads();
    int l_; PG8_LANE(l_);
    if (wave0 == 0 && l_ == 0) {
        unsigned* bar = b.bar;
        __builtin_amdgcn_s_waitcnt(0);
        unsigned nloc = b.st[0], nx = b.st[1];
        if (nloc == 0u) { xcd_barrier_complete(bar, b.x, nloc, nx); b.st[0] = nloc; b.st[1] = nx; }
        const unsigned old = xb_add(&bar[XB_XSUB(b.x)], 1u);
        const unsigned gen = old / nloc;
        if (old + 1u == (gen + 1u) * nloc) {
            __builtin_amdgcn_fence(__ATOMIC_RELEASE, "agent");
            asm volatile("s_waitcnt vmcnt(0)" ::: "memory");
            const unsigned og = xb_add(&bar[XB_TOP], 1u);
            const unsigned tg = og / nx;
            if (og + 1u == (tg + 1u) * nx) xb_add(&bar[XB_TOPGEN], 1u);
            else XB_SPIN(xb_ld(&bar[XB_TOPGEN]) == tg, bar);
            __builtin_amdgcn_fence(__ATOMIC_ACQUIRE, "agent");
            xb_add(&bar[XB_XGEN(b.x)], 1u);
            asm volatile("s_waitcnt vmcnt(0)" ::: "memory");
        } else {
            XB_SPIN(xb_ld(&bar[XB_XGEN(b.x)]) == gen, bar);
            __builtin_amdgcn_fence(__ATOMIC_ACQUIRE, "agent");
            asm volatile("s_waitcnt vmcnt(0)" ::: "memory");
        }
    }
    __syncthreads();
}

struct Params { const float* in[36]; float* out; unsigned char* ws; int ph_lo, ph_hi, dupmask, pad; };
enum { I_XP = 0, I_XS, I_SF, I_SB, I_C, I_CCTX, I_ADAW, I_ADAB, I_N1G, I_N2G, I_WIN, I_MUP, I_MUN, I_DW0, I_DW1, I_DW2, I_IA0, I_IA1, I_IA2, I_GG1, I_GG2,
       I_KK, I_KA, I_RK, I_LNXG, I_LNXB, I_WOR, I_CW, I_CB, I_CLG, I_CLB, I_WOC, I_WO, I_W1, I_W2, I_FG };

typedef const __attribute__((address_space(4))) Params* KPtr;
__device__ __forceinline__ int cond_of(int m) { return m < NCTX ? 0 : 1 + ((m - NCTX) >> 11); }

struct EpiG1 {
    static constexpr bool PERM = true, AFTER_DRAIN = false;
    bf16* RKV; bf16* PB; bf16* A2;
    __device__ __forceinline__ void operator()(const f32x4 (&acc)[2][2][4][2], const pg8::Unit& u, int wr, int wc, int fr, int fq) const {
        const int row0 = u.pm * 256 + wr * 64 + fr, colt = wc * 32 + 8 * fq;
        if (u.pn < 6) {
#pragma unroll
            for (int ai = 0; ai < 2; ++ai)
#pragma unroll
                for (int m = 0; m < 4; ++m) { bf16* rp = RKV + (size_t)(row0 + ai * 128 + m * 16) * 1536 + u.pn * 256 + colt;
#pragma unroll
                    for (int bj = 0; bj < 2; ++bj) *(v4u*)(rp + bj * 128) = pack8(acc[ai][bj][m][0], acc[ai][bj][m][1]); }
        } else if (u.pn < 18) {
#pragma unroll
            for (int ai = 0; ai < 2; ++ai)
#pragma unroll
                for (int m = 0; m < 4; ++m) { bf16* rp = PB + (size_t)(row0 + ai * 128 + m * 16) * 3072 + (u.pn - 6) * 256 + colt;
#pragma unroll
                    for (int bj = 0; bj < 2; ++bj) *(v4u*)(rp + bj * 128) = pack8(acc[ai][bj][m][0], acc[ai][bj][m][1]); }
        } else {
            const int l = u.pn - 18;
#pragma unroll
            for (int ai = 0; ai < 2; ++ai)
#pragma unroll
                for (int m = 0; m < 4; ++m) { bf16* rp = A2 + (size_t)(row0 + ai * 128 + m * 16) * 1280 + l * 256 + colt;
#pragma unroll
                    for (int bj = 0; bj < 2; ++bj) { f32x4 a = acc[ai][bj][m][0], b = acc[ai][bj][m][1];
                        if (l == 0) {
#pragma unroll
                            for (int e = 0; e < 4; ++e) { a[e] = sigm(a[e]); b[e] = sigm(b[e]); }
                        } else if (l <= 2) {
#pragma unroll
                            for (int e = 0; e < 4; ++e) { a[e] = tanh_fast(a[e]); b[e] = tanh_fast(b[e]); }
                        }
                        *(v4u*)(rp + bj * 128) = pack8(a, b); } }
        }
    }
};
struct EpiG2 {
    static constexpr bool PERM = true, AFTER_DRAIN = false;
    bf16* G; float* WD; bf16* AL; const float* w0; const float* a0;
    __device__ __forceinline__ void operator()(const f32x4 (&acc)[2][2][4][2], const pg8::Unit& u, int wr, int wc, int fr, int fq) const {
        const int row0 = u.pm * 256 + wr * 64 + fr, l = u.pn >> 1, cb = (u.pn & 1) * 256 + wc * 32 + 8 * fq;
#pragma unroll
        for (int bj = 0; bj < 2; ++bj) {
            const int c0 = cb + bj * 128;
            f32x4 o0 = (f32x4){0.f, 0.f, 0.f, 0.f}, o1 = o0;
            if (l >= 1 && l <= 2) { o0 = *(const f32x4*)(w0 + (l - 1) * 512 + c0); o1 = *(const f32x4*)(w0 + (l - 1) * 512 + c0 + 4); }
            if (l >= 3) { o0 = *(const f32x4*)(a0 + (l - 3) * 512 + c0); o1 = *(const f32x4*)(a0 + (l - 3) * 512 + c0 + 4); }
#pragma unroll
            for (int ai = 0; ai < 2; ++ai)
#pragma unroll
                for (int m = 0; m < 4; ++m) { const size_t ro = (size_t)(row0 + ai * 128 + m * 16) * 512 + c0;
                    f32x4 a = acc[ai][bj][m][0] + o0, b = acc[ai][bj][m][1] + o1;
                    if (l == 0) { *(v4u*)(G + ro) = pack8(a, b); }
                    else if (l <= 2) {
#pragma unroll
                        for (int e = 0; e < 4; ++e) { a[e] = -0.6065306597126334f * sigm(a[e]); b[e] = -0.6065306597126334f * sigm(b[e]); }
                        float* wp = WD + (size_t)(l - 1) * NTOK * 512 + ro; *(f32x4*)wp = a; *(f32x4*)(wp + 4) = b;
                    } else {
#pragma unroll
                        for (int e = 0; e < 4; ++e) { a[e] = sigm(a[e]); b[e] = sigm(b[e]); }
                        *(v4u*)(AL + (size_t)(l - 3) * NTOK * 512 + ro) = pack8(a, b);
                    } }
        }
    }
};
struct EpiG3 {
    static constexpr bool PERM = true, AFTER_DRAIN = false;
    const bf16* PB; bf16* GM;
    __device__ __forceinline__ void operator()(const f32x4 (&acc)[2][2][4][2], const pg8::Unit& u, int wr, int wc, int fr, int fq) const {
        const int row0 = u.pm * 256 + wr * 64 + fr, cb = u.pn * 256 + wc * 32 + 8 * fq;
#pragma unroll
        for (int ai = 0; ai < 2; ++ai)
#pragma unroll
            for (int m = 0; m < 4; ++m) { const int row = row0 + ai * 128 + m * 16;
#pragma unroll
                for (int bj = 0; bj < 2; ++bj) { const int c0 = cb + bj * 128;
                    const v4u gw = *(const v4u*)(PB + (size_t)row * 3072 + 1024 + c0); float g[8]; unpack8(gw, g);
                    f32x4 a = acc[ai][bj][m][0], b = acc[ai][bj][m][1];
#pragma unroll
                    for (int e = 0; e < 4; ++e) { a[e] *= sigm(g[e]); b[e] *= sigm(g[4 + e]); }
                    *(v4u*)(GM + (size_t)row * 2048 + c0) = pack8(a, b); } }
    }
};
__device__ __forceinline__ void st16_wt(void* p, v4u v) { asm volatile("global_store_dwordx4 %0, %1, off sc1\n\ts_nop 1" :: "v"(p), "v"(v) : "memory"); }
struct EpiG3F {
    static constexpr bool PERM = true, AFTER_DRAIN = true;
    const bf16* PB; bf16* GM; unsigned* flags;
    __device__ __forceinline__ void fused(f32x4 (&acc)[2][2][4][2], const pg8::Unit& u, int wr, int wc, int fr, int fq, PG8_LAS unsigned char* lds, int wid, int lane) const {
        const bool second = u.pn >= 4; const int pn4 = u.pn & 3;
        const int row0 = u.pm * 256 + wr * 64 + fr, cb = pn4 * 256 + wc * 32 + 8 * fq;
        unsigned* flag = flags + 64 * (u.pm * 4 + pn4);
        if (second) {
            if (wid == 0 && lane == 0) { unsigned sp = 0; while (__hip_atomic_load(flag, __ATOMIC_RELAXED, __HIP_MEMORY_SCOPE_AGENT) == 0u) { __builtin_amdgcn_s_sleep(2); if (++sp > (1u << 22)) break; }
                __builtin_amdgcn_fence(__ATOMIC_ACQUIRE, "agent"); asm volatile("s_waitcnt vmcnt(0)" ::: "memory"); }
            __builtin_amdgcn_s_barrier(); asm volatile("" ::: "memory");
        }
#pragma unroll
        for (int ai = 0; ai < 2; ++ai)
#pragma unroll
            for (int m = 0; m < 4; ++m) { const int row = row0 + ai * 128 + m * 16;
#pragma unroll
                for (int bj = 0; bj < 2; ++bj) { const int c0 = cb + bj * 128;
                    const v4u gw = *(const v4u*)(PB + (size_t)row * 3072 + 1024 + u.pn * 256 + wc * 32 + 8 * fq + bj * 128); float g[8]; unpack8(gw, g);
                    f32x4 a = acc[ai][bj][m][0], b = acc[ai][bj][m][1];
#pragma unroll
                    for (int e = 0; e < 4; ++e) { a[e] *= sigm(g[e]); b[e] *= sigm(g[4 + e]); }
                    bf16* dst = GM + (size_t)row * 1024 + c0;
                    if (second) { float t[8]; unpack8(*(const v4u*)dst, t);
#pragma unroll
                        for (int e = 0; e < 4; ++e) { a[e] += t[e]; b[e] += t[4 + e]; } }
                    if (second) *(v4u*)dst = pack8(a, b); else st16_wt(dst, pack8(a, b)); } }
        if (!second) {
            asm volatile("s_waitcnt vmcnt(0)" ::: "memory"); __builtin_amdgcn_s_barrier();
            if (wid == 0 && lane == 0) __hip_atomic_store(flag, 1u, __ATOMIC_RELAXED, __HIP_MEMORY_SCOPE_AGENT);
        }
    }
};
struct EpiPart {
    static constexpr bool PERM = true, AFTER_DRAIN = false;
    bf16* PART;
    __device__ __forceinline__ void operator()(const f32x4 (&acc)[2][2][4][2], const pg8::Unit& u, int wr, int wc, int fr, int fq) const {
        const int row0 = u.pm * 256 + wr * 64 + fr, cb = (u.pn & 3) * 256 + wc * 32 + 8 * fq;
        bf16* base = PART + (size_t)(u.pn >> 2) * NTOK * 1024;
#pragma unroll
        for (int ai = 0; ai < 2; ++ai)
#pragma unroll
            for (int m = 0; m < 4; ++m) { bf16* rp = base + (size_t)(row0 + ai * 128 + m * 16) * 1024 + cb;
#pragma unroll
                for (int bj = 0; bj < 2; ++bj) *(v4u*)(rp + bj * 128) = pack8(acc[ai][bj][m][0], acc[ai][bj][m][1]); }
    }
};
struct EpiG5 {
    static constexpr bool PERM = true, AFTER_DRAIN = false;
    bf16* H;
    __device__ __forceinline__ void operator()(const f32x4 (&acc)[2][2][4][2], const pg8::Unit& u, int wr, int wc, int fr, int fq) const {
        const int row0 = u.pm * 256 + wr * 64 + fr, cb = u.pn * 256 + wc * 32 + 8 * fq;
#pragma unroll
        for (int ai = 0; ai < 2; ++ai)
#pragma unroll
            for (int m = 0; m < 4; ++m) { bf16* rp = H + (size_t)(row0 + ai * 128 + m * 16) * DFF + cb;
#pragma unroll
                for (int bj = 0; bj < 2; ++bj) { f32x4 a = acc[ai][bj][m][0], b = acc[ai][bj][m][1];
#pragma unroll
                    for (int e = 0; e < 4; ++e) { const float x = fmaxf(a[e], 0.f), y = fmaxf(b[e], 0.f); a[e] = x * x; b[e] = y * y; }
                    *(v4u*)(rp + bj * 128) = pack8(a, b); } }
    }
};

__device__ __forceinline__ void p0_transpose_item(const float* W, int N, bf16* WT, int ldt, int row_off, LAS float* scr, int item, int lane) {
    const int nblk = N / 32, kb = item / nblk, nb = item % nblk, k0 = 64 * kb, n0 = 32 * nb;
    float tv[32];
#pragma unroll
    for (int i = 0; i < 32; ++i) { const int kk = 2 * i + (lane >> 5); tv[i] = W[(size_t)(k0 + kk) * N + n0 + (lane & 31)]; }
#pragma unroll
    for (int i = 0; i < 32; ++i) { const int kk = 2 * i + (lane >> 5); scr[kk * 33 + (lane & 31)] = tv[i]; }
    LDS_WAIT(); asm volatile("" ::: "memory");
    const int c = lane & 7;
#pragma unroll
    for (int j = 0; j < 4; ++j) { const int n = (lane >> 3) + 8 * j; const LAS float* s = scr + (8 * c) * 33 + n;
        v4u o; o.x = pk2(s[0 * 33], s[1 * 33]); o.y = pk2(s[2 * 33], s[3 * 33]); o.z = pk2(s[4 * 33], s[5 * 33]); o.w = pk2(s[6 * 33], s[7 * 33]);
        *(GAS v4u*)(WT + (size_t)(row_off + n0 + n) * ldt + k0 + 8 * c) = o; }
    LDS_WAIT(); asm volatile("" ::: "memory");
}
__device__ __forceinline__ void p0_mod_item(KPtr p, LAS unsigned char* lds, int item, int tid) {
    const int wave = tid >> 6, lane = tid & 63, kk = lane >> 3, c4 = lane & 7;
    const float* ada_w = p->in[I_ADAW]; const float* cc = p->in[I_C]; const float* cx = p->in[I_CCTX];
    f32x4 a0 = (f32x4){0.f, 0.f, 0.f, 0.f}, a1 = a0, a2 = a0;
#pragma unroll
    for (int i = 0; i < 16; ++i) {
        const int k = wave * 128 + i * 8 + kk;
        const f32x4 w = *(const f32x4*)(ada_w + (size_t)k * 6144 + item * 32 + c4 * 4);
        const float c0 = cx[k], c1 = cc[k], c2 = cc[1024 + k];
        a0 += w * (c0 * sigm(c0)); a1 += w * (c1 * sigm(c1)); a2 += w * (c2 * sigm(c2));
    }
#pragma unroll
    for (int e = 0; e < 4; ++e) {
#pragma unroll
        for (int o = 8; o < 64; o <<= 1) { a0[e] += __shfl_xor(a0[e], o); a1[e] += __shfl_xor(a1[e], o); a2[e] += __shfl_xor(a2[e], o); }
    }
    LAS float* red = (LAS float*)lds;
    if (lane < 8) {
#pragma unroll
        for (int e = 0; e < 4; ++e) { red[(wave * 3 + 0) * 32 + c4 * 4 + e] = a0[e]; red[(wave * 3 + 1) * 32 + c4 * 4 + e] = a1[e]; red[(wave * 3 + 2) * 32 + c4 * 4 + e] = a2[e]; }
    }
    __syncthreads();
    if (tid < 96) { const int j = tid >> 5, c = tid & 31; float s = p->in[I_ADAB][item * 32 + c];
#pragma unroll
        for (int w = 0; w < 8; ++w) s += red[(w * 3 + j) * 32 + c];
        __hip_atomic_store((float*)(p->ws + WS_MOD) + j * 6144 + item * 32 + c, s, __ATOMIC_RELAXED, __HIP_MEMORY_SCOPE_AGENT); }
    asm volatile("s_waitcnt vmcnt(0)" ::: "memory");
    __syncthreads();
    if (tid == 0) {
        __hip_atomic_fetch_add((unsigned*)(p->ws + WS_CTL) + CW_MODCNT, 1u, __ATOMIC_RELAXED, __HIP_MEMORY_SCOPE_AGENT); }
}
__device__ __forceinline__ void p0_prologue(KPtr p, LAS unsigned char* lds, int vcu, int G, int tid) {
    const int wave = __builtin_amdgcn_readfirstlane(tid >> 6), lane = tid & 63;
    for (int it = vcu; it < 192; it += G) p0_mod_item(p, lds, it, tid);
    LAS float* scr = (LAS float*)(lds + wave * 16384);
    const int gw = vcu * NWAVES + wave, NGW = G * NWAVES;
    bf16* Win = (bf16*)(p->ws + WS_WIN); bf16* B2 = (bf16*)(p->ws + WS_B2); bf16* Wout = (bf16*)(p->ws + WS_WOUT);
    bf16* Wo = (bf16*)(p->ws + WS_WO); bf16* W1 = (bf16*)(p->ws + WS_W1); bf16* W2 = (bf16*)(p->ws + WS_W2);
    constexpr int T_WIN = 16 * 144, T_GG1 = 16 * 4, T_L1 = 16 * 2, T_GG2 = 2 * 16, T_L2 = 16, T_WOUT = 8 * 32, T_WO = 16 * 32, T_W1 = 16 * 128, T_W2 = 64 * 32;
    constexpr int NITEMS = T_WIN + T_GG1 + 4 * T_L1 + T_GG2 + 4 * T_L2 + 2 * T_WOUT + T_WO;
    for (int it = gw; it < NITEMS; it += NGW) {
        int r = it;
        if (r < T_WIN) { p0_transpose_item(p->in[I_WIN], 4608, Win, 1024, 0, scr, r, lane); continue; } r -= T_WIN;
        if (r < T_WO) { p0_transpose_item(p->in[I_WO], DM, Wo, 1024, 0, scr, r, lane); continue; } r -= T_WO;
        if (r < T_WOUT) { p0_transpose_item(p->in[I_WOR], DM, Wout, 512, 0, scr, r, lane); continue; } r -= T_WOUT;
        if (r < T_WOUT) { p0_transpose_item(p->in[I_WOC], DM, Wout, 512, 1024, scr, r, lane); continue; } r -= T_WOUT;
        if (r < T_GG1) { p0_transpose_item(p->in[I_GG1], 128, Win, 1024, 4608, scr, r, lane); continue; } r -= T_GG1;
        if (r < 4 * T_L1) { const int q = r / T_L1; r -= q * T_L1;
            const float* src = (q < 2 ? p->in[I_DW1] : p->in[I_IA1]) + (size_t)(q & 1) * 1024 * 64;
            p0_transpose_item(src, 64, Win, 1024, 4608 + 256 * (q + 1), scr, r, lane); continue; } r -= 4 * T_L1;
        if (r < T_GG2) { p0_transpose_item(p->in[I_GG2], 512, B2, 256, 0, scr, r, lane); continue; } r -= T_GG2;
        { const int q = r / T_L2; r -= q * T_L2;
            const float* src = (q < 2 ? p->in[I_DW2] : p->in[I_IA2]) + (size_t)(q & 1) * 64 * 512;
            p0_transpose_item(src, 512, B2, 256, 512 * (q + 1), scr, r, lane); }
    }
    const v4u z = (v4u){0u, 0u, 0u, 0u};
    for (int it = gw; it < 5 * 256; it += NGW) { const int l = it >> 8, rr = it & 255; const int real = (l == 0) ? 128 : 64;
        if (rr >= real) { GAS v4u* dst = (GAS v4u*)(Win + (size_t)(4608 + l * 256 + rr) * 1024); dst[lane] = z; dst[64 + lane] = z; } }
    for (int it = gw; it < 2560; it += NGW) { const int real = (it < 512) ? 128 : 64;
        if (lane * 4 >= real) *(GAS v2u*)(B2 + (size_t)it * 256 + lane * 4) = (v2u){0u, 0u}; }
}

__device__ __forceinline__ void p1_norm1(KPtr p, int gw, int NGW, int lane) {
    const float* MOD = (const float*)(p->ws + WS_MOD); bf16* XN = (bf16*)(p->ws + WS_XN); const float* ng = p->in[I_N1G];
    for (int mi = gw; mi < NTOK; mi += NGW) { const int m = (NGW == 2048) ? ((mi & 255) + 1024 * ((mi >> 8) & 7) + 256 * (mi >> 11)) : mi;

        const float* xr = (m < NCTX) ? p->in[I_XP] + (size_t)m * DM : p->in[I_XS] + (size_t)(m - NCTX) * DM;
        const float* md = MOD + cond_of(m) * 6144;
        f32x4 v[4]; float s = 0.f;
#pragma unroll
        for (int j = 0; j < 4; ++j) { v[j] = ((const f32x4*)xr)[lane + 64 * j]; s += (v[j][0] * v[j][0] + v[j][1] * v[j][1]) + (v[j][2] * v[j][2] + v[j][3] * v[j][3]); }
        const float rstd = rsqrtf(wave_sum(s) * (1.f / DM) + 1e-6f);
        GAS v2u* o8 = (GAS v2u*)(XN + (size_t)m * DM) + lane;
#pragma unroll
        for (int j = 0; j < 4; ++j) { const int c = 4 * (lane + 64 * j);
            const f32x4 g = *(const f32x4*)(ng + c), sh = *(const f32x4*)(md + c), sc = *(const f32x4*)(md + 1024 + c);
            const f32x4 y = v[j] * rstd * g * (sc + 1.0f) + sh;
            o8[64 * j] = (v2u){pk2(y[0], y[1]), pk2(y[2], y[3])}; }
    }
}
__device__ __forceinline__ void p7_res_norm2(KPtr p, int gw, int NGW, int lane) {
    const float* MOD = (const float*)(p->ws + WS_MOD); bf16* XN = (bf16*)(p->ws + WS_XN); const float* ng = p->in[I_N2G];
    const bf16* P0 = (const bf16*)(p->ws + WS_PART); const bf16* P1 = P0 + (size_t)NTOK * DM;
    for (int mi = gw; mi < NTOK; mi += NGW) { const int m = (NGW == 2048) ? ((mi & 255) + 1024 * ((mi >> 8) & 7) + 256 * (mi >> 11)) : mi;

        const float* xr = (m < NCTX) ? p->in[I_XP] + (size_t)m * DM : p->in[I_XS] + (size_t)(m - NCTX) * DM;
        const float* md = MOD + cond_of(m) * 6144;
        f32x4 v[4]; float s = 0.f;
#pragma unroll
        for (int j = 0; j < 4; ++j) { const int c = 4 * (lane + 64 * j);
            const f32x4 x = *(const f32x4*)(xr + c), g1 = *(const f32x4*)(md + 2048 + c); const v2u aw = *(const v2u*)(P0 + (size_t)m * DM + c), bw = *(const v2u*)(P1 + (size_t)m * DM + c);
            const f32x4 a = (f32x4){bflo(aw.x), bfhi(aw.x), bflo(aw.y), bfhi(aw.y)}, b = (f32x4){bflo(bw.x), bfhi(bw.x), bflo(bw.y), bfhi(bw.y)};
            v[j] = x + g1 * (a + b);
            *(f32x4*)(p->out + (size_t)m * DM + c) = v[j];
            s += (v[j][0] * v[j][0] + v[j][1] * v[j][1]) + (v[j][2] * v[j][2] + v[j][3] * v[j][3]); }
        const float rstd = rsqrtf(wave_sum(s) * (1.f / DM) + 1e-6f);
        GAS v2u* o8 = (GAS v2u*)(XN + (size_t)m * DM) + lane;
#pragma unroll
        for (int j = 0; j < 4; ++j) { const int c = 4 * (lane + 64 * j);
            const f32x4 g = *(const f32x4*)(ng + c), sh = *(const f32x4*)(md + 3072 + c), sc = *(const f32x4*)(md + 4096 + c);
            const f32x4 y = v[j] * rstd * g * (sc + 1.0f) + sh;
            o8[64 * j] = (v2u){pk2(y[0], y[1]), pk2(y[2], y[3])}; }
    }
}
__device__ __forceinline__ void p12_final(KPtr p, int gw, int NGW, int lane) {
    const float* MOD = (const float*)(p->ws + WS_MOD); const float* fg = p->in[I_FG];
    const bf16* P0 = (const bf16*)(p->ws + WS_PART); const bf16* P1 = P0 + (size_t)NTOK * DM;
    for (int mi = gw; mi < NTOK; mi += NGW) { const int m = (NGW == 2048) ? ((mi & 255) + 1024 * ((mi >> 8) & 7) + 256 * (mi >> 11)) : mi;

        const float* md = MOD + cond_of(m) * 6144;
        f32x4 v[4]; float s = 0.f;
#pragma unroll
        for (int j = 0; j < 4; ++j) { const int c = 4 * (lane + 64 * j);
            const f32x4 x = *(const f32x4*)(p->out + (size_t)m * DM + c), g2 = *(const f32x4*)(md + 5120 + c); const v2u aw = *(const v2u*)(P0 + (size_t)m * DM + c), bw = *(const v2u*)(P1 + (size_t)m * DM + c);
            const f32x4 a = (f32x4){bflo(aw.x), bfhi(aw.x), bflo(aw.y), bfhi(aw.y)}, b = (f32x4){bflo(bw.x), bfhi(bw.x), bflo(bw.y), bfhi(bw.y)};
            v[j] = x + g2 * (a + b);
            s += (v[j][0] * v[j][0] + v[j][1] * v[j][1]) + (v[j][2] * v[j][2] + v[j][3] * v[j][3]); }
        const float rstd = rsqrtf(wave_sum(s) * (1.f / DM) + 1e-6f);
#pragma unroll
        for (int j = 0; j < 4; ++j) { const int c = 4 * (lane + 64 * j);
            *(f32x4*)(p->out + (size_t)m * DM + c) = v[j] * rstd * *(const f32x4*)(fg + c); }
    }
}
__device__ __forceinline__ void load8(const float* p, float (&o)[8]) { const f32x4 a = *(const f32x4*)p, b = *(const f32x4*)(p + 4); o[0] = a[0]; o[1] = a[1]; o[2] = a[2]; o[3] = a[3]; o[4] = b[0]; o[5] = b[1]; o[6] = b[2]; o[7] = b[3]; }
__device__ __forceinline__ void store8bf(bf16* p, const float (&v)[8]) { v4u w; w.x = pk2(v[0], v[1]); w.y = pk2(v[2], v[3]); w.z = pk2(v[4], v[5]); w.w = pk2(v[6], v[7]); *(GAS v4u*)p = w; }
typedef short bf16x8v __attribute__((ext_vector_type(8)));
typedef float f32x16 __attribute__((ext_vector_type(16)));
#define MFMA32(a, b, c) __builtin_amdgcn_mfma_f32_32x32x16_bf16(a, b, c, 0, 0, 0)
__device__ __forceinline__ bf16x8v ldfrag(const LAS unsigned char* base, int row_stride, int row, int col) { return *(const LAS bf16x8v*)(base + row * row_stride + col * 2); }
__device__ __forceinline__ int trow(int reg, int half) { return (reg & 3) + 8 * (reg >> 2) + 4 * half; }
__device__ __forceinline__ bf16x8v pack_acc(const f32x16& x, int s) {
    v4u w; w.x = pk2(x[8 * s], x[8 * s + 1]); w.y = pk2(x[8 * s + 2], x[8 * s + 3]); w.z = pk2(x[8 * s + 4], x[8 * s + 5]); w.w = pk2(x[8 * s + 6], x[8 * s + 7]);
    return __builtin_bit_cast(bf16x8v, w);
}
__device__ __forceinline__ int rec_off_s(int fbase, int rr, int cc) { const int s = cc >> 4, o = cc & 15, hh = (o >> 2) & 1, j = 4 * (o >> 3) + (o & 3); return (fbase + s) * 1024 + (32 * hh + rr) * 16 + j * 2; }
__device__ __forceinline__ int rec_off_n(int fbase, int rr, int ii) { const int s = ii >> 4, o = ii & 15, hh = o >> 3, j = o & 7; return (fbase + s) * 1024 + (32 * hh + rr) * 16 + j * 2; }
constexpr int P1_WAVE_LDS = 32768;
constexpr int P1_AT = 0, P1_BT = 4608, P1_RT = 9216, P1_KT = 13824, P1_BTT = 18432, P1_NBR = 23552, P1_WT = 26112, P1_GCL = 31232, P1_RN = 32256;
constexpr int P1_L = 4608, P1_NKA = 26112, P1_ZT = 4608, P1_RED0 = 0, P1_RED1 = 23552;

__device__ __forceinline__ void p4_decode(int task, int& b, int& h, int& n, int& m0, int& T) {
    if (task < 1024) { b = task >> 6; h = (task >> 3) & 7; n = task & 7; m0 = b * 256; T = 256; }
    else { const int t2 = task - 1024; b = t2 >> 9; h = (t2 >> 6) & 7; n = t2 & 63; m0 = NCTX + b * 2048; T = 2048; }
}
template <int D>
__device__ __forceinline__ void p4_pass1(KPtr p, LAS unsigned char* wl, int task) {
    int lane; PG8_LANE(lane);
    int b, h, n, m0, T; p4_decode(task, b, h, n, m0, T);
    const bf16* RKV = (const bf16*)(p->ws + WS_RKV);
    const int c = h * 64 + lane, mb = m0 + 32 * n;
    const bool has_prev = n > 0, has_next = (32 * n + 32) < T;
    float kraw[34];
    {   const bf16* srck = RKV + (size_t)mb * 1536 + 512 + c;
        kraw[0] = has_prev ? bf1(srck[-1536]) : 0.f;
        int eo = 0;
#pragma unroll
        for (int i = 0; i < 32; ++i) { kraw[i + 1] = bf1(srck[eo]); eo += 1536; asm volatile("" : "+v"(eo)); }
        kraw[33] = has_next ? bf1(srck[eo]) : 0.f; }
    __builtin_amdgcn_sched_barrier(0);
    float lw[32], al[32];
    {   const int fr0 = lane & 31, fh0 = lane >> 5;
        const bf16* A2p = (const bf16*)(p->ws + WS_A2) + (size_t)(mb + fr0) * 1280 + 8 * fh0;
        const bf16* B2p = (const bf16*)(p->ws + WS_B2) + (size_t)(h * 64 + fr0) * 256 + 8 * fh0;
        const float w0c = p->in[I_DW0][D * 512 + c], a0c = p->in[I_IA0][D * 512 + c];
#pragma unroll
        for (int which = 0; which < (D == 0 ? 3 : 2); ++which) {
            const int l = (which == 0) ? 1 + D : (which == 1) ? 3 + D : 0, nk = (which == 2) ? 8 : 4;
            f32x16 c0, c1;
#pragma unroll
            for (int e = 0; e < 16; ++e) { c0[e] = 0.f; c1[e] = 0.f; }
#pragma unroll
            for (int s4 = 0; s4 < nk; ++s4) { const bf16x8v a = *(const bf16x8v*)(A2p + 256 * l + 16 * s4);
                const bf16x8v b0 = *(const bf16x8v*)(B2p + (size_t)(l * 512) * 256 + 16 * s4), b1 = *(const bf16x8v*)(B2p + (size_t)(l * 512 + 32) * 256 + 16 * s4);
                c0 = MFMA32(a, b0, c0); c1 = MFMA32(a, b1, c1); }
#pragma unroll
            for (int e = 0; e < 16; ++e) {
                const auto sw = __builtin_amdgcn_permlane32_swap(__float_as_uint(c0[e]), __float_as_uint(c1[e]), false, false);
                const float x0 = __uint_as_float(sw[0]), x1 = __uint_as_float(sw[1]);
                const int t0 = trow(e, 0), t1 = trow(e, 1);
                if (which == 0) { lw[t0] = -0.6065306597126334f * sigm(w0c + x0); lw[t1] = -0.6065306597126334f * sigm(w0c + x1); }
                else if (which == 1) { al[t0] = sigm(a0c + x0); al[t1] = sigm(a0c + x1); }
                else { bf16* Gp = (bf16*)((unsigned char*)p->out + DO_G) + (size_t)mb * 512 + c; Gp[(size_t)t0 * 512] = (bf16)(pk2(x0, 0.f) & 0xffffu); Gp[(size_t)t1 * 512] = (bf16)(pk2(x1, 0.f) & 0xffffu); }
            }
        }
    }
    __builtin_amdgcn_sched_barrier(0);
    {   const float mp = p->in[I_MUP][512 + c], mn = p->in[I_MUN][512 + c], kkw = p->in[I_KK][c];
        LAS float* red = (LAS float*)(wl + P1_RED0);
#pragma unroll
        for (int i = 0; i < 32; ++i) { const float u = (kraw[i + 1] + (kraw[i] - kraw[i + 1]) * mp + (kraw[i + 2] - kraw[i + 1]) * mn) * kkw; red[i * 68 + lane] = u * u; }
        asm volatile("" ::: "memory");
        const int ri = lane & 31, hf = lane >> 5; float ssum = 0.f;
#pragma unroll
        for (int q = 0; q < 8; ++q) { const f32x4 x = *(const LAS f32x4*)(red + ri * 68 + hf * 32 + 4 * q); ssum += (x[0] + x[1]) + (x[2] + x[3]); }
        ssum += __int_as_float(__builtin_amdgcn_ds_bpermute((lane ^ 32) << 2, __float_as_int(ssum)));
        if (lane < 32) ((LAS float*)(wl + P1_RN))[lane] = rsqrtf(fmaxf(ssum, 1e-24f));
    }
    asm volatile("" ::: "memory");
    float gC;
    {   const float kaw = p->in[I_KA][c], rkw = p->in[I_RK][c], kkw = p->in[I_KK][c];
        const float mpr = p->in[I_MUP][c], mnr = p->in[I_MUN][c], mpk = p->in[I_MUP][512 + c], mnk = p->in[I_MUN][512 + c], mpv = p->in[I_MUP][1024 + c], mnv = p->in[I_MUN][1024 + c];
        LAS bf16* lAT = (LAS bf16*)(wl + P1_AT); LAS bf16* lBT = (LAS bf16*)(wl + P1_BT); LAS bf16* lRT = (LAS bf16*)(wl + P1_RT); LAS bf16* lKT = (LAS bf16*)(wl + P1_KT);
        LAS float* red1 = (LAS float*)(wl + P1_RED1); const LAS float* rnl = (const LAS float*)(wl + P1_RN);
        const int j0 = D ? 31 : 0;
        const bf16* src = RKV + (size_t)(mb + j0) * 1536 + c; const bf16* srcv = src + 1024;
        bf16* VN = (bf16*)((unsigned char*)p->out + DO_V) + (size_t)mb * 512 + c;
        bf16* VT = (bf16*)((unsigned char*)p->out + DO_VT) + (size_t)m0 * 512 + (size_t)h * 64 * T + (size_t)lane * T + 32 * n;
        const bool has_behind = D ? has_next : has_prev, has_ahead = D ? has_prev : has_next;
        constexpr int stp = D ? -1536 : 1536;
        float rb = has_behind ? bf1(src[-stp]) : 0.f, kb = has_behind ? bf1(src[-stp + 512]) : 0.f, vb = has_behind ? bf1(srcv[-stp]) : 0.f;
        float rc = bf1(src[0]), kc = bf1(src[512]), vc = bf1(srcv[0]);
        float Lc = 0.f, gprev = 1.f; float btp[8], vtp[8];
        int eo = 0, vo = 0;
        float nra[8], nka[8], nva[8];
#define P1_LOAD_GROUP(g_) do { _Pragma("unroll") for (int u_ = 0; u_ < 8; ++u_) { const int s_ = 8 * (g_) + u_; \
            eo += stp; asm volatile("" : "+v"(eo)); const bool ha_ = (s_ < 31) || has_ahead; \
            nra[u_] = ha_ ? bf1(src[eo]) : 0.f; nka[u_] = ha_ ? bf1(src[eo + 512]) : 0.f; nva[u_] = ha_ ? bf1(srcv[eo]) : 0.f; } } while (0)
        P1_LOAD_GROUP(0);
#pragma unroll
        for (int g8 = 0; g8 < 4; ++g8) {
            float cra[8], cka[8], cva[8];
#pragma unroll
            for (int u = 0; u < 8; ++u) { cra[u] = nra[u]; cka[u] = nka[u]; cva[u] = nva[u]; }
            if (g8 < 3) P1_LOAD_GROUP(g8 + 1);
#pragma unroll
            for (int u = 0; u < 8; ++u) {
                const int s = 8 * g8 + u, j = D ? 31 - s : s;
                const float lwj = lw[j], alj = al[j], ra = cra[u], ka = cka[u], va = cva[u];
                const float rp_ = D ? ra : rb, rn_ = D ? rb : ra, kp_ = D ? ka : kb, kn_ = D ? kb : ka, vp_ = D ? va : vb, vn_ = D ? vb : va;
                const float rj = rc + (rp_ - rc) * mpr + (rn_ - rc) * mnr, kj = kc + (kp_ - kc) * mpk + (kn_ - kc) * mnk, vj = vc + (vp_ - vc) * mpv + (vn_ - vc) * mnv;
                const float kkj = kj * kkw * rnl[j];
                Lc += lwj;
                const float g = __expf(Lc), gi = __expf(-Lc);
                const float kd = kj * (1.f + (alj - 1.f) * kaw), bb = kkj * alj;
                const float at = -kkj * gprev;
                const float rt = rj * g, bt = bb * gi, kt = kd * gi;
                lAT[s * 72 + lane] = (bf16)(pk2(at, 0.f) & 0xffffu); lBT[s * 72 + lane] = (bf16)(pk2(bt, 0.f) & 0xffffu);
                lRT[s * 72 + lane] = (bf16)(pk2(rt, 0.f) & 0xffffu); lKT[s * 72 + lane] = (bf16)(pk2(kt, 0.f) & 0xffffu);
                btp[u] = bt;
                red1[j * 68 + lane] = rj * kd * rkw;
                if (D == 0) { VN[vo] = (bf16)(pk2(vj, 0.f) & 0xffffu); vo += 512; asm volatile("" : "+v"(vo)); vtp[u] = vj; }
                gprev = g; rb = rc; kb = kc; vb = vc; rc = ra; kc = ka; vc = va;
            }
            { v4u w; w.x = pk2(btp[0], btp[1]); w.y = pk2(btp[2], btp[3]); w.z = pk2(btp[4], btp[5]); w.w = pk2(btp[6], btp[7]); *(LAS v4u*)(wl + P1_BTT + lane * 80 + g8 * 16) = w; }
            if (D == 0) { v4u w; w.x = pk2(vtp[0], vtp[1]); w.y = pk2(vtp[2], vtp[3]); w.z = pk2(vtp[4], vtp[5]); w.w = pk2(vtp[6], vtp[7]); *(GAS v4u*)(VT + 8 * g8) = w; }
            __builtin_amdgcn_sched_barrier(0);
        }
#undef P1_LOAD_GROUP
        gC = gprev;
    }
    asm volatile("" ::: "memory");
    {   LAS float* red = (LAS float*)(wl + P1_RED1);
        const int ri = lane & 31, hf = lane >> 5; float ssum = 0.f;
#pragma unroll
        for (int q = 0; q < 8; ++q) { const f32x4 x = *(const LAS f32x4*)(red + ri * 68 + hf * 32 + 4 * q); ssum += (x[0] + x[1]) + (x[2] + x[3]); }
        ssum += __int_as_float(__builtin_amdgcn_ds_bpermute((lane ^ 32) << 2, __float_as_int(ssum)));
        if (lane < 32) ((float*)((unsigned char*)p->out + DO_DOT))[(size_t)D * NTOK * 8 + (size_t)(mb + lane) * 8 + h] = ssum;
    }
    asm volatile("" ::: "memory");
    const int fr = lane & 31, fh = lane >> 5;
    f32x16 nab, nka, nbr, nkr;
#pragma unroll
    for (int e = 0; e < 16; ++e) { nab[e] = 0.f; nka[e] = 0.f; nbr[e] = 0.f; nkr[e] = 0.f; }
    { bf16x8v fa[4], fb[4], fR[4], fk[4];
#pragma unroll
        for (int s4 = 0; s4 < 4; ++s4) { fa[s4] = ldfrag(wl + P1_AT, 144, fr, 16 * s4 + 8 * fh); fb[s4] = ldfrag(wl + P1_BT, 144, fr, 16 * s4 + 8 * fh);
            fR[s4] = ldfrag(wl + P1_RT, 144, fr, 16 * s4 + 8 * fh); fk[s4] = ldfrag(wl + P1_KT, 144, fr, 16 * s4 + 8 * fh); }
#pragma unroll
        for (int s4 = 0; s4 < 4; ++s4) { nab = MFMA32(fa[s4], fb[s4], nab); nka = MFMA32(fa[s4], fk[s4], nka); nbr = MFMA32(fR[s4], fb[s4], nbr); nkr = MFMA32(fk[s4], fR[s4], nkr); }
    }
    { LAS float* lL = (LAS float*)(wl + P1_L); LAS float* lN = (LAS float*)(wl + P1_NKA); LAS bf16* lB = (LAS bf16*)(wl + P1_NBR);
#pragma unroll
        for (int e = 0; e < 16; ++e) { const int t = trow(e, fh), i = fr;
            const float vab = (i < t) ? nab[e] : 0.f, vka = (i < t) ? nka[e] : 0.f, vbr = (i <= t) ? nbr[e] : 0.f; nkr[e] = (t <= i) ? nkr[e] : 0.f;
            lL[t * 32 + i] = vab; lN[t * 33 + i] = vka; lB[t * 40 + i] = (bf16)(pk2(vbr, 0.f) & 0xffffu); } }
    asm volatile("" ::: "memory");
    float W[32], Z[32];
    { int dep = 0; asm volatile("" : "+v"(dep));
#pragma unroll
        for (int t = 0; t < 32; ++t) {
            if (t >= 2) asm volatile("" : "+v"(dep) : "v"(W[t - 2]), "v"(Z[t - 2]));
            const LAS float* lL = (const LAS float*)(wl + P1_L) + dep; const LAS float* lN = (const LAS float*)(wl + P1_NKA) + dep; const LAS bf16* lAT = (const LAS bf16*)(wl + P1_AT) + dep;
            float aw = bf1(lAT[t * 72 + lane]), az = lN[t * 33 + fr], aw2 = 0.f, az2 = 0.f;
#pragma unroll
            for (int i4 = 0; i4 * 4 < t; ++i4) { const f32x4 l4 = *(const LAS f32x4*)(lL + t * 32 + 4 * i4);
#pragma unroll
                for (int e = 0; e < 4; ++e) { const int i = 4 * i4 + e; if (i < t) { if (e & 1) { aw2 += l4[e] * W[i]; az2 += l4[e] * Z[i]; } else { aw += l4[e] * W[i]; az += l4[e] * Z[i]; } } } }
            W[t] = aw + aw2; Z[t] = az + az2;
        } }
    asm volatile("" ::: "memory");
#pragma unroll
    for (int q = 0; q < 4; ++q) { v4u w; w.x = pk2(W[8 * q], W[8 * q + 1]); w.y = pk2(W[8 * q + 2], W[8 * q + 3]); w.z = pk2(W[8 * q + 4], W[8 * q + 5]); w.w = pk2(W[8 * q + 6], W[8 * q + 7]); *(LAS v4u*)(wl + P1_WT + lane * 80 + 16 * q) = w; }
    if (lane < 32) {
#pragma unroll
        for (int q = 0; q < 4; ++q) { v4u w; w.x = pk2(Z[8 * q], Z[8 * q + 1]); w.y = pk2(Z[8 * q + 2], Z[8 * q + 3]); w.z = pk2(Z[8 * q + 4], Z[8 * q + 5]); w.w = pk2(Z[8 * q + 6], Z[8 * q + 7]); *(LAS v4u*)(wl + P1_ZT + lane * 80 + 16 * q) = w; } }
    ((LAS float*)(wl + P1_GCL))[lane] = gC;
    asm volatile("" ::: "memory");
    const int wt = task * 2 + D;
    unsigned char* rec = p->ws + (wt < 2048 ? WS_RECA + (size_t)wt * REC_BYTES : WS_RECB + (size_t)(wt - 2048) * REC_BYTES);
    ((float*)(p->ws + WS_GC))[(size_t)wt * 64 + lane] = gC;
    const LAS float* lG = (const LAS float*)(wl + P1_GCL);
    bf16x8v fnb[2], fzt[2];
#pragma unroll
    for (int s2 = 0; s2 < 2; ++s2) { fnb[s2] = ldfrag(wl + P1_NBR, 80, fr, 16 * s2 + 8 * fh); fzt[s2] = ldfrag(wl + P1_ZT, 80, fr, 16 * s2 + 8 * fh); }
    unsigned char* recl = rec + lane * 16;
    __builtin_amdgcn_sched_barrier(0);
    { f32x16 acc = nkr;
#pragma unroll
        for (int s2 = 0; s2 < 2; ++s2) acc = MFMA32(fzt[s2], fnb[s2], acc);
        *(GAS bf16x8v*)(recl + 16 * 1024) = pack_acc(acc, 0); *(GAS bf16x8v*)(recl + 17 * 1024) = pack_acc(acc, 1); }
#pragma unroll
    for (int a2 = 0; a2 < 2; ++a2) {
        __builtin_amdgcn_sched_barrier(0);
        bf16x8v fbt[2];
#pragma unroll
        for (int s2 = 0; s2 < 2; ++s2) fbt[s2] = ldfrag(wl + P1_BTT, 80, 32 * a2 + fr, 16 * s2 + 8 * fh);
        const float gcl = lG[32 * a2 + fr];
        { f32x16 acc; const LAS bf16* lKT = (const LAS bf16*)(wl + P1_KT);
#pragma unroll
            for (int e = 0; e < 16; ++e) acc[e] = bf1(lKT[trow(e, fh) * 72 + 32 * a2 + fr]);
#pragma unroll
            for (int s2 = 0; s2 < 2; ++s2) acc = MFMA32(fzt[s2], fbt[s2], acc);
#pragma unroll
            for (int e = 0; e < 16; ++e) acc[e] *= gcl;
            *(GAS bf16x8v*)(recl + (8 + 2 * a2) * 1024) = pack_acc(acc, 0); *(GAS bf16x8v*)(recl + (9 + 2 * a2) * 1024) = pack_acc(acc, 1); }
#pragma unroll
        for (int kt = 0; kt < 2; ++kt) { __builtin_amdgcn_sched_barrier(0); f32x16 acc;
#pragma unroll
            for (int e = 0; e < 16; ++e) acc[e] = 0.f;
#pragma unroll
            for (int s2 = 0; s2 < 2; ++s2) acc = MFMA32(ldfrag(wl + P1_WT, 80, 32 * kt + fr, 16 * s2 + 8 * fh), fbt[s2], acc);
#pragma unroll
            for (int e = 0; e < 16; ++e) acc[e] *= gcl;
            *(GAS bf16x8v*)(recl + (a2 * 4 + 2 * kt) * 1024) = pack_acc(acc, 0); *(GAS bf16x8v*)(recl + (a2 * 4 + 2 * kt + 1) * 1024) = pack_acc(acc, 1); }
    }
#pragma unroll
    for (int kt = 0; kt < 2; ++kt) { __builtin_amdgcn_sched_barrier(0); f32x16 acc; const LAS bf16* lRT = (const LAS bf16*)(wl + P1_RT);
#pragma unroll
        for (int e = 0; e < 16; ++e) acc[e] = bf1(lRT[fr * 72 + 32 * kt + trow(e, fh)]);
#pragma unroll
        for (int s2 = 0; s2 < 2; ++s2) acc = MFMA32(ldfrag(wl + P1_WT, 80, 32 * kt + fr, 16 * s2 + 8 * fh), fnb[s2], acc);
        *(GAS bf16x8v*)(recl + (12 + 2 * kt) * 1024) = pack_acc(acc, 0); *(GAS bf16x8v*)(recl + (13 + 2 * kt) * 1024) = pack_acc(acc, 1); }
    asm volatile("" ::: "memory");
}
__device__ __forceinline__ void p4_conv_item(KPtr p, LAS unsigned char* lds, int item, int tid) {
    const int wave = __builtin_amdgcn_readfirstlane(tid >> 6), lane = tid & 63;
    const bf16* PB = (const bf16*)(p->ws + WS_PB); bf16* RC = (bf16*)(p->ws + WS_RC);
    const int t0 = item * 32;
    int lo, hi; if (t0 < NCTX) { lo = t0 & ~255; hi = lo + 256; } else { lo = t0 & ~63; hi = lo + 64; }
    LAS bf16* U = (LAS bf16*)lds;
    LAS float* CWL = (LAS float*)(lds + 62 * 1024);
    for (int e = tid; e < 62 * 64; e += 512) {
        const int r = e >> 6, ch = (e & 63) * 8, tok = t0 - 15 + r;
        v4u w = (v4u){0u, 0u, 0u, 0u};
        if (tok >= lo && tok < hi) { float a[8], g[8]; unpack8(*(const v4u*)(PB + (size_t)tok * 3072 + ch), a); unpack8(*(const v4u*)(PB + (size_t)tok * 3072 + 512 + ch), g);
#pragma unroll
            for (int i = 0; i < 8; ++i) a[i] *= sigm(g[i]);
            w.x = pk2(a[0], a[1]); w.y = pk2(a[2], a[3]); w.z = pk2(a[4], a[5]); w.w = pk2(a[6], a[7]); }
        *(LAS v4u*)(U + r * 512 + ch) = w;
    }
    for (int e = tid; e < 31 * 128; e += 512) ((LAS f32x4*)CWL)[e] = ((const f32x4*)p->in[I_CW])[e];
    __syncthreads();
    const int c = 8 * lane;
    float cb[8], lg[8], lb[8]; load8(p->in[I_CB] + c, cb); load8(p->in[I_CLG] + c, lg); load8(p->in[I_CLB] + c, lb);
    {
        float acc[4][8];
#pragma unroll
        for (int tt = 0; tt < 4; ++tt)
#pragma unroll
            for (int e = 0; e < 8; ++e) acc[tt][e] = cb[e];
#pragma unroll 2
        for (int j = 0; j < 31; ++j) {
            const f32x4 w0 = *(const LAS f32x4*)(CWL + j * 512 + c), w1 = *(const LAS f32x4*)(CWL + j * 512 + c + 4);
#pragma unroll
            for (int tt = 0; tt < 4; ++tt) { float uv[8]; unpack8(*(const LAS v4u*)(U + (wave * 4 + tt + j) * 512 + c), uv);
#pragma unroll
                for (int e = 0; e < 4; ++e) { acc[tt][e] += uv[e] * w0[e]; acc[tt][4 + e] += uv[4 + e] * w1[e]; } }
        }
#pragma unroll
        for (int tt = 0; tt < 4; ++tt) {
            float s = 0.f;
#pragma unroll
            for (int e = 0; e < 8; ++e) s += acc[tt][e];
            const float mean = wave_sum(s) * (1.f / 512.f); float q = 0.f;
#pragma unroll
            for (int e = 0; e < 8; ++e) { acc[tt][e] -= mean; q += acc[tt][e] * acc[tt][e]; }
            const float rstd = rsqrtf(wave_sum(q) * (1.f / 512.f) + 1e-5f);
            float o[8];
#pragma unroll
            for (int e = 0; e < 8; ++e) { const float un = acc[tt][e] * rstd * lg[e] + lb[e]; o[e] = un * sigm(un); }
            store8bf(RC + (size_t)(t0 + wave * 4 + tt) * 1024 + 512 + c, o);
        }
    }
    __syncthreads();
}
__device__ __forceinline__ void p6_post(KPtr p, int gw, int NGW, int lane) {
    const float* YF = (const float*)(p->ws + WS_YF); const float* YB = (const float*)(p->ws + WS_YB);
    const bf16* VN = (const bf16*)((const unsigned char*)p->out + DO_V); const float* DOT = (const float*)((const unsigned char*)p->out + DO_DOT); const bf16* G = (const bf16*)((const unsigned char*)p->out + DO_G); bf16* RC = (bf16*)(p->ws + WS_RC);
    const int c = 8 * lane;
    float lg[8], lb[8]; load8(p->in[I_LNXG] + c, lg); load8(p->in[I_LNXB] + c, lb);
    for (int mi = gw; mi < NTOK; mi += NGW) { const int m = (NGW == 2048) ? ((mi & 255) + 1024 * ((mi >> 8) & 7) + 256 * (mi >> 11)) : mi;

        float a[8], b[8]; load8(YF + (size_t)m * 512 + c, a); load8(YB + (size_t)m * 512 + c, b);
        float s = 0.f;
#pragma unroll
        for (int e = 0; e < 8; ++e) { a[e] += b[e]; s += a[e]; }
        const float mu = oct_sum(s) * (1.f / 64.f); float q = 0.f;
#pragma unroll
        for (int e = 0; e < 8; ++e) { a[e] -= mu; q += a[e] * a[e]; }
        const float rstd = rsqrtf(oct_sum(q) * (1.f / 64.f) + 64e-5f);
        float vv[8], g[8]; unpack8(*(const v4u*)(VN + (size_t)m * 512 + c), vv); unpack8(*(const v4u*)(G + (size_t)m * 512 + c), g);
        const float dt = DOT[(size_t)m * 8 + (lane >> 3)] + DOT[(size_t)NTOK * 8 + (size_t)m * 8 + (lane >> 3)];
#pragma unroll
        for (int e = 0; e < 8; ++e) a[e] = (a[e] * rstd * lg[e] + lb[e] + dt * vv[e]) * g[e];
        store8bf(RC + (size_t)m * 1024 + c, a);
    }
}
__device__ __forceinline__ bf16x8v p2_vfrag(const bf16* vt, int s2, int hf, int d) {
    v4u w;
    if (d == 0) { const v2u lo = *(const v2u*)(vt + 16 * s2 + 4 * hf), hi = *(const v2u*)(vt + 16 * s2 + 8 + 4 * hf); w.x = lo.x; w.y = lo.y; w.z = hi.x; w.w = hi.y; }
    else { const v2u lo = *(const v2u*)(vt + 28 - 16 * s2 - 4 * hf), hi = *(const v2u*)(vt + 20 - 16 * s2 - 4 * hf);
        w.x = __builtin_amdgcn_alignbit(lo.y, lo.y, 16); w.y = __builtin_amdgcn_alignbit(lo.x, lo.x, 16); w.z = __builtin_amdgcn_alignbit(hi.y, hi.y, 16); w.w = __builtin_amdgcn_alignbit(hi.x, hi.x, 16); }
    return __builtin_bit_cast(bf16x8v, w);
}
__device__ __forceinline__ void p5_pass2_wave(KPtr p, int X) {
    int lane; PG8_LANE(lane);
    const int r = lane & 31, hf = lane >> 5;
    const int chain = X >> 1, wq = X & 1;
    int b, h, d, m0, T, tbase; const float* s0 = nullptr; float* sfin = nullptr;
    if (chain < 32) { b = chain >> 4; h = (chain >> 1) & 7; d = chain & 1; m0 = NCTX + b * 2048; T = 2048; tbase = 1024 + (b * 8 + h) * 64; s0 = (d == 0 ? p->in[I_SF] : p->in[I_SB]) + (size_t)(b * 8 + h) * 4096; }
    else { const int cc = chain - 32; b = cc >> 4; h = (cc >> 1) & 7; d = cc & 1; m0 = b * 256; T = 256; tbase = (b * 8 + h) * 8; sfin = p->out + (size_t)NTOK * DM + (size_t)d * 524288 + (size_t)(b * 8 + h) * 4096; }
    const int nc = T / 32, vcol = 32 * wq + r;
    const bf16* VT = (const bf16*)((const unsigned char*)p->out + DO_VT) + (size_t)m0 * 512 + (size_t)h * 64 * T + (size_t)vcol * T;
    float* Y = (float*)(p->ws + (d == 0 ? WS_YF : WS_YB)) + (size_t)m0 * 512 + h * 64 + vcol;
    const float* GC = (const float*)(p->ws + WS_GC);
    f32x16 S0t, S1t;
    if (s0) {
#pragma unroll
        for (int g = 0; g < 4; ++g) { const f32x4 x0 = *(const f32x4*)(s0 + (size_t)vcol * 64 + 8 * g + 4 * hf), x1 = *(const f32x4*)(s0 + (size_t)vcol * 64 + 32 + 8 * g + 4 * hf);
#pragma unroll
            for (int e = 0; e < 4; ++e) { S0t[4 * g + e] = x0[e]; S1t[4 * g + e] = x1[e]; } }
    } else {
#pragma unroll
        for (int e = 0; e < 16; ++e) { S0t[e] = 0.f; S1t[e] = 0.f; }
    }
    bf16x8v fGP[2][4], fKP[2][2], fRP[4], fPP[2], fV[2]; f32x4 gam[2][4];
#define P2_REC(n_) (p->ws + ((((tbase + (n_)) * 2 + d) < 2048) ? WS_RECA + (size_t)((tbase + (n_)) * 2 + d) * REC_BYTES : WS_RECB + (size_t)((tbase + (n_)) * 2 + d - 2048) * REC_BYTES) + lane * 16)
#define P2_LOAD_Y(n_) do { const unsigned char* rb_ = P2_REC(n_); _Pragma("unroll") for (int s4 = 0; s4 < 4; ++s4) fRP[s4] = *(const bf16x8v*)(rb_ + (12 + s4) * 1024); \
        _Pragma("unroll") for (int s2 = 0; s2 < 2; ++s2) fPP[s2] = *(const bf16x8v*)(rb_ + (16 + s2) * 1024); } while (0)
#define P2_LOAD_S(n_) do { const unsigned char* rb_ = P2_REC(n_); const float* gc_ = GC + (size_t)((tbase + (n_)) * 2 + d) * 64 + 4 * hf; \
        _Pragma("unroll") for (int a = 0; a < 2; ++a) { _Pragma("unroll") for (int s4 = 0; s4 < 4; ++s4) fGP[a][s4] = *(const bf16x8v*)(rb_ + (a * 4 + s4) * 1024); \
            _Pragma("unroll") for (int s2 = 0; s2 < 2; ++s2) fKP[a][s2] = *(const bf16x8v*)(rb_ + (8 + a * 2 + s2) * 1024); \
            _Pragma("unroll") for (int g = 0; g < 4; ++g) gam[a][g] = *(const f32x4*)(gc_ + 32 * a + 8 * g); } \
        _Pragma("unroll") for (int s2 = 0; s2 < 2; ++s2) fV[s2] = p2_vfrag(VT + 32 * (n_), s2, hf, d); } while (0)
    { const int n0 = d ? nc - 1 : 0; P2_LOAD_Y(n0); P2_LOAD_S(n0); }
    for (int ci = 0; ci < nc; ++ci) {
        const int n = d ? nc - 1 - ci : ci, nn = d ? n - 1 : n + 1; const bool more = ci + 1 < nc;
        bf16x8v sb[4]; sb[0] = pack_acc(S0t, 0); sb[1] = pack_acc(S0t, 1); sb[2] = pack_acc(S1t, 0); sb[3] = pack_acc(S1t, 1);
        f32x16 y;
#pragma unroll
        for (int e = 0; e < 16; ++e) y[e] = 0.f;
#pragma unroll
        for (int s4 = 0; s4 < 4; ++s4) y = MFMA32(fRP[s4], sb[s4], y);
#pragma unroll
        for (int s2 = 0; s2 < 2; ++s2) y = MFMA32(fPP[s2], fV[s2], y);
        if (more) P2_LOAD_Y(nn);
        { float* yo = Y + (size_t)(32 * n) * 512;
#pragma unroll
            for (int e = 0; e < 16; ++e) yo[(size_t)(d ? 31 - trow(e, hf) : trow(e, hf)) * 512] = y[e]; }
        f32x16 n0t, n1t;
#pragma unroll
        for (int g = 0; g < 4; ++g)
#pragma unroll
            for (int e = 0; e < 4; ++e) { n0t[4 * g + e] = S0t[4 * g + e] * gam[0][g][e]; n1t[4 * g + e] = S1t[4 * g + e] * gam[1][g][e]; }
#pragma unroll
        for (int s4 = 0; s4 < 4; ++s4) { n0t = MFMA32(fGP[0][s4], sb[s4], n0t); n1t = MFMA32(fGP[1][s4], sb[s4], n1t); }
#pragma unroll
        for (int s2 = 0; s2 < 2; ++s2) { n0t = MFMA32(fKP[0][s2], fV[s2], n0t); n1t = MFMA32(fKP[1][s2], fV[s2], n1t); }
        S0t = n0t; S1t = n1t;
        if (more) P2_LOAD_S(nn);
    }
    if (sfin) {
#pragma unroll
        for (int g = 0; g < 4; ++g) { *(f32x4*)(sfin + (size_t)vcol * 64 + 8 * g + 4 * hf) = (f32x4){S0t[4 * g], S0t[4 * g + 1], S0t[4 * g + 2], S0t[4 * g + 3]};
            *(f32x4*)(sfin + (size_t)vcol * 64 + 32 + 8 * g + 4 * hf) = (f32x4){S1t[4 * g], S1t[4 * g + 1], S1t[4 * g + 2], S1t[4 * g + 3]}; }
    }
#undef P2_REC
#undef P2_LOAD_Y
#undef P2_LOAD_S
}

constexpr int P2R_NS = 5, P2R_SLOT = 25600, P2R_GAM = 18432, P2R_V = 19456, P2R_SB = 21504, P2R_FLAGS = P2R_NS * P2R_SLOT, P2R_NH = 6;
__device__ __forceinline__ void p2_chain_decode(int chain, KPtr p, int& b, int& h, int& d, int& m0, int& T, int& tbase) {
    if (chain < 32) { b = chain >> 4; h = (chain >> 1) & 7; d = chain & 1; m0 = NCTX + b * 2048; T = 2048; tbase = 1024 + (b * 8 + h) * 64; }
    else { const int cc = chain - 32; b = cc >> 4; h = (cc >> 1) & 7; d = cc & 1; m0 = b * 256; T = 256; tbase = (b * 8 + h) * 8; }
}
__device__ __forceinline__ void p5_ring_helper(KPtr p, LAS unsigned char* lds, int X, int hidx) {
    int lane; PG8_LANE(lane);
    const int r = lane & 31, hf = lane >> 5, chain = X >> 1, wq = X & 1;
    int b, h, d, m0, T, tbase; p2_chain_decode(chain, p, b, h, d, m0, T, tbase);
    const int nc = T / 32, vcol = 32 * wq + r;
    const bf16* VT = (const bf16*)((const unsigned char*)p->out + DO_VT) + (size_t)m0 * 512 + (size_t)h * 64 * T + (size_t)vcol * T;
    const float* GC = (const float*)(p->ws + WS_GC);
    volatile LAS unsigned* flags = (volatile LAS unsigned*)(lds + P2R_FLAGS);
    for (int m = hidx; m < nc; m += P2R_NH) {
        const int n = d ? nc - 1 - m : m, wt = (tbase + n) * 2 + d, slot = m % P2R_NS;
        const unsigned char* rb = p->ws + (wt < 2048 ? WS_RECA + (size_t)wt * REC_BYTES : WS_RECB + (size_t)(wt - 2048) * REC_BYTES) + lane * 16;
        bf16x8v f[18];
#pragma unroll
        for (int i = 0; i < 18; ++i) f[i] = *(const bf16x8v*)(rb + i * 1024);
        const float gv = GC[(size_t)wt * 64 + lane];
        const bf16x8v v0 = p2_vfrag(VT + 32 * n, 0, hf, d), v1 = p2_vfrag(VT + 32 * n, 1, hf, d);
        while ((int)flags[5] < m - P2R_NS + 1 || (int)flags[13] < m - P2R_NS + 1) __builtin_amdgcn_s_sleep(2);
        LAS unsigned char* sl = lds + slot * P2R_SLOT;
#pragma unroll
        for (int i = 0; i < 18; ++i) *(LAS bf16x8v*)(sl + i * 1024 + lane * 16) = f[i];
        ((LAS float*)(sl + P2R_GAM))[lane] = gv;
        *(LAS bf16x8v*)(sl + P2R_V + lane * 16) = v0; *(LAS bf16x8v*)(sl + P2R_V + 1024 + lane * 16) = v1;
        asm volatile("s_waitcnt lgkmcnt(0)" ::: "memory");
        if (lane == 0) flags[slot] = (unsigned)(m + 1);
    }
}
__device__ __forceinline__ void p5_ring_ywave(KPtr p, LAS unsigned char* lds, int X) {
    int lane; PG8_LANE(lane);
    const int r = lane & 31, hf = lane >> 5, chain = X >> 1, wq = X & 1;
    int b, h, d, m0, T, tbase; p2_chain_decode(chain, p, b, h, d, m0, T, tbase);
    const int nc = T / 32, vcol = 32 * wq + r;
    float* Y = (float*)(p->ws + (d == 0 ? WS_YF : WS_YB)) + (size_t)m0 * 512 + h * 64 + vcol;
    volatile LAS unsigned* flags = (volatile LAS unsigned*)(lds + P2R_FLAGS);
    for (int m = 0; m < nc; ++m) {
        const int n = d ? nc - 1 - m : m, slot = m % P2R_NS;
        while (flags[8 + slot] != (unsigned)(m + 1)) __builtin_amdgcn_s_sleep(1);
        asm volatile("" ::: "memory");
        const LAS unsigned char* sl = lds + slot * P2R_SLOT + lane * 16;
        f32x16 y;
#pragma unroll
        for (int e = 0; e < 16; ++e) y[e] = 0.f;
#pragma unroll
        for (int s4 = 0; s4 < 4; ++s4) y = MFMA32(*(const LAS bf16x8v*)(sl + (12 + s4) * 1024), *(const LAS bf16x8v*)(sl + P2R_SB + s4 * 1024), y);
        y = MFMA32(*(const LAS bf16x8v*)(sl + 16 * 1024), *(const LAS bf16x8v*)(sl + P2R_V), y); y = MFMA32(*(const LAS bf16x8v*)(sl + 17 * 1024), *(const LAS bf16x8v*)(sl + P2R_V + 1024), y);
        asm volatile("s_waitcnt lgkmcnt(0)" ::: "memory");
        if (lane == 0) flags[13] = (unsigned)(m + 1);
        { float* yo = Y + (size_t)(32 * n) * 512;
#pragma unroll
            for (int e = 0; e < 16; ++e) yo[(size_t)(d ? 31 - trow(e, hf) : trow(e, hf)) * 512] = y[e]; }
    }
}
__device__ __forceinline__ void p5_ring_consumer(KPtr p, LAS unsigned char* lds, int X) {
    int lane; PG8_LANE(lane);
    const int r = lane & 31, hf = lane >> 5, chain = X >> 1, wq = X & 1;
    int b, h, d, m0, T, tbase; p2_chain_decode(chain, p, b, h, d, m0, T, tbase);
    const float* s0 = (chain < 32) ? (d == 0 ? p->in[I_SF] : p->in[I_SB]) + (size_t)(b * 8 + h) * 4096 : nullptr;
    float* sfin = (chain < 32) ? nullptr : p->out + (size_t)NTOK * DM + (size_t)d * 524288 + (size_t)(b * 8 + h) * 4096;
    const int nc = T / 32, vcol = 32 * wq + r;
    volatile LAS unsigned* flags = (volatile LAS unsigned*)(lds + P2R_FLAGS);
    f32x16 S0t, S1t;
    if (s0) {
#pragma unroll
        for (int g = 0; g < 4; ++g) { const f32x4 x0 = *(const f32x4*)(s0 + (size_t)vcol * 64 + 8 * g + 4 * hf), x1 = *(const f32x4*)(s0 + (size_t)vcol * 64 + 32 + 8 * g + 4 * hf);
#pragma unroll
            for (int e = 0; e < 4; ++e) { S0t[4 * g + e] = x0[e]; S1t[4 * g + e] = x1[e]; } }
    } else {
#pragma unroll
        for (int e = 0; e < 16; ++e) { S0t[e] = 0.f; S1t[e] = 0.f; }
    }
    bf16x8v gpA[8], kpA[4], v0A, v1A, gpB[8], kpB[4], v0B, v1B;
#define C_WAIT(m_) do { while (flags[(m_) % P2R_NS] != (unsigned)((m_) + 1)) __builtin_amdgcn_s_sleep(1); asm volatile("" ::: "memory"); } while (0)
#define C_LOAD(m_, GP_, KP_, V0_, V1_) do { const LAS unsigned char* sl_ = lds + ((m_) % P2R_NS) * P2R_SLOT + lane * 16; \
        _Pragma("unroll") for (int i_ = 0; i_ < 8; ++i_) GP_[i_] = *(const LAS bf16x8v*)(sl_ + i_ * 1024); \
        _Pragma("unroll") for (int i_ = 0; i_ < 4; ++i_) KP_[i_] = *(const LAS bf16x8v*)(sl_ + (8 + i_) * 1024); \
        V0_ = *(const LAS bf16x8v*)(sl_ + P2R_V); V1_ = *(const LAS bf16x8v*)(sl_ + P2R_V + 1024); } while (0)
#define C_STEP(m_, GP_, KP_, V0_, V1_, NGP_, NKP_, NV0_, NV1_) do { const int slot_ = (m_) % P2R_NS; \
        bf16x8v sb_[4]; sb_[0] = pack_acc(S0t, 0); sb_[1] = pack_acc(S0t, 1); sb_[2] = pack_acc(S1t, 0); sb_[3] = pack_acc(S1t, 1); \
        { LAS unsigned char* slw_ = lds + slot_ * P2R_SLOT + P2R_SB + lane * 16; _Pragma("unroll") for (int s4 = 0; s4 < 4; ++s4) *(LAS bf16x8v*)(slw_ + s4 * 1024) = sb_[s4]; } \
        asm volatile("" ::: "memory"); if (lane == 0) flags[8 + slot_] = (unsigned)((m_) + 1); \
        f32x16 n0_, n1_; { const LAS float* gl_ = (const LAS float*)(lds + slot_ * P2R_SLOT + P2R_GAM) + 4 * hf; \
            _Pragma("unroll") for (int g = 0; g < 4; ++g) { const f32x4 g0 = *(const LAS f32x4*)(gl_ + 8 * g), g1 = *(const LAS f32x4*)(gl_ + 32 + 8 * g); \
                _Pragma("unroll") for (int e = 0; e < 4; ++e) { n0_[4 * g + e] = S0t[4 * g + e] * g0[e]; n1_[4 * g + e] = S1t[4 * g + e] * g1[e]; } } } \
        asm volatile("s_waitcnt lgkmcnt(0)" ::: "memory"); if (lane == 0) flags[5] = (unsigned)((m_) + 1);     \
        _Pragma("unroll") for (int s4 = 0; s4 < 4; ++s4) { n0_ = MFMA32(GP_[s4], sb_[s4], n0_); n1_ = MFMA32(GP_[4 + s4], sb_[s4], n1_); } \
        if ((m_) + 1 < nc) { C_WAIT((m_) + 1); C_LOAD((m_) + 1, NGP_, NKP_, NV0_, NV1_); }     \
        n0_ = MFMA32(KP_[0], V0_, n0_); n0_ = MFMA32(KP_[1], V1_, n0_); n1_ = MFMA32(KP_[2], V0_, n1_); n1_ = MFMA32(KP_[3], V1_, n1_); \
        S0t = n0_; S1t = n1_; } while (0)
    C_WAIT(0); C_LOAD(0, gpA, kpA, v0A, v1A);
    for (int m = 0; m < nc; m += 2) {
        C_STEP(m, gpA, kpA, v0A, v1A, gpB, kpB, v0B, v1B);
        C_STEP(m + 1, gpB, kpB, v0B, v1B, gpA, kpA, v0A, v1A);
    }
#undef C_WAIT
#undef C_LOAD
#undef C_STEP
    if (sfin) {
#pragma unroll
        for (int g = 0; g < 4; ++g) { *(f32x4*)(sfin + (size_t)vcol * 64 + 8 * g + 4 * hf) = (f32x4){S0t[4 * g], S0t[4 * g + 1], S0t[4 * g + 2], S0t[4 * g + 3]};
            *(f32x4*)(sfin + (size_t)vcol * 64 + 32 + 8 * g + 4 * hf) = (f32x4){S1t[4 * g], S1t[4 * g + 1], S1t[4 * g + 2], S1t[4 * g + 3]}; }
    }
}
__global__ void __launch_bounds__(NWAVES * 64, 2) fwd_kernel(Params p_unused) {
    extern __shared__ __attribute__((aligned(16))) unsigned char lds_raw[];
    LAS unsigned char* lds = (LAS unsigned char*)lds_raw;
    volatile LAS unsigned* MISC = (volatile LAS unsigned*)(lds + MISC_OFF);
    const int G = gridDim.x, bx = blockIdx.x, vcu = (G % 8 == 0) ? (bx % 8) * (G / 8) + bx / 8 : bx;
    const int NGW = G * NWAVES;
    const int wave0 = __builtin_amdgcn_readfirstlane(threadIdx.x >> 6);
    for (int u = threadIdx.x; u < (LDS_BYTES - LDSCTL_OFF) / 4; u += NWAVES * 64) ((LAS unsigned*)(lds + LDSCTL_OFF))[u] = 0u;
#define TID_VARS KPtr p = kp0; asm volatile("" : "+s"(p)); unsigned char* ws = p->ws; (void)ws; int lane; PG8_LANE(lane); const int wave = wave0, tid = wave0 * 64 + lane, gw = vcu * NWAVES + wave; (void)tid; (void)gw;
    __syncthreads();
    const KPtr kp0 = (KPtr)__builtin_amdgcn_kernarg_segment_ptr();
    const int lo = kp0->ph_lo, hi = kp0->ph_hi, dupm = kp0->dupmask;
    const bool multi = (hi - lo) > 1;
    XcdBarrier bar; bar.bar = (unsigned*)(kp0->ws + WS_CTL) + CW_BAR; bar.x = 0; bar.st = nullptr;
    if (multi) bar = xcd_barrier_post((unsigned*)(kp0->ws + WS_CTL) + CW_BAR, MISC + 8);
#ifndef PHMASK
#define PHMASK 0xffff
#endif
#define IN(k) (((PHMASK >> (k)) & 1) && lo <= (k) && (k) < hi)
#ifndef DUPMASK
#define DUPMASK 0
#endif
#define REP(k) for (int rep_ = 0; rep_ < 1 + ((dupm >> (k)) & 1); ++rep_)
#ifndef BARDUP
#define BARDUP 0
#endif
#define SEAM(k) do { if (IN(k) && IN((k) + 1)) { xcd_barrier(bar, wave0); if (BARDUP) xcd_barrier(bar, wave0); } } while (0)
    if (IN(0)) REP(0) { TID_VARS p0_prologue(p, lds, vcu, G, tid); }
    if (IN(1)) REP(1) { TID_VARS
        if (IN(0)) {
            if (tid == 0) { unsigned* cnt = (unsigned*)(ws + WS_CTL) + CW_MODCNT; unsigned sp = 0;
                while (__hip_atomic_load(cnt, __ATOMIC_RELAXED, __HIP_MEMORY_SCOPE_AGENT) < 192u * (1u + ((dupm >> 0) & 1))) { __builtin_amdgcn_s_sleep(2); if (++sp > (1u << 22)) break; }
                __builtin_amdgcn_fence(__ATOMIC_ACQUIRE, "agent"); asm volatile("s_waitcnt vmcnt(0)" ::: "memory"); }
            __syncthreads();
        }
        p1_norm1(p, gw, NGW, lane); } SEAM(1);
    if (IN(2)) REP(2) {
        KPtr p = kp0; asm volatile("" : "+s"(p)); unsigned char* ws = p->ws;
        typedef pg8::Gemm<1024, 1024, 1024, 1 << 20, 0, 1 << 20, 0> GT; GT g{(const bf16*)(ws + WS_XN), (const bf16*)(ws + WS_WIN)};
        pg8::StaticOrder S; S.init(NTOK, N_IN, G, bx);
        EpiG1 E{(bf16*)(ws + WS_RKV), (bf16*)(ws + WS_PB), (bf16*)(ws + WS_A2)};
        pg8::gemm_phase<EpiG1, pg8::StaticOrder, GT, true, true>(lds, g, S, E, wave0);
    } SEAM(2);
    if (IN(4)) REP(4) { TID_VARS
        if (wave < 4) { LAS unsigned char* wl = lds + wave * P1_WAVE_LDS;
            for (int W = vcu * 4 + wave; W < 4096; W += G * 4) { if (W & 1) p4_pass1<1>(p, wl, W >> 1); else p4_pass1<0>(p, wl, W >> 1); } }
        __syncthreads();
    } SEAM(4);
    if (IN(5)) REP(5) { KPtr p = kp0; asm volatile("" : "+s"(p));
        if (G == 256) {
            if (vcu < 64) {
                if (wave0 == 0) { int l_; PG8_LANE(l_); if (l_ < 16) ((volatile LAS unsigned*)(lds + P2R_FLAGS))[l_] = 0u; }
                __syncthreads();
                if (wave0 == 0) p5_ring_consumer(p, lds, vcu); else if (wave0 == 1) p5_ring_ywave(p, lds, vcu); else p5_ring_helper(p, lds, vcu, wave0 - 2);
                __syncthreads();
            } else {
                if (wave0 < 3) { const int Xc = (vcu - 64) * 3 + wave0; if (Xc < 512) p5_pass2_wave(p, 64 + Xc); }
                else { int lane; PG8_LANE(lane); LAS float* scr = (LAS float*)(lds + wave0 * 16384);
                    bf16* W1 = (bf16*)(p->ws + WS_W1); bf16* W2 = (bf16*)(p->ws + WS_W2);
                    for (int it = (vcu - 64) * 5 + (wave0 - 3); it < 4096; it += 192 * 5) { if (it < 2048) p0_transpose_item(p->in[I_W1], DFF, W1, 1024, 0, scr, it, lane); else p0_transpose_item(p->in[I_W2], DM, W2, 4096, 0, scr, it - 2048, lane); } }
            }
        } else {
            for (int X = wave0 * G + vcu; X < 576; X += NWAVES * G) p5_pass2_wave(p, X);
            { int lane; PG8_LANE(lane); LAS float* scr = (LAS float*)(lds + wave0 * 16384); bf16* W1 = (bf16*)(p->ws + WS_W1); bf16* W2 = (bf16*)(p->ws + WS_W2);
              for (int it = vcu * NWAVES + wave0; it < 4096; it += G * NWAVES) { if (it < 2048) p0_transpose_item(p->in[I_W1], DFF, W1, 1024, 0, scr, it, lane); else p0_transpose_item(p->in[I_W2], DM, W2, 4096, 0, scr, it - 2048, lane); } }
        }
    } SEAM(5);
    if (IN(6)) REP(6) { TID_VARS for (int it = vcu; it < NTOK / 32; it += G) p4_conv_item(p, lds, it, tid); p6_post(p, gw, NGW, lane); } SEAM(6);
    if (IN(7)) REP(7) {
        KPtr p = kp0; asm volatile("" : "+s"(p)); unsigned char* ws = p->ws;
        typedef pg8::Gemm<1024, 512, 512, 4, 512, 1 << 20, 0> GT; GT g{(const bf16*)(ws + WS_RC), (const bf16*)(ws + WS_WOUT)};
        pg8::StaticOrder S; S.init(NTOK, 2048, G, bx);
        EpiG3F E{(const bf16*)(ws + WS_PB), (bf16*)(ws + WS_GM), (unsigned*)(ws + WS_CTL) + CW_G3FLAG};
        pg8::gemm_phase<EpiG3F, pg8::StaticOrder, GT, false, true>(lds, g, S, E, wave0);
    } SEAM(7);
    if (IN(8)) REP(8) {
        KPtr p = kp0; asm volatile("" : "+s"(p)); unsigned char* ws = p->ws;
        typedef pg8::Gemm<1024, 1024, 512, 4, 512, 4, 512> GT; GT g{(const bf16*)(ws + WS_GM), (const bf16*)(ws + WS_WO)};
        pg8::StaticOrder S; S.init(NTOK, 2048, G, bx);
        EpiPart E{(bf16*)(ws + WS_PART)};
        pg8::gemm_phase<EpiPart, pg8::StaticOrder, GT, true, true>(lds, g, S, E, wave0);
    } SEAM(8);
    if (IN(9)) REP(9) { TID_VARS p7_res_norm2(p, gw, NGW, lane); } SEAM(9);
    if (IN(10)) REP(10) {
        KPtr p = kp0; asm volatile("" : "+s"(p)); unsigned char* ws = p->ws;
        typedef pg8::Gemm<1024, 1024, 1024, 1 << 20, 0, 1 << 20, 0> GT; GT g{(const bf16*)(ws + WS_XN), (const bf16*)(ws + WS_W1)};
        pg8::StaticOrder S; S.init(NTOK, DFF, G, bx);
        EpiG5 E{(bf16*)(ws + WS_H)};
        pg8::gemm_phase<EpiG5, pg8::StaticOrder, GT, true, true>(lds, g, S, E, wave0);
    } SEAM(10);
    if (IN(11)) REP(11) {
        KPtr p = kp0; asm volatile("" : "+s"(p)); unsigned char* ws = p->ws;
        typedef pg8::Gemm<4096, 4096, 2048, 4, 2048, 4, 2048> GT; GT g{(const bf16*)(ws + WS_H), (const bf16*)(ws + WS_W2)};
        pg8::StaticOrder S; S.init(NTOK, 2048, G, bx);
        EpiPart E{(bf16*)(ws + WS_PART)};
        pg8::gemm_phase<EpiPart, pg8::StaticOrder, GT, true, true>(lds, g, S, E, wave0);
    } SEAM(11);
    if (IN(12)) REP(12) { TID_VARS p12_final(p, gw, NGW, lane); }
#undef IN
#undef SEAM
}

extern "C" void kernel_launch(void* const* d_in, const int* in_sizes, int n_in, void* d_out, int out_size, void* d_ws, size_t ws_size, hipStream_t stream) {
    static int grid = 0;
    if (grid == 0) {
        if (n_in != 36 || ws_size < WS_END) { fprintf(stderr, "kernel_launch: unexpected n_in %d / ws %zu\n", n_in, ws_size); grid = -1; return; }
        int dev = 0, cus = 0, per_cu = 0;
        if (hipGetDevice(&dev) != hipSuccess || hipDeviceGetAttribute(&cus, hipDeviceAttributeMultiprocessorCount, dev) != hipSuccess) { grid = -1; return; }
        if (hipFuncSetAttribute((const void*)fwd_kernel, hipFuncAttributeMaxDynamicSharedMemorySize, LDS_BYTES) != hipSuccess) { fprintf(stderr, "kernel_launch: hipFuncSetAttribute failed\n"); grid = -1; return; }
        if (hipOccupancyMaxActiveBlocksPerMultiprocessor(&per_cu, (const void*)fwd_kernel, NWAVES * 64, LDS_BYTES) != hipSuccess || per_cu < 1)
            fprintf(stderr, "kernel_launch: occupancy query reports %d\n", per_cu);
        (void)hipGetLastError();
        grid = cus;
    }
    if (grid < 0) return;
    if (hipMemsetAsync((char*)d_ws + WS_CTL, 0, CTL_ZERO_BYTES, stream) != hipSuccess) { fprintf(stderr, "kernel_launch: memset failed\n"); return; }
    Params a{};
    for (int i = 0; i < 36; ++i) a.in[i] = (const float*)d_in[i];
    a.out = (float*)d_out; a.ws = (unsigned char*)d_ws; a.dupmask = DUPMASK;
#if MK_ONE_LAUNCH
    a.ph_lo = 0; a.ph_hi = NPH;
    hipLaunchKernelGGL(fwd_kernel, dim3(grid), dim3(NWAVES * 64), LDS_BYTES, stream, a);
#else
    for (int ph = 0; ph < NPH; ++ph) { a.ph_lo = ph; a.ph_hi = ph + 1; hipLaunchKernelGGL(fwd_kernel, dim3(grid), dim3(NWAVES * 64), LDS_BYTES, stream, a); }
#endif
    const hipError_t le = hipPeekAtLastError();
    if (le != hipSuccess) fprintf(stderr, "kernel_launch: launch failed: %s\n", hipGetErrorName(le));
}
```

```cpp
#include <hip/hip_runtime.h>
#include <cstdio>
#include <cstdint>
namespace pg8 {
#define PG8_LAS __attribute__((address_space(3)))
typedef unsigned short bf16_t;
typedef short bf16x8 __attribute__((ext_vector_type(8)));
typedef float f32x4 __attribute__((ext_vector_type(4)));
typedef unsigned u32x4 __attribute__((ext_vector_type(4)));
constexpr int BM = 256, BK = 64, HALF = 128, HTB = HALF * BK * 2  , STAGE_BYTES = 8 * HTB, NXCD = 8, WGM = 8;

__host__ __device__ __forceinline__ int lds_byte(int r, int c) { const int st = (r >> 4) * 2 + (c >> 5), rr = r & 15, cc = c & 31, ob = rr * 64 + cc * 2; return st * 1024 + (ob ^ (((ob >> 9) & 1) << 5)); }
__host__ __device__ __forceinline__ void stage_rc(int b, int& R, int& C) { const int st = b / 1024, sb = b % 1024, swz = sb ^ (((sb >> 9) & 1) << 5); R = (st >> 1) * 16 + swz / 64; C = (st & 1) * 32 + (swz % 64) / 2; }
__host__ __device__ __forceinline__ int perm32(int rho) { const int n = rho >> 4, i = rho & 15; return 8 * (i >> 2) + 4 * n + (i & 3); }

struct Unit { int pm, pn; };
template <int LDA, int LDB, int KK, int GA, int ACOFF, int GB, int BCOFF>
struct Gemm { const bf16_t* A; const bf16_t* Bt;
    static constexpr int lda = LDA, ldb = LDB, K = KK;
    __device__ __forceinline__ const char* aptr(const Unit& u) const { return (const char*)(A + (size_t)u.pm * BM * LDA + (size_t)(u.pn / GA) * ACOFF); }
    __device__ __forceinline__ const char* bptr(const Unit& u) const { return (const char*)(Bt + (size_t)(u.pn % GB) * BM * LDB + (size_t)(u.pn / GB) * BCOFF); }
};

struct StaticOrder {
    int nM, nN, nwg, G, c;
    __host__ __device__ void init(int M, int N, int G_, int c_) { nM = M / BM; nN = N / BM; nwg = nM * nN; G = G_; c = c_; }
    __host__ __device__ bool next(int i, Unit& u) const {
        const long L = (long)i * G + c; if (L >= nwg) return false;
        int wgid = (int)L; { const int q = nwg / NXCD, r = nwg % NXCD, xcd = wgid % NXCD, off = wgid / NXCD; wgid = (xcd < r ? xcd * (q + 1) : r * (q + 1) + (xcd - r) * q) + off; }
        const int nig = WGM * nN, gid = wgid / nig, fm = gid * WGM, gsz = (nM - fm) < WGM ? (nM - fm) : WGM;
        u.pm = fm + ((wgid % nig) % gsz); u.pn = (wgid % nig) / gsz; return true;
    }
    __device__ __forceinline__ void a_ready(const Unit&) const {}
    __device__ __forceinline__ void done(const Unit&) const {}
};
#define PG8_LANE(x) asm volatile("v_mbcnt_lo_u32_b32 %0, -1, 0\n\tv_mbcnt_hi_u32_b32 %0, -1, %0" : "=v"(x))
typedef __bf16 bf16n2 __attribute__((ext_vector_type(2)));
typedef float f32n2 __attribute__((ext_vector_type(2)));
__device__ __forceinline__ unsigned cvt_pk_bf16(float lo, float hi) { const f32n2 v = {lo, hi}; const bf16n2 b = __builtin_convertvector(v, bf16n2); return __builtin_bit_cast(unsigned, b); }

template <class Epi, class Sched, class GemmT, bool ALIGN_EPI = false, bool SP2 = false>
__device__ __forceinline__ void gemm_phase(PG8_LAS unsigned char* lds, const GemmT g, const Sched& S, const Epi& E, const int wid) {
    int lane; PG8_LANE(lane);
    const int tid = wid * 64 + lane, wr = wid >> 2, wc = wid & 3, fr = lane & 15, fq = lane >> 4;
    const int K = g.K, nt = K / BK;
    unsigned voffA[2], voffB[2];
#pragma unroll
    for (int i = 0; i < 2; ++i) { int R, C; stage_rc(tid * 16 + i * 8192, R, C); const int Rb = Epi::PERM ? ((R & ~31) + perm32(R & 31)) : R;
        voffA[i] = (unsigned)(R * g.lda + C) * 2u; voffB[i] = (unsigned)(Rb * g.ldb + C) * 2u; }
    const size_t kstep = (size_t)(BK * 2);
    const size_t hstepA = (size_t)HALF * g.lda * 2, hstepB = (size_t)HALF * g.ldb * 2;
    const unsigned ldsw = (unsigned)wid * 1024u;
    const int aoff = lds_byte(wr * 64 + fr, fq * 8), boff = lds_byte(wc * 32 + fr, fq * 8);
#define PG8_SA(b, h) (((b) * 2 + (h)) * HTB)
#define PG8_SB(b, h) ((4 + (b) * 2 + (h)) * HTB)
#define PG8_STAGE(bufoff, gbase, voff) do { _Pragma("unroll") for (int _i = 0; _i < 2; ++_i) \
        __builtin_amdgcn_global_load_lds((const unsigned*)((const char*)(gbase) + (voff)[_i]), (PG8_LAS unsigned*)(lds + (bufoff) + ldsw + _i * 8192), 16, 0, 0); } while (0)
#define PG8_LDA(dst, b, h) do { _Pragma("unroll") for (int m = 0; m < 4; ++m) _Pragma("unroll") for (int k = 0; k < 2; ++k) dst[m][k] = *(const PG8_LAS bf16x8*)(lds + PG8_SA(b, h) + aoff + m * 2048 + k * 1024); } while (0)
#define PG8_LDB(dst, b, h) do { _Pragma("unroll") for (int n = 0; n < 2; ++n) _Pragma("unroll") for (int k = 0; k < 2; ++k) dst[n][k] = *(const PG8_LAS bf16x8*)(lds + PG8_SB(b, h) + boff + n * 2048 + k * 1024); } while (0)
#define PG8_MMA(ai, bj, At, Bt) do { __builtin_amdgcn_s_setprio(1); _Pragma("unroll") for (int m = 0; m < 4; ++m) _Pragma("unroll") for (int n = 0; n < 2; ++n) _Pragma("unroll") for (int k = 0; k < 2; ++k) \
        acc[ai][bj][m][n] = __builtin_amdgcn_mfma_f32_16x16x32_bf16(Bt[n][k], At[m][k], acc[ai][bj][m][n], 0, 0, 0); __builtin_amdgcn_s_setprio(0); } while (0)
#define PG8_WAIT_V(n) asm volatile("s_waitcnt vmcnt(" #n ")" ::: "memory")
#define PG8_WAIT_L(n) asm volatile("s_waitcnt lgkmcnt(" #n ")" ::: "memory")
#define PG8_BAR __builtin_amdgcn_s_barrier()
#define PG8_SCHED __builtin_amdgcn_sched_barrier(0)
    Unit cur, nxt; int ui = 0;
    if (!S.next(0, cur)) return;
    f32x4 acc[2][2][4][2];
#pragma unroll
    for (int a = 0; a < 2; ++a)
#pragma unroll
        for (int b = 0; b < 2; ++b)
#pragma unroll
            for (int m = 0; m < 4; ++m)
#pragma unroll
                for (int n = 0; n < 2; ++n) acc[a][b][m][n] = (f32x4){0.f, 0.f, 0.f, 0.f};
    bf16x8 At[4][2], B0[2][2], B1[2][2];
    const char* cA = g.aptr(cur); const char* cB = g.bptr(cur);
    S.a_ready(cur);
    if constexpr (SP2) {
        PG8_STAGE(PG8_SB(0, 0), cB, voffB); PG8_STAGE(PG8_SB(0, 1), cB + hstepB, voffB); PG8_STAGE(PG8_SA(0, 0), cA, voffA); PG8_STAGE(PG8_SA(0, 1), cA + hstepA, voffA);
        if (wr == 1) PG8_BAR;
        PG8_WAIT_V(2); PG8_BAR;
        PG8_STAGE(PG8_SB(1, 0), cB + kstep, voffB); PG8_STAGE(PG8_SA(1, 0), cA + kstep, voffA); PG8_STAGE(PG8_SB(1, 1), cB + hstepB + kstep, voffB);
        PG8_WAIT_V(6); PG8_BAR;
    } else {
        PG8_STAGE(PG8_SB(0, 0), cB, voffB); PG8_STAGE(PG8_SA(0, 0), cA, voffA); PG8_STAGE(PG8_SB(0, 1), cB + hstepB, voffB); PG8_STAGE(PG8_SA(0, 1), cA + hstepA, voffA);
        if (wr == 1) PG8_BAR;
        PG8_WAIT_V(4); PG8_BAR;
        PG8_STAGE(PG8_SB(1, 0), cB + kstep, voffB); PG8_STAGE(PG8_SA(1, 0), cA + kstep, voffA); PG8_STAGE(PG8_SB(1, 1), cB + hstepB + kstep, voffB);
        PG8_WAIT_V(6); PG8_BAR;
    }
    for (;;) {
        const bool has_next = S.next(ui + 1, nxt);
        const char* nA = has_next ? g.aptr(nxt) : cA; const char* nB = has_next ? g.bptr(nxt) : cB;
        for (int t = 0; t < nt; t += 2) {
            const bool last = (t == nt - 2);
            const char* a1 = cA + (size_t)(t + 1) * kstep;
            const char* a2 = last ? nA : cA + (size_t)(t + 2) * kstep; const char* b2 = last ? nB : cB + (size_t)(t + 2) * kstep;
            const char* a3 = a2 + kstep; const char* b3 = b2 + kstep;
            if (last && has_next) S.a_ready(nxt);
            if constexpr (SP2) {
            PG8_LDB(B0, 0, 0); PG8_LDB(B1, 0, 1); PG8_SCHED; PG8_LDA(At, 0, 0); PG8_STAGE(PG8_SA(1, 1), a1 + hstepA, voffA);
            PG8_WAIT_V(8); PG8_WAIT_L(0); PG8_BAR; PG8_MMA(0, 0, At, B0); PG8_MMA(0, 1, At, B1); PG8_BAR; PG8_SCHED;
            PG8_LDA(At, 0, 1); PG8_STAGE(PG8_SB(0, 0), b2, voffB); PG8_STAGE(PG8_SB(0, 1), b2 + hstepB, voffB); PG8_STAGE(PG8_SA(0, 0), a2, voffA);
            PG8_WAIT_V(8); PG8_WAIT_L(0); PG8_BAR; PG8_MMA(1, 0, At, B0); PG8_MMA(1, 1, At, B1); PG8_BAR; PG8_SCHED;
            PG8_LDB(B0, 1, 0); PG8_LDB(B1, 1, 1); PG8_SCHED; PG8_LDA(At, 1, 0); PG8_STAGE(PG8_SA(0, 1), a2 + hstepA, voffA);
            PG8_WAIT_V(8); PG8_WAIT_L(0); PG8_BAR; PG8_MMA(0, 0, At, B0); PG8_MMA(0, 1, At, B1); PG8_BAR; PG8_SCHED;
            PG8_LDA(At, 1, 1); PG8_STAGE(PG8_SB(1, 0), b3, voffB); PG8_STAGE(PG8_SB(1, 1), b3 + hstepB, voffB); PG8_STAGE(PG8_SA(1, 0), a3, voffA);
            PG8_WAIT_V(8); PG8_WAIT_L(0); PG8_BAR; PG8_MMA(1, 0, At, B0); PG8_MMA(1, 1, At, B1); PG8_BAR; PG8_SCHED;
            } else {
            PG8_LDB(B0, 0, 0); PG8_SCHED; PG8_LDA(At, 0, 0); PG8_STAGE(PG8_SA(1, 1), a1 + hstepA, voffA);
            PG8_WAIT_L(8); PG8_BAR; PG8_WAIT_L(0); PG8_MMA(0, 0, At, B0); PG8_BAR; PG8_SCHED;
            PG8_LDB(B1, 0, 1); PG8_STAGE(PG8_SB(0, 0), b2, voffB);
            PG8_BAR; PG8_WAIT_L(0); PG8_MMA(0, 1, At, B1); PG8_BAR;
            PG8_LDA(At, 0, 1); PG8_STAGE(PG8_SA(0, 0), a2, voffA);
            PG8_BAR; PG8_WAIT_L(0); PG8_MMA(1, 0, At, B0); PG8_BAR; PG8_SCHED;
            PG8_STAGE(PG8_SB(0, 1), b2 + hstepB, voffB);
            PG8_WAIT_V(6); PG8_BAR; PG8_MMA(1, 1, At, B1); PG8_BAR;
            PG8_LDB(B0, 1, 0); PG8_SCHED; PG8_LDA(At, 1, 0); PG8_STAGE(PG8_SA(0, 1), a2 + hstepA, voffA);
            PG8_WAIT_L(8); PG8_BAR; PG8_WAIT_L(0); PG8_MMA(0, 0, At, B0); PG8_BAR; PG8_SCHED;
            PG8_LDB(B1, 1, 1); PG8_STAGE(PG8_SB(1, 0), b3, voffB);
            PG8_BAR; PG8_WAIT_L(0); PG8_MMA(0, 1, At, B1); PG8_BAR;
            PG8_LDA(At, 1, 1); PG8_STAGE(PG8_SA(1, 0), a3, voffA);
            PG8_BAR; PG8_WAIT_L(0); PG8_MMA(1, 0, At, B0); PG8_BAR; PG8_SCHED;
            PG8_STAGE(PG8_SB(1, 1), b3 + hstepB, voffB);
            PG8_WAIT_V(6); PG8_BAR; PG8_MMA(1, 1, At, B1); PG8_BAR;
            }
        }
        if constexpr (ALIGN_EPI) { if (wr == 0) PG8_BAR; }
        if constexpr (!Epi::AFTER_DRAIN) { int el; PG8_LANE(el); E(acc, cur, wr, wc, el & 15, el >> 4); S.done(cur); }
        if (!has_next) break;
#pragma unroll
        for (int a = 0; a < 2; ++a)
#pragma unroll
            for (int b = 0; b < 2; ++b)
#pragma unroll
                for (int m = 0; m < 4; ++m)
#pragma unroll
                    for (int n = 0; n < 2; ++n) acc[a][b][m][n] = (f32x4){0.f, 0.f, 0.f, 0.f};
        cur = nxt; cA = nA; cB = nB; ++ui;
        if constexpr (ALIGN_EPI) { if (wr == 1) PG8_BAR; }
    }
    PG8_WAIT_V(0);
    if constexpr (!ALIGN_EPI) { if (wr == 0) PG8_BAR; }
    PG8_BAR;
    if constexpr (Epi::AFTER_DRAIN) { E.fused(acc, cur, wr, wc, fr, fq, lds, wid, lane); S.done(cur); }
#undef PG8_SA
#undef PG8_SB
#undef PG8_STAGE
#undef PG8_LDA
#undef PG8_LDB
#undef PG8_MMA
#undef PG8_WAIT_V
#undef PG8_WAIT_L
#undef PG8_BAR
#undef PG8_SCHED
}
}

constexpr int NWAVES = 8;
constexpr int NTOK = 8192, NCTX = 4096, DM = 1024, RW = 512, NH = 8, HD = 64, DFF = 4096;
constexpr int N_IN = 5888;
constexpr int NPH = 13;
#ifndef MK_ONE_LAUNCH
#define MK_ONE_LAUNCH 1
#endif
constexpr size_t MiB = 1u << 20;
constexpr size_t WS_CTL = 0, CTL_ZERO_BYTES = 64 * 1024;
constexpr size_t WS_MOD = 1 * MiB;
constexpr size_t WS_WIN = 2 * MiB;
constexpr size_t WS_B2 = 14 * MiB;
constexpr size_t WS_WOUT = 16 * MiB;
constexpr size_t WS_WO = 18 * MiB;
constexpr size_t WS_W1 = 20 * MiB;
constexpr size_t WS_W2 = 28 * MiB;
constexpr size_t WS_XN = 36 * MiB;
constexpr size_t WS_A2 = 52 * MiB;
constexpr size_t WS_RKV = 72 * MiB;
constexpr size_t WS_PB = 120 * MiB;
constexpr size_t WS_WD = 168 * MiB;
constexpr size_t WS_AL = 200 * MiB;
constexpr size_t WS_RECB = 216 * MiB;
constexpr size_t WS_GC = 252 * MiB;
constexpr size_t WS_END = 256 * MiB;
constexpr size_t WS_RECA = 168 * MiB;
constexpr size_t REC_BYTES = 18432;
constexpr size_t WS_YF = WS_RKV, WS_YB = WS_RKV + 16 * MiB, WS_RC = WS_RKV + 32 * MiB;
constexpr size_t WS_GM = WS_RKV, WS_H = WS_RKV;
constexpr size_t WS_PART = 168 * MiB;
constexpr size_t DO_G = 0, DO_V = 8 * MiB, DO_VT = 16 * MiB, DO_DOT = 24 * MiB;
constexpr int CW_MODCNT = 512;
constexpr int CW_BAR = 1024;
constexpr int RING_BYTES = 131072;
constexpr int LDSCTL_OFF = RING_BYTES, MISC_OFF = LDSCTL_OFF + 320;
constexpr int LDS_BYTES = 147456;

#define GAS __attribute__((address_space(1)))
#define LAS __attribute__((address_space(3)))
typedef unsigned short bf16;
typedef unsigned v4u __attribute__((ext_vector_type(4)));
typedef unsigned v2u __attribute__((ext_vector_type(2)));
typedef float f32x4 __attribute__((ext_vector_type(4)));
#define LDS_WAIT() asm volatile("s_waitcnt lgkmcnt(0)" ::: "memory")
#define VM_WAIT() asm volatile("s_waitcnt vmcnt(0)" ::: "memory")
__device__ __forceinline__ unsigned pk2(float lo, float hi) { return pg8::cvt_pk_bf16(lo, hi); }
__device__ __forceinline__ float bflo(unsigned u) { return __uint_as_float(u << 16); }
__device__ __forceinline__ float bfhi(unsigned u) { return __uint_as_float(u & 0xffff0000u); }
__device__ __forceinline__ float bf1(bf16 u) { return __uint_as_float((unsigned)u << 16); }
__device__ __forceinline__ float sigm(float x) { return __builtin_amdgcn_rcpf(1.0f + __expf(-x)); }
__device__ __forceinline__ float tanh_fast(float x) { const float t = __expf(2.0f * x); return 1.0f - 2.0f * __builtin_amdgcn_rcpf(t + 1.0f); }
__device__ __forceinline__ v4u pack8(const f32x4 a, const f32x4 b) { v4u w; w.x = pk2(a[0], a[1]); w.y = pk2(a[2], a[3]); w.z = pk2(b[0], b[1]); w.w = pk2(b[2], b[3]); return w; }
__device__ __forceinline__ void unpack8(const v4u w, float (&o)[8]) { o[0] = bflo(w.x); o[1] = bfhi(w.x); o[2] = bflo(w.y); o[3] = bfhi(w.y); o[4] = bflo(w.z); o[5] = bfhi(w.z); o[6] = bflo(w.w); o[7] = bfhi(w.w); }
__device__ __forceinline__ float wave_sum(float v) {
#pragma unroll
    for (int o = 1; o < 64; o <<= 1) v += __shfl_xor(v, o);
    return v;
}
__device__ __forceinline__ float oct_sum(float v) { v += __shfl_xor(v, 1); v += __shfl_xor(v, 2); v += __shfl_xor(v, 4); return v; }

#define XB_TMO      128
#define XB_XCNT(j)  (256  + 64 * (j))
#define XB_XSUB(j)  (1280 + 64 * (j))
#define XB_XGEN(j)  (2304 + 64 * (j))
#define XB_TOP      3328
#define XB_TOPGEN   3392
#define XCD_BAR_WORDS 3456
#define XB_SPIN_CAP (1u << 18)
__device__ __forceinline__ unsigned xb_ld(unsigned* p)              { return __hip_atomic_load(p, __ATOMIC_RELAXED, __HIP_MEMORY_SCOPE_AGENT); }
__device__ __forceinline__ unsigned xb_add(unsigned* p, unsigned v) { return __hip_atomic_fetch_add(p, v, __ATOMIC_RELAXED, __HIP_MEMORY_SCOPE_AGENT); }
__device__ __forceinline__ unsigned xb_xcc_id() { return (unsigned)__builtin_amdgcn_s_getreg((3 << 11) | 20) & 0xFu; }
#define XB_SPIN(cond, bar) do { unsigned _sp = 0; while (cond) { __builtin_amdgcn_s_sleep(1); \
    if ((++_sp & 255u) == 0u) { if (xb_ld(&(bar)[XB_TMO])) break; if (_sp > XB_SPIN_CAP) { atomicAdd(&(bar)[XB_TMO], 1u); break; } } } } while (0)
struct XcdBarrier { unsigned* bar; unsigned x; volatile LAS unsigned* st; };
__device__ __forceinline__ XcdBarrier xcd_barrier_post(unsigned* bar, volatile LAS unsigned* st) {
    XcdBarrier b; b.bar = bar; b.x = xb_xcc_id(); b.st = st;
    if (threadIdx.x == 0) (void)xb_add(&bar[XB_XCNT(b.x)], 1u);
    return b;
}
__device__ __forceinline__ void xcd_barrier_complete(unsigned* bar, unsigned x, unsigned& nloc, unsigned& nx) {
    const unsigned G = gridDim.x * gridDim.y * gridDim.z;
    unsigned sum, cnt, mine, sp = 0u;
    for (;;) {
        sum = 0u; cnt = 0u; mine = 0u;
#pragma unroll
        for (unsigned j = 0; j < 16; ++j) { const unsigned c = xb_ld(&bar[XB_XCNT(j)]); sum += c; cnt += (c > 0u) ? 1u : 0u; mine = (j == x) ? c : mine; }
        if (sum == G) break;
        __builtin_amdgcn_s_sleep(1);
        if ((++sp & 255u) == 0u) { if (xb_ld(&bar[XB_TMO])) break; if (sp > XB_SPIN_CAP) { atomicAdd(&bar[XB_TMO], 1u); break; } }
    }
    nloc = mine > 0u ? mine : 1u; nx = cnt > 0u ? cnt : 1u;
}
__device__ __forceinline__ void xcd_barrier(const XcdBarrier& b, const int wave0) {
    asm volatile("s_waitcnt vmcnt(0)" ::: "memory");
    __syncthreads();
    int l_; PG8_LANE(l_);
    if (wave0 == 0 && l_ == 0) {
        unsigned* bar = b.bar;
        __builtin_amdgcn_s_waitcnt(0);
        unsigned nloc = b.st[0], nx = b.st[1];
        if (nloc == 0u) { xcd_barrier_complete(bar, b.x, nloc, nx); b.st[0] = nloc; b.st[1] = nx; }
        const unsigned old = xb_add(&bar[XB_XSUB(b.x)], 1u);
        const unsigned gen = old / nloc;
        if (old + 1u == (gen + 1u) * nloc) {
            __builtin_amdgcn_fence(__ATOMIC_RELEASE, "agent");
            asm volatile("s_waitcnt vmcnt(0)" ::: "memory");
            const unsigned og = xb_add(&bar[XB_TOP], 1u);
            const unsigned tg = og / nx;
            if (og + 1u == (tg + 1u) * nx) xb_add(&bar[XB_TOPGEN], 1u);
            else XB_SPIN(xb_ld(&bar[XB_TOPGEN]) == tg, bar);
            __builtin_amdgcn_fence(__ATOMIC_ACQUIRE, "agent");
            xb_add(&bar[XB_XGEN(b.x)], 1u);
            asm volatile("s_waitcnt vmcnt(0)" ::: "memory");
        } else {
            XB_SPIN(xb_ld(&bar[XB_XGEN(b.x)]) == gen, bar);
            __builtin_amdgcn_fence(__ATOMIC_ACQUIRE, "agent");
            asm volatile("s_waitcnt vmcnt(0)" ::: "memory");
        }
    }
    __syncthreads();
}

struct Params { const float* in[36]; float* out; unsigned char* ws; int ph_lo, ph_hi, dupmask, pad; };
enum { I_XP = 0, I_XS, I_SF, I_SB, I_C, I_CCTX, I_ADAW, I_ADAB, I_N1G, I_N2G, I_WIN, I_MUP, I_MUN, I_DW0, I_DW1, I_DW2, I_IA0, I_IA1, I_IA2, I_GG1, I_GG2,
       I_KK, I_KA, I_RK, I_LNXG, I_LNXB, I_WOR, I_CW, I_CB, I_CLG, I_CLB, I_WOC, I_WO, I_W1, I_W2, I_FG };

typedef const __attribute__((address_space(4))) Params* KPtr;
__device__ __forceinline__ int cond_of(int m) { return m < NCTX ? 0 : 1 + ((m - NCTX) >> 11); }

struct EpiG1 {
    static constexpr bool PERM = true, AFTER_DRAIN = false;
    bf16* RKV; bf16* PB; bf16* A2;
    __device__ __forceinline__ void operator()(const f32x4 (&acc)[2][2][4][2], const pg8::Unit& u, int wr, int wc, int fr, int fq) const {
        const int row0 = u.pm * 256 + wr * 64 + fr, colt = wc * 32 + 8 * fq;
        if (u.pn < 6) {
#pragma unroll
            for (int ai = 0; ai < 2; ++ai)
#pragma unroll
                for (int m = 0; m < 4; ++m) { bf16* rp = RKV + (size_t)(row0 + ai * 128 + m * 16) * 1536 + u.pn * 256 + colt;
#pragma unroll
                    for (int bj = 0; bj < 2; ++bj) *(v4u*)(rp + bj * 128) = pack8(acc[ai][bj][m][0], acc[ai][bj][m][1]); }
        } else if (u.pn < 18) {
#pragma unroll
            for (int ai = 0; ai < 2; ++ai)
#pragma unroll
                for (int m = 0; m < 4; ++m) { bf16* rp = PB + (size_t)(row0 + ai * 128 + m * 16) * 3072 + (u.pn - 6) * 256 + colt;
#pragma unroll
                    for (int bj = 0; bj < 2; ++bj) *(v4u*)(rp + bj * 128) = pack8(acc[ai][bj][m][0], acc[ai][bj][m][1]); }
        } else {
            const int l = u.pn - 18;
#pragma unroll
            for (int ai = 0; ai < 2; ++ai)
#pragma unroll
                for (int m = 0; m < 4; ++m) { bf16* rp = A2 + (size_t)(row0 + ai * 128 + m * 16) * 1280 + l * 256 + colt;
#pragma unroll
                    for (int bj = 0; bj < 2; ++bj) { f32x4 a = acc[ai][bj][m][0], b = acc[ai][bj][m][1];
                        if (l == 0) {
#pragma unroll
                            for (int e = 0; e < 4; ++e) { a[e] = sigm(a[e]); b[e] = sigm(b[e]); }
                        } else if (l <= 2) {
#pragma unroll
                            for (int e = 0; e < 4; ++e) { a[e] = tanh_fast(a[e]); b[e] = tanh_fast(b[e]); }
                        }
                        *(v4u*)(rp + bj * 128) = pack8(a, b); } }
        }
    }
};
struct EpiG2 {
    static constexpr bool PERM = true, AFTER_DRAIN = false;
    bf16* G; float* WD; bf16* AL; const float* w0; const float* a0;
    __device__ __forceinline__ void operator()(const f32x4 (&acc)[2][2][4][2], const pg8::Unit& u, int wr, int wc, int fr, int fq) const {
        const int row0 = u.pm * 256 + wr * 64 + fr, l = u.pn >> 1, cb = (u.pn & 1) * 256 + wc * 32 + 8 * fq;
#pragma unroll
        for (int bj = 0; bj < 2; ++bj) {
            const int c0 = cb + bj * 128;
            f32x4 o0 = (f32x4){0.f, 0.f, 0.f, 0.f}, o1 = o0;
            if (l >= 1 && l <= 2) { o0 = *(const f32x4*)(w0 + (l - 1) * 512 + c0); o1 = *(const f32x4*)(w0 + (l - 1) * 512 + c0 + 4); }
            if (l >= 3) { o0 = *(const f32x4*)(a0 + (l - 3) * 512 + c0); o1 = *(const f32x4*)(a0 + (l - 3) * 512 + c0 + 4); }
#pragma unroll
            for (int ai = 0; ai < 2; ++ai)
#pragma unroll
                for (int m = 0; m < 4; ++m) { const size_t ro = (size_t)(row0 + ai * 128 + m * 16) * 512 + c0;
                    f32x4 a = acc[ai][bj][m][0] + o0, b = acc[ai][bj][m][1] + o1;
                    if (l == 0) { *(v4u*)(G + ro) = pack8(a, b); }
                    else if (l <= 2) {
#pragma unroll
                        for (int e = 0; e < 4; ++e) { a[e] = -0.6065306597126334f * sigm(a[e]); b[e] = -0.6065306597126334f * sigm(b[e]); }
                        float* wp = WD + (size_t)(l - 1) * NTOK * 512 + ro; *(f32x4*)wp = a; *(f32x4*)(wp + 4) = b;
                    } else {
#pragma unroll
                        for (int e = 0; e < 4; ++e) { a[e] = sigm(a[e]); b[e] = sigm(b[e]); }
                        *(v4u*)(AL + (size_t)(l - 3) * NTOK * 512 + ro) = pack8(a, b);
                    } }
        }
    }
};
struct EpiG3 {
    static constexpr bool PERM = true, AFTER_DRAIN = false;
    const bf16* PB; bf16* GM;
    __device__ __forceinline__ void operator()(const f32x4 (&acc)[2][2][4][2], const pg8::Unit& u, int wr, int wc, int fr, int fq) const {
        const int row0 = u.pm * 256 + wr * 64 + fr, cb = u.pn * 256 + wc * 32 + 8 * fq;
#pragma unroll
        for (int ai = 0; ai < 2; ++ai)
#pragma unroll
            for (int m = 0; m < 4; ++m) { const int row = row0 + ai * 128 + m * 16;
#pragma unroll
                for (int bj = 0; bj < 2; ++bj) { const int c0 = cb + bj * 128;
                    const v4u gw = *(const v4u*)(PB + (size_t)row * 3072 + 1024 + c0); float g[8]; unpack8(gw, g);
                    f32x4 a = acc[ai][bj][m][0], b = acc[ai][bj][m][1];
#pragma unroll
                    for (int e = 0; e < 4; ++e) { a[e] *= sigm(g[e]); b[e] *= sigm(g[4 + e]); }
                    *(v4u*)(GM + (size_t)row * 2048 + c0) = pack8(a, b); } }
    }
};
struct EpiPart {
    static constexpr bool PERM = true, AFTER_DRAIN = false;
    bf16* PART;
    __device__ __forceinline__ void operator()(const f32x4 (&acc)[2][2][4][2], const pg8::Unit& u, int wr, int wc, int fr, int fq) const {
        const int row0 = u.pm * 256 + wr * 64 + fr, cb = (u.pn & 3) * 256 + wc * 32 + 8 * fq;
        bf16* base = PART + (size_t)(u.pn >> 2) * NTOK * 1024;
#pragma unroll
        for (int ai = 0; ai < 2; ++ai)
#pragma unroll
            for (int m = 0; m < 4; ++m) { bf16* rp = base + (size_t)(row0 + ai * 128 + m * 16) * 1024 + cb;
#pragma unroll
                for (int bj = 0; bj < 2; ++bj) *(v4u*)(rp + bj * 128) = pack8(acc[ai][bj][m][0], acc[ai][bj][m][1]); }
    }
};
struct EpiG5 {
    static constexpr bool PERM = true, AFTER_DRAIN = false;
    bf16* H;
    __device__ __forceinline__ void operator()(const f32x4 (&acc)[2][2][4][2], const pg8::Unit& u, int wr, int wc, int fr, int fq) const {
        const int row0 = u.pm * 256 + wr * 64 + fr, cb = u.pn * 256 + wc * 32 + 8 * fq;
#pragma unroll
        for (int ai = 0; ai < 2; ++ai)
#pragma unroll
            for (int m = 0; m < 4; ++m) { bf16* rp = H + (size_t)(row0 + ai * 128 + m * 16) * DFF + cb;
#pragma unroll
                for (int bj = 0; bj < 2; ++bj) { f32x4 a = acc[ai][bj][m][0], b = acc[ai][bj][m][1];
#pragma unroll
                    for (int e = 0; e < 4; ++e) { const float x = fmaxf(a[e], 0.f), y = fmaxf(b[e], 0.f); a[e] = x * x; b[e] = y * y; }
                    *(v4u*)(rp + bj * 128) = pack8(a, b); } }
    }
};

__device__ __forceinline__ void p0_transpose_item(const float* W, int N, bf16* WT, int ldt, int row_off, LAS float* scr, int item, int lane) {
    const int nblk = N / 32, kb = item / nblk, nb = item % nblk, k0 = 64 * kb, n0 = 32 * nb;
    float tv[32];
#pragma unroll
    for (int i = 0; i < 32; ++i) { const int kk = 2 * i + (lane >> 5); tv[i] = W[(size_t)(k0 + kk) * N + n0 + (lane & 31)]; }
#pragma unroll
    for (int i = 0; i < 32; ++i) { const int kk = 2 * i + (lane >> 5); scr[kk * 33 + (lane & 31)] = tv[i]; }
    LDS_WAIT(); asm volatile("" ::: "memory");
    const int c = lane & 7;
#pragma unroll
    for (int j = 0; j < 4; ++j) { const int n = (lane >> 3) + 8 * j; const LAS float* s = scr + (8 * c) * 33 + n;
        v4u o; o.x = pk2(s[0 * 33], s[1 * 33]); o.y = pk2(s[2 * 33], s[3 * 33]); o.z = pk2(s[4 * 33], s[5 * 33]); o.w = pk2(s[6 * 33], s[7 * 33]);
        *(GAS v4u*)(WT + (size_t)(row_off + n0 + n) * ldt + k0 + 8 * c) = o; }
    LDS_WAIT(); asm volatile("" ::: "memory");
}
__device__ __forceinline__ void p0_mod_item(KPtr p, LAS unsigned char* lds, int item, int tid) {
    const int wave = tid >> 6, lane = tid & 63, kk = lane >> 3, c4 = lane & 7;
    const float* ada_w = p->in[I_ADAW]; const float* cc = p->in[I_C]; const float* cx = p->in[I_CCTX];
    f32x4 a0 = (f32x4){0.f, 0.f, 0.f, 0.f}, a1 = a0, a2 = a0;
#pragma unroll
    for (int i = 0; i < 16; ++i) {
        const int k = wave * 128 + i * 8 + kk;
        const f32x4 w = *(const f32x4*)(ada_w + (size_t)k * 6144 + item * 32 + c4 * 4);
        const float c0 = cx[k], c1 = cc[k], c2 = cc[1024 + k];
        a0 += w * (c0 * sigm(c0)); a1 += w * (c1 * sigm(c1)); a2 += w * (c2 * sigm(c2));
    }
#pragma unroll
    for (int e = 0; e < 4; ++e) {
#pragma unroll
        for (int o = 8; o < 64; o <<= 1) { a0[e] += __shfl_xor(a0[e], o); a1[e] += __shfl_xor(a1[e], o); a2[e] += __shfl_xor(a2[e], o); }
    }
    LAS float* red = (LAS float*)lds;
    if (lane < 8) {
#pragma unroll
        for (int e = 0; e < 4; ++e) { red[(wave * 3 + 0) * 32 + c4 * 4 + e] = a0[e]; red[(wave * 3 + 1) * 32 + c4 * 4 + e] = a1[e]; red[(wave * 3 + 2) * 32 + c4 * 4 + e] = a2[e]; }
    }
    __syncthreads();
    if (tid < 96) { const int j = tid >> 5, c = tid & 31; float s = p->in[I_ADAB][item * 32 + c];
#pragma unroll
        for (int w = 0; w < 8; ++w) s += red[(w * 3 + j) * 32 + c];
        __hip_atomic_store((float*)(p->ws + WS_MOD) + j * 6144 + item * 32 + c, s, __ATOMIC_RELAXED, __HIP_MEMORY_SCOPE_AGENT); }
    asm volatile("s_waitcnt vmcnt(0)" ::: "memory");
    __syncthreads();
    if (tid == 0) {
        __hip_atomic_fetch_add((unsigned*)(p->ws + WS_CTL) + CW_MODCNT, 1u, __ATOMIC_RELAXED, __HIP_MEMORY_SCOPE_AGENT); }
}
__device__ __forceinline__ void p0_prologue(KPtr p, LAS unsigned char* lds, int vcu, int G, int tid) {
    const int wave = __builtin_amdgcn_readfirstlane(tid >> 6), lane = tid & 63;
    for (int it = vcu; it < 192; it += G) p0_mod_item(p, lds, it, tid);
    LAS float* scr = (LAS float*)(lds + wave * 16384);
    const int gw = vcu * NWAVES + wave, NGW = G * NWAVES;
    bf16* Win = (bf16*)(p->ws + WS_WIN); bf16* B2 = (bf16*)(p->ws + WS_B2); bf16* Wout = (bf16*)(p->ws + WS_WOUT);
    bf16* Wo = (bf16*)(p->ws + WS_WO); bf16* W1 = (bf16*)(p->ws + WS_W1); bf16* W2 = (bf16*)(p->ws + WS_W2);
    constexpr int T_WIN = 16 * 144, T_GG1 = 16 * 4, T_L1 = 16 * 2, T_GG2 = 2 * 16, T_L2 = 16, T_WOUT = 8 * 32, T_WO = 16 * 32, T_W1 = 16 * 128, T_W2 = 64 * 32;
    constexpr int NITEMS = T_WIN + T_GG1 + 4 * T_L1 + T_GG2 + 4 * T_L2 + 2 * T_WOUT + T_WO;
    for (int it = gw; it < NITEMS; it += NGW) {
        int r = it;
        if (r < T_WIN) { p0_transpose_item(p->in[I_WIN], 4608, Win, 1024, 0, scr, r, lane); continue; } r -= T_WIN;
        if (r < T_WO) { p0_transpose_item(p->in[I_WO], DM, Wo, 1024, 0, scr, r, lane); continue; } r -= T_WO;
        if (r < T_WOUT) { p0_transpose_item(p->in[I_WOR], DM, Wout, 512, 0, scr, r, lane); continue; } r -= T_WOUT;
        if (r < T_WOUT) { p0_transpose_item(p->in[I_WOC], DM, Wout, 512, 1024, scr, r, lane); continue; } r -= T_WOUT;
        if (r < T_GG1) { p0_transpose_item(p->in[I_GG1], 128, Win, 1024, 4608, scr, r, lane); continue; } r -= T_GG1;
        if (r < 4 * T_L1) { const int q = r / T_L1; r -= q * T_L1;
            const float* src = (q < 2 ? p->in[I_DW1] : p->in[I_IA1]) + (size_t)(q & 1) * 1024 * 64;
            p0_transpose_item(src, 64, Win, 1024, 4608 + 256 * (q + 1), scr, r, lane); continue; } r -= 4 * T_L1;
        if (r < T_GG2) { p0_transpose_item(p->in[I_GG2], 512, B2, 256, 0, scr, r, lane); continue; } r -= T_GG2;
        { const int q = r / T_L2; r -= q * T_L2;
            const float* src = (q < 2 ? p->in[I_DW2] : p->in[I_IA2]) + (size_t)(q & 1) * 64 * 512;
            p0_transpose_item(src, 512, B2, 256, 512 * (q + 1), scr, r, lane); }
    }
    const v4u z = (v4u){0u, 0u, 0u, 0u};
    for (int it = gw; it < 5 * 256; it += NGW) { const int l = it >> 8, rr = it & 255; const int real = (l == 0) ? 128 : 64;
        if (rr >= real) { GAS v4u* dst = (GAS v4u*)(Win + (size_t)(4608 + l * 256 + rr) * 1024); dst[lane] = z; dst[64 + lane] = z; } }
    for (int it = gw; it < 2560; it += NGW) { const int real = (it < 512) ? 128 : 64;
        if (lane * 4 >= real) *(GAS v2u*)(B2 + (size_t)it * 256 + lane * 4) = (v2u){0u, 0u}; }
}

__device__ __forceinline__ void p1_norm1(KPtr p, int gw, int NGW, int lane) {
    const float* MOD = (const float*)(p->ws + WS_MOD); bf16* XN = (bf16*)(p->ws + WS_XN); const float* ng = p->in[I_N1G];
    for (int mi = gw; mi < NTOK; mi += NGW) { const int m = (NGW == 2048) ? ((mi & 255) + 1024 * ((mi >> 8) & 7) + 256 * (mi >> 11)) : mi;

        const float* xr = (m < NCTX) ? p->in[I_XP] + (size_t)m * DM : p->in[I_XS] + (size_t)(m - NCTX) * DM;
        const float* md = MOD + cond_of(m) * 6144;
        f32x4 v[4]; float s = 0.f;
#pragma unroll
        for (int j = 0; j < 4; ++j) { v[j] = ((const f32x4*)xr)[lane + 64 * j]; s += (v[j][0] * v[j][0] + v[j][1] * v[j][1]) + (v[j][2] * v[j][2] + v[j][3] * v[j][3]); }
        const float rstd = rsqrtf(wave_sum(s) * (1.f / DM) + 1e-6f);
        GAS v2u* o8 = (GAS v2u*)(XN + (size_t)m * DM) + lane;
#pragma unroll
        for (int j = 0; j < 4; ++j) { const int c = 4 * (lane + 64 * j);
            const f32x4 g = *(const f32x4*)(ng + c), sh = *(const f32x4*)(md + c), sc = *(const f32x4*)(md + 1024 + c);
            const f32x4 y = v[j] * rstd * g * (sc + 1.0f) + sh;
            o8[64 * j] = (v2u){pk2(y[0], y[1]), pk2(y[2], y[3])}; }
    }
}
__device__ __forceinline__ void p7_res_norm2(KPtr p, int gw, int NGW, int lane) {
    const float* MOD = (const float*)(p->ws + WS_MOD); bf16* XN = (bf16*)(p->ws + WS_XN); const float* ng = p->in[I_N2G];
    const bf16* P0 = (const bf16*)(p->ws + WS_PART); const bf16* P1 = P0 + (size_t)NTOK * DM;
    for (int mi = gw; mi < NTOK; mi += NGW) { const int m = (NGW == 2048) ? ((mi & 255) + 1024 * ((mi >> 8) & 7) + 256 * (mi >> 11)) : mi;

        const float* xr = (m < NCTX) ? p->in[I_XP] + (size_t)m * DM : p->in[I_XS] + (size_t)(m - NCTX) * DM;
        const float* md = MOD + cond_of(m) * 6144;
        f32x4 v[4]; float s = 0.f;
#pragma unroll
        for (int j = 0; j < 4; ++j) { const int c = 4 * (lane + 64 * j);
            const f32x4 x = *(const f32x4*)(xr + c), g1 = *(const f32x4*)(md + 2048 + c); const v2u aw = *(const v2u*)(P0 + (size_t)m * DM + c), bw = *(const v2u*)(P1 + (size_t)m * DM + c);
            const f32x4 a = (f32x4){bflo(aw.x), bfhi(aw.x), bflo(aw.y), bfhi(aw.y)}, b = (f32x4){bflo(bw.x), bfhi(bw.x), bflo(bw.y), bfhi(bw.y)};
            v[j] = x + g1 * (a + b);
            *(f32x4*)(p->out + (size_t)m * DM + c) = v[j];
            s += (v[j][0] * v[j][0] + v[j][1] * v[j][1]) + (v[j][2] * v[j][2] + v[j][3] * v[j][3]); }
        const float rstd = rsqrtf(wave_sum(s) * (1.f / DM) + 1e-6f);
        GAS v2u* o8 = (GAS v2u*)(XN + (size_t)m * DM) + lane;
#pragma unroll
        for (int j = 0; j < 4; ++j) { const int c = 4 * (lane + 64 * j);
            const f32x4 g = *(const f32x4*)(ng + c), sh = *(const f32x4*)(md + 3072 + c), sc = *(const f32x4*)(md + 4096 + c);
            const f32x4 y = v[j] * rstd * g * (sc + 1.0f) + sh;
            o8[64 * j] = (v2u){pk2(y[0], y[1]), pk2(y[2], y[3])}; }
    }
}
__device__ __forceinline__ void p12_final(KPtr p, int gw, int NGW, int lane) {
    const float* MOD = (const float*)(p->ws + WS_MOD); const float* fg = p->in[I_FG];
    const bf16* P0 = (const bf16*)(p->ws + WS_PART); const bf16* P1 = P0 + (size_t)NTOK * DM;
    for (int mi = gw; mi < NTOK; mi += NGW) { const int m = (NGW == 2048) ? ((mi & 255) + 1024 * ((mi >> 8) & 7) + 256 * (mi >> 11)) : mi;

        const float* md = MOD + cond_of(m) * 6144;
        f32x4 v[4]; float s = 0.f;
#pragma unroll
        for (int j = 0; j < 4; ++j) { const int c = 4 * (lane + 64 * j);
            const f32x4 x = *(const f32x4*)(p->out + (size_t)m * DM + c), g2 = *(const f32x4*)(md + 5120 + c); const v2u aw = *(const v2u*)(P0 + (size_t)m * DM + c), bw = *(const v2u*)(P1 + (size_t)m * DM + c);
            const f32x4 a = (f32x4){bflo(aw.x), bfhi(aw.x), bflo(aw.y), bfhi(aw.y)}, b = (f32x4){bflo(bw.x), bfhi(bw.x), bflo(bw.y), bfhi(bw.y)};
            v[j] = x + g2 * (a + b);
            s += (v[j][0] * v[j][0] + v[j][1] * v[j][1]) + (v[j][2] * v[j][2] + v[j][3] * v[j][3]); }
        const float rstd = rsqrtf(wave_sum(s) * (1.f / DM) + 1e-6f);
#pragma unroll
        for (int j = 0; j < 4; ++j) { const int c = 4 * (lane + 64 * j);
            *(f32x4*)(p->out + (size_t)m * DM + c) = v[j] * rstd * *(const f32x4*)(fg + c); }
    }
}
template <typename T> __device__ __forceinline__ const __attribute__((address_space(1))) T* uni_ptr(const T* q) {
    unsigned long long u = (unsigned long long)q;
    unsigned lo = __builtin_amdgcn_readfirstlane((unsigned)u), hi = __builtin_amdgcn_readfirstlane((unsigned)(u >> 32));
    return (const __attribute__((address_space(1))) T*)(((unsigned long long)hi << 32) | lo);
}
__device__ __forceinline__ float ldg16(const __attribute__((address_space(1))) bf16* sb, unsigned bo, int cbytes = 0) {
    return bf1(*(const __attribute__((address_space(1))) bf16*)((const __attribute__((address_space(1))) unsigned char*)sb + bo + cbytes));
}
__device__ __forceinline__ void load8(const float* p, float (&o)[8]) { const f32x4 a = *(const f32x4*)p, b = *(const f32x4*)(p + 4); o[0] = a[0]; o[1] = a[1]; o[2] = a[2]; o[3] = a[3]; o[4] = b[0]; o[5] = b[1]; o[6] = b[2]; o[7] = b[3]; }
__device__ __forceinline__ void store8bf(bf16* p, const float (&v)[8]) { v4u w; w.x = pk2(v[0], v[1]); w.y = pk2(v[2], v[3]); w.z = pk2(v[4], v[5]); w.w = pk2(v[6], v[7]); *(GAS v4u*)p = w; }
typedef short bf16x8v __attribute__((ext_vector_type(8)));
typedef float f32x16 __attribute__((ext_vector_type(16)));
#define MFMA32(a, b, c) __builtin_amdgcn_mfma_f32_32x32x16_bf16(a, b, c, 0, 0, 0)
__device__ __forceinline__ bf16x8v ldfrag(const LAS unsigned char* base, int row_stride, int row, int col) { return *(const LAS bf16x8v*)(base + row * row_stride + col * 2); }
__device__ __forceinline__ int trow(int reg, int half) { return (reg & 3) + 8 * (reg >> 2) + 4 * half; }
__device__ __forceinline__ bf16x8v pack_acc(const f32x16& x, int s) {
    v4u w; w.x = pk2(x[8 * s], x[8 * s + 1]); w.y = pk2(x[8 * s + 2], x[8 * s + 3]); w.z = pk2(x[8 * s + 4], x[8 * s + 5]); w.w = pk2(x[8 * s + 6], x[8 * s + 7]);
    return __builtin_bit_cast(bf16x8v, w);
}
__device__ __forceinline__ int rec_off_s(int fbase, int rr, int cc) { const int s = cc >> 4, o = cc & 15, hh = (o >> 2) & 1, j = 4 * (o >> 3) + (o & 3); return (fbase + s) * 1024 + (32 * hh + rr) * 16 + j * 2; }
__device__ __forceinline__ int rec_off_n(int fbase, int rr, int ii) { const int s = ii >> 4, o = ii & 15, hh = o >> 3, j = o & 7; return (fbase + s) * 1024 + (32 * hh + rr) * 16 + j * 2; }
constexpr int P1_WAVE_LDS = 32768;
constexpr int P1_AT = 0, P1_BT = 4608, P1_RT = 9216, P1_KT = 13824, P1_BTT = 18432, P1_NBR = 23552, P1_WT = 26112, P1_GCL = 31232, P1_RN = 32256;
constexpr int P1_L = 4608, P1_NKA = 26112, P1_ZT = 4608, P1_RED0 = 0, P1_RED1 = 23552;

__device__ __forceinline__ void p4_decode(int task, int& b, int& h, int& n, int& m0, int& T) {
    if (task < 1024) { b = task >> 6; h = (task >> 3) & 7; n = task & 7; m0 = b * 256; T = 256; }
    else { const int t2 = task - 1024; b = t2 >> 9; h = (t2 >> 6) & 7; n = t2 & 63; m0 = NCTX + b * 2048; T = 2048; }
}
template <int D>
__device__ __forceinline__ void p4_pass1(KPtr p, LAS unsigned char* wl, int task) {
    int lane; PG8_LANE(lane);
    int b, h, n, m0, T; p4_decode(task, b, h, n, m0, T);
    const bf16* RKV = (const bf16*)(p->ws + WS_RKV);
    const int c = h * 64 + lane, mb = m0 + 32 * n;
    const bool has_prev = n > 0, has_next = (32 * n + 32) < T;
    float kraw[34];
    {   const __attribute__((address_space(1))) bf16* srck = uni_ptr(RKV + ((size_t)mb - 1) * 1536 + 512 + h * 64);
        unsigned eo = (unsigned)lane * 2u;
        kraw[0] = has_prev ? ldg16(srck, eo) : 0.f;
#pragma unroll
        for (int i = 0; i < 32; ++i) { eo += 3072u; asm volatile("" : "+v"(eo)); kraw[i + 1] = ldg16(srck, eo); }
        eo += 3072u; kraw[33] = has_next ? ldg16(srck, eo) : 0.f; }
    __builtin_amdgcn_sched_barrier(0);
    float lw[32], al[32];
    {   const int fr0 = lane & 31, fh0 = lane >> 5;
        const bf16* A2p = (const bf16*)(p->ws + WS_A2) + (size_t)(mb + fr0) * 1280 + 8 * fh0;
        const bf16* B2p = (const bf16*)(p->ws + WS_B2) + (size_t)(h * 64 + fr0) * 256 + 8 * fh0;
        const float w0c = p->in[I_DW0][D * 512 + c], a0c = p->in[I_IA0][D * 512 + c];
#pragma unroll
        for (int which = 0; which < (D == 0 ? 3 : 2); ++which) {
            const int l = (which == 0) ? 1 + D : (which == 1) ? 3 + D : 0, nk = (which == 2) ? 8 : 4;
            f32x16 c0, c1;
#pragma unroll
            for (int e = 0; e < 16; ++e) { c0[e] = 0.f; c1[e] = 0.f; }
#pragma unroll
            for (int s4 = 0; s4 < nk; ++s4) { const bf16x8v a = *(const bf16x8v*)(A2p + 256 * l + 16 * s4);
                const bf16x8v b0 = *(const bf16x8v*)(B2p + (size_t)(l * 512) * 256 + 16 * s4), b1 = *(const bf16x8v*)(B2p + (size_t)(l * 512 + 32) * 256 + 16 * s4);
                c0 = MFMA32(a, b0, c0); c1 = MFMA32(a, b1, c1); }
#pragma unroll
            for (int e = 0; e < 16; ++e) {
                const auto sw = __builtin_amdgcn_permlane32_swap(__float_as_uint(c0[e]), __float_as_uint(c1[e]), false, false);
                const float x0 = __uint_as_float(sw[0]), x1 = __uint_as_float(sw[1]);
                const int t0 = trow(e, 0), t1 = trow(e, 1);
                if (which == 0) { lw[t0] = -0.6065306597126334f * sigm(w0c + x0); lw[t1] = -0.6065306597126334f * sigm(w0c + x1); }
                else if (which == 1) { al[t0] = sigm(a0c + x0); al[t1] = sigm(a0c + x1); }
                else { bf16* Gp = (bf16*)((unsigned char*)p->out + DO_G) + (size_t)mb * 512 + c; Gp[(size_t)t0 * 512] = (bf16)(pk2(x0, 0.f) & 0xffffu); Gp[(size_t)t1 * 512] = (bf16)(pk2(x1, 0.f) & 0xffffu); }
            }
        }
    }
    __builtin_amdgcn_sched_barrier(0);
    {   const float mp = p->in[I_MUP][512 + c], mn = p->in[I_MUN][512 + c], kkw = p->in[I_KK][c];
        LAS float* red = (LAS float*)(wl + P1_RED0);
#pragma unroll
        for (int i = 0; i < 32; ++i) { const float u = (kraw[i + 1] + (kraw[i] - kraw[i + 1]) * mp + (kraw[i + 2] - kraw[i + 1]) * mn) * kkw; red[i * 68 + lane] = u * u; }
        asm volatile("" ::: "memory");
        const int ri = lane & 31, hf = lane >> 5; float ssum = 0.f;
#pragma unroll
        for (int q = 0; q < 8; ++q) { const f32x4 x = *(const LAS f32x4*)(red + ri * 68 + hf * 32 + 4 * q); ssum += (x[0] + x[1]) + (x[2] + x[3]); }
        ssum += __int_as_float(__builtin_amdgcn_ds_bpermute((lane ^ 32) << 2, __float_as_int(ssum)));
        if (lane < 32) ((LAS float*)(wl + P1_RN))[lane] = rsqrtf(fmaxf(ssum, 1e-24f));
    }
    asm volatile("" ::: "memory");
    float gC;
    {   const float kaw = p->in[I_KA][c], rkw = p->in[I_RK][c], kkw = p->in[I_KK][c];
        const float mpr = p->in[I_MUP][c], mnr = p->in[I_MUN][c], mpk = p->in[I_MUP][512 + c], mnk = p->in[I_MUN][512 + c], mpv = p->in[I_MUP][1024 + c], mnv = p->in[I_MUN][1024 + c];
        LAS bf16* lAT = (LAS bf16*)(wl + P1_AT); LAS bf16* lBT = (LAS bf16*)(wl + P1_BT); LAS bf16* lRT = (LAS bf16*)(wl + P1_RT); LAS bf16* lKT = (LAS bf16*)(wl + P1_KT);
        LAS float* red1 = (LAS float*)(wl + P1_RED1); const LAS float* rnl = (const LAS float*)(wl + P1_RN);
        const int j0 = D ? 31 : 0;
        const __attribute__((address_space(1))) bf16* src = uni_ptr(RKV + ((size_t)mb - 1) * 1536 + h * 64);
        bf16* VN = (bf16*)((unsigned char*)p->out + DO_V) + (size_t)mb * 512 + c;
        bf16* VT = (bf16*)((unsigned char*)p->out + DO_VT) + (size_t)m0 * 512 + (size_t)h * 64 * T + (size_t)lane * T + 32 * n;
        const bool has_behind = D ? has_next : has_prev, has_ahead = D ? has_prev : has_next;
        constexpr int stp = D ? -3072 : 3072;
        unsigned eo = (unsigned)lane * 2u + (unsigned)(j0 + 1) * 3072u;
        float rb = has_behind ? ldg16(src, eo - stp) : 0.f, kb = has_behind ? ldg16(src, eo - stp, 1024) : 0.f, vb = has_behind ? ldg16(src, eo - stp, 2048) : 0.f;
        float rc = ldg16(src, eo), kc = ldg16(src, eo, 1024), vc = ldg16(src, eo, 2048);
        float Lc = 0.f, gprev = 1.f; float btp[8], vtp[8];
        int vo = 0;
        float nra[8], nka[8], nva[8];
#define P1_LOAD_GROUP(g_) do { _Pragma("unroll") for (int u_ = 0; u_ < 8; ++u_) { const int s_ = 8 * (g_) + u_; \
            eo += stp; asm volatile("" : "+v"(eo)); const bool ha_ = (s_ < 31) || has_ahead; \
            nra[u_] = ha_ ? ldg16(src, eo) : 0.f; nka[u_] = ha_ ? ldg16(src, eo, 1024) : 0.f; nva[u_] = ha_ ? ldg16(src, eo, 2048) : 0.f; } } while (0)
        P1_LOAD_GROUP(0);
#pragma unroll
        for (int g8 = 0; g8 < 4; ++g8) {
            float cra[8], cka[8], cva[8];
#pragma unroll
            for (int u = 0; u < 8; ++u) { cra[u] = nra[u]; cka[u] = nka[u]; cva[u] = nva[u]; }
            if (g8 < 3) P1_LOAD_GROUP(g8 + 1);
#pragma unroll
            for (int u = 0; u < 8; ++u) {
                const int s = 8 * g8 + u, j = D ? 31 - s : s;
                const float lwj = lw[j], alj = al[j], ra = cra[u], ka = cka[u], va = cva[u];
                const float rp_ = D ? ra : rb, rn_ = D ? rb : ra, kp_ = D ? ka : kb, kn_ = D ? kb : ka, vp_ = D ? va : vb, vn_ = D ? vb : va;
                const float rj = rc + (rp_ - rc) * mpr + (rn_ - rc) * mnr, kj = kc + (kp_ - kc) * mpk + (kn_ - kc) * mnk, vj = vc + (vp_ - vc) * mpv + (vn_ - vc) * mnv;
                const float kkj = kj * kkw * rnl[j];
                Lc += lwj;
                const float g = __expf(Lc), gi = __expf(-Lc);
                const float kd = kj * (1.f + (alj - 1.f) * kaw), bb = kkj * alj;
                const float at = -kkj * gprev;
                const float rt = rj * g, bt = bb * gi, kt = kd * gi;
                lAT[s * 72 + lane] = (bf16)(pk2(at, 0.f) & 0xffffu); lBT[s * 72 + lane] = (bf16)(pk2(bt, 0.f) & 0xffffu);
                lRT[s * 72 + lane] = (bf16)(pk2(rt, 0.f) & 0xffffu); lKT[s * 72 + lane] = (bf16)(pk2(kt, 0.f) & 0xffffu);
                btp[u] = bt;
                red1[j * 68 + lane] = rj * kd * rkw;
                if (D == 0) { VN[vo] = (bf16)(pk2(vj, 0.f) & 0xffffu); vo += 512; asm volatile("" : "+v"(vo)); vtp[u] = vj; }
                gprev = g; rb = rc; kb = kc; vb = vc; rc = ra; kc = ka; vc = va;
            }
            { v4u w; w.x = pk2(btp[0], btp[1]); w.y = pk2(btp[2], btp[3]); w.z = pk2(btp[4], btp[5]); w.w = pk2(btp[6], btp[7]); *(LAS v4u*)(wl + P1_BTT + lane * 80 + g8 * 16) = w; }
            if (D == 0) { v4u w; w.x = pk2(vtp[0], vtp[1]); w.y = pk2(vtp[2], vtp[3]); w.z = pk2(vtp[4], vtp[5]); w.w = pk2(vtp[6], vtp[7]); *(GAS v4u*)(VT + 8 * g8) = w; }
            __builtin_amdgcn_sched_barrier(0);
        }
#undef P1_LOAD_GROUP
        gC = gprev;
    }
    asm volatile("" ::: "memory");
    {   LAS float* red = (LAS float*)(wl + P1_RED1);
        const int ri = lane & 31, hf = lane >> 5; float ssum = 0.f;
#pragma unroll
        for (int q = 0; q < 8; ++q) { const f32x4 x = *(const LAS f32x4*)(red + ri * 68 + hf * 32 + 4 * q); ssum += (x[0] + x[1]) + (x[2] + x[3]); }
        ssum += __int_as_float(__builtin_amdgcn_ds_bpermute((lane ^ 32) << 2, __float_as_int(ssum)));
        if (lane < 32) ((float*)((unsigned char*)p->out + DO_DOT))[(size_t)D * NTOK * 8 + (size_t)(mb + lane) * 8 + h] = ssum;
    }
    asm volatile("" ::: "memory");
    const int fr = lane & 31, fh = lane >> 5;
    f32x16 nab, nka, nbr, nkr;
#pragma unroll
    for (int e = 0; e < 16; ++e) { nab[e] = 0.f; nka[e] = 0.f; nbr[e] = 0.f; nkr[e] = 0.f; }
    { bf16x8v fa[4], fb[4], fR[4], fk[4];
#pragma unroll
        for (int s4 = 0; s4 < 4; ++s4) { fa[s4] = ldfrag(wl + P1_AT, 144, fr, 16 * s4 + 8 * fh); fb[s4] = ldfrag(wl + P1_BT, 144, fr, 16 * s4 + 8 * fh);
            fR[s4] = ldfrag(wl + P1_RT, 144, fr, 16 * s4 + 8 * fh); fk[s4] = ldfrag(wl + P1_KT, 144, fr, 16 * s4 + 8 * fh); }
#pragma unroll
        for (int s4 = 0; s4 < 4; ++s4) { nab = MFMA32(fa[s4], fb[s4], nab); nka = MFMA32(fa[s4], fk[s4], nka); nbr = MFMA32(fR[s4], fb[s4], nbr); nkr = MFMA32(fk[s4], fR[s4], nkr); }
    }
    { LAS float* lL = (LAS float*)(wl + P1_L); LAS float* lN = (LAS float*)(wl + P1_NKA); LAS bf16* lB = (LAS bf16*)(wl + P1_NBR);
#pragma unroll
        for (int e = 0; e < 16; ++e) { const int t = trow(e, fh), i = fr;
            const float vab = (i < t) ? nab[e] : 0.f, vka = (i < t) ? nka[e] : 0.f, vbr = (i <= t) ? nbr[e] : 0.f; nkr[e] = (t <= i) ? nkr[e] : 0.f;
            lL[t * 32 + i] = vab; lN[t * 33 + i] = vka; lB[t * 40 + i] = (bf16)(pk2(vbr, 0.f) & 0xffffu); } }
    asm volatile("" ::: "memory");
    float W[32], Z[32];
    { int dep = 0; asm volatile("" : "+v"(dep));
#pragma unroll
        for (int t = 0; t < 32; ++t) {
            if (t >= 2) asm volatile("" : "+v"(dep) : "v"(W[t - 2]), "v"(Z[t - 2]));
            const LAS float* lL = (const LAS float*)(wl + P1_L) + dep; const LAS float* lN = (const LAS float*)(wl + P1_NKA) + dep; const LAS bf16* lAT = (const LAS bf16*)(wl + P1_AT) + dep;
            float aw = bf1(lAT[t * 72 + lane]), az = lN[t * 33 + fr], aw2 = 0.f, az2 = 0.f;
#pragma unroll
            for (int i4 = 0; i4 * 4 < t; ++i4) { const f32x4 l4 = *(const LAS f32x4*)(lL + t * 32 + 4 * i4);
#pragma unroll
                for (int e = 0; e < 4; ++e) { const int i = 4 * i4 + e; if (i < t) { if (e & 1) { aw2 += l4[e] * W[i]; az2 += l4[e] * Z[i]; } else { aw += l4[e] * W[i]; az += l4[e] * Z[i]; } } } }
            W[t] = aw + aw2; Z[t] = az + az2;
        } }
    asm volatile("" ::: "memory");
#pragma unroll
    for (int q = 0; q < 4; ++q) { v4u w; w.x = pk2(W[8 * q], W[8 * q + 1]); w.y = pk2(W[8 * q + 2], W[8 * q + 3]); w.z = pk2(W[8 * q + 4], W[8 * q + 5]); w.w = pk2(W[8 * q + 6], W[8 * q + 7]); *(LAS v4u*)(wl + P1_WT + lane * 80 + 16 * q) = w; }
    if (lane < 32) {
#pragma unroll
        for (int q = 0; q < 4; ++q) { v4u w; w.x = pk2(Z[8 * q], Z[8 * q + 1]); w.y = pk2(Z[8 * q + 2], Z[8 * q + 3]); w.z = pk2(Z[8 * q + 4], Z[8 * q + 5]); w.w = pk2(Z[8 * q + 6], Z[8 * q + 7]); *(LAS v4u*)(wl + P1_ZT + lane * 80 + 16 * q) = w; } }
    ((LAS float*)(wl + P1_GCL))[lane] = gC;
    asm volatile("" ::: "memory");
    const int wt = task * 2 + D;
    unsigned char* rec = p->ws + (wt < 2048 ? WS_RECA + (size_t)wt * REC_BYTES : WS_RECB + (size_t)(wt - 2048) * REC_BYTES);
    ((float*)(p->ws + WS_GC))[(size_t)wt * 64 + lane] = gC;
    const LAS float* lG = (const LAS float*)(wl + P1_GCL);
    bf16x8v fnb[2], fzt[2];
#pragma unroll
    for (int s2 = 0; s2 < 2; ++s2) { fnb[s2] = ldfrag(wl + P1_NBR, 80, fr, 16 * s2 + 8 * fh); fzt[s2] = ldfrag(wl + P1_ZT, 80, fr, 16 * s2 + 8 * fh); }
    unsigned char* recl = rec + lane * 16;
    __builtin_amdgcn_sched_barrier(0);
    { f32x16 acc = nkr;
#pragma unroll
        for (int s2 = 0; s2 < 2; ++s2) acc = MFMA32(fzt[s2], fnb[s2], acc);
        *(GAS bf16x8v*)(recl + 16 * 1024) = pack_acc(acc, 0); *(GAS bf16x8v*)(recl + 17 * 1024) = pack_acc(acc, 1); }
#pragma unroll
    for (int a2 = 0; a2 < 2; ++a2) {
        __builtin_amdgcn_sched_barrier(0);
        bf16x8v fbt[2];
#pragma unroll
        for (int s2 = 0; s2 < 2; ++s2) fbt[s2] = ldfrag(wl + P1_BTT, 80, 32 * a2 + fr, 16 * s2 + 8 * fh);
        const float gcl = lG[32 * a2 + fr];
        { f32x16 acc; const LAS bf16* lKT = (const LAS bf16*)(wl + P1_KT);
#pragma unroll
            for (int e = 0; e < 16; ++e) acc[e] = bf1(lKT[trow(e, fh) * 72 + 32 * a2 + fr]);
#pragma unroll
            for (int s2 = 0; s2 < 2; ++s2) acc = MFMA32(fzt[s2], fbt[s2], acc);
#pragma unroll
            for (int e = 0; e < 16; ++e) acc[e] *= gcl;
            *(GAS bf16x8v*)(recl + (8 + 2 * a2) * 1024) = pack_acc(acc, 0); *(GAS bf16x8v*)(recl + (9 + 2 * a2) * 1024) = pack_acc(acc, 1); }
#pragma unroll
        for (int kt = 0; kt < 2; ++kt) { __builtin_amdgcn_sched_barrier(0); f32x16 acc;
#pragma unroll
            for (int e = 0; e < 16; ++e) acc[e] = 0.f;
#pragma unroll
            for (int s2 = 0; s2 < 2; ++s2) acc = MFMA32(ldfrag(wl + P1_WT, 80, 32 * kt + fr, 16 * s2 + 8 * fh), fbt[s2], acc);
#pragma unroll
            for (int e = 0; e < 16; ++e) acc[e] *= gcl;
            *(GAS bf16x8v*)(recl + (a2 * 4 + 2 * kt) * 1024) = pack_acc(acc, 0); *(GAS bf16x8v*)(recl + (a2 * 4 + 2 * kt + 1) * 1024) = pack_acc(acc, 1); }
    }
#pragma unroll
    for (int kt = 0; kt < 2; ++kt) { __builtin_amdgcn_sched_barrier(0); f32x16 acc; const LAS bf16* lRT = (const LAS bf16*)(wl + P1_RT);
#pragma unroll
        for (int e = 0; e < 16; ++e) acc[e] = bf1(lRT[fr * 72 + 32 * kt + trow(e, fh)]);
#pragma unroll
        for (int s2 = 0; s2 < 2; ++s2) acc = MFMA32(ldfrag(wl + P1_WT, 80, 32 * kt + fr, 16 * s2 + 8 * fh), fnb[s2], acc);
        *(GAS bf16x8v*)(recl + (12 + 2 * kt) * 1024) = pack_acc(acc, 0); *(GAS bf16x8v*)(recl + (13 + 2 * kt) * 1024) = pack_acc(acc, 1); }
    asm volatile("" ::: "memory");
}
__device__ __forceinline__ void p4_conv_item(KPtr p, LAS unsigned char* lds, int item, int tid) {
    const int wave = __builtin_amdgcn_readfirstlane(tid >> 6), lane = tid & 63;
    const bf16* PB = (const bf16*)(p->ws + WS_PB); bf16* RC = (bf16*)(p->ws + WS_RC);
    const int t0 = item * 32;
    int lo, hi; if (t0 < NCTX) { lo = t0 & ~255; hi = lo + 256; } else { lo = t0 & ~63; hi = lo + 64; }
    LAS bf16* U = (LAS bf16*)lds;
    LAS float* CWL = (LAS float*)(lds + 62 * 1024);
    for (int e = tid; e < 62 * 64; e += 512) {
        const int r = e >> 6, ch = (e & 63) * 8, tok = t0 - 15 + r;
        v4u w = (v4u){0u, 0u, 0u, 0u};
        if (tok >= lo && tok < hi) { float a[8], g[8]; unpack8(*(const v4u*)(PB + (size_t)tok * 3072 + ch), a); unpack8(*(const v4u*)(PB + (size_t)tok * 3072 + 512 + ch), g);
#pragma unroll
            for (int i = 0; i < 8; ++i) a[i] *= sigm(g[i]);
            w.x = pk2(a[0], a[1]); w.y = pk2(a[2], a[3]); w.z = pk2(a[4], a[5]); w.w = pk2(a[6], a[7]); }
        *(LAS v4u*)(U + r * 512 + ch) = w;
    }
    for (int e = tid; e < 31 * 128; e += 512) ((LAS f32x4*)CWL)[e] = ((const f32x4*)p->in[I_CW])[e];
    __syncthreads();
    const int c = 8 * lane;
    float cb[8], lg[8], lb[8]; load8(p->in[I_CB] + c, cb); load8(p->in[I_CLG] + c, lg); load8(p->in[I_CLB] + c, lb);
    {
        float acc[4][8];
#pragma unroll
        for (int tt = 0; tt < 4; ++tt)
#pragma unroll
            for (int e = 0; e < 8; ++e) acc[tt][e] = cb[e];
#pragma unroll 2
        for (int j = 0; j < 31; ++j) {
            const f32x4 w0 = *(const LAS f32x4*)(CWL + j * 512 + c), w1 = *(const LAS f32x4*)(CWL + j * 512 + c + 4);
#pragma unroll
            for (int tt = 0; tt < 4; ++tt) { float uv[8]; unpack8(*(const LAS v4u*)(U + (wave * 4 + tt + j) * 512 + c), uv);
#pragma unroll
                for (int e = 0; e < 4; ++e) { acc[tt][e] += uv[e] * w0[e]; acc[tt][4 + e] += uv[4 + e] * w1[e]; } }
        }
#pragma unroll
        for (int tt = 0; tt < 4; ++tt) {
            float s = 0.f;
#pragma unroll
            for (int e = 0; e < 8; ++e) s += acc[tt][e];
            const float mean = wave_sum(s) * (1.f / 512.f); float q = 0.f;
#pragma unroll
            for (int e = 0; e < 8; ++e) { acc[tt][e] -= mean; q += acc[tt][e] * acc[tt][e]; }
            const float rstd = rsqrtf(wave_sum(q) * (1.f / 512.f) + 1e-5f);
            float o[8];
#pragma unroll
            for (int e = 0; e < 8; ++e) { const float un = acc[tt][e] * rstd * lg[e] + lb[e]; o[e] = un * sigm(un); }
            store8bf(RC + (size_t)(t0 + wave * 4 + tt) * 1024 + 512 + c, o);
        }
    }
    __syncthreads();
}
__device__ __forceinline__ void p6_post(KPtr p, int gw, int NGW, int lane) {
    const float* YF = (const float*)(p->ws + WS_YF); const float* YB = (const float*)(p->ws + WS_YB);
    const bf16* VN = (const bf16*)((const unsigned char*)p->out + DO_V); const float* DOT = (const float*)((const unsigned char*)p->out + DO_DOT); const bf16* G = (const bf16*)((const unsigned char*)p->out + DO_G); bf16* RC = (bf16*)(p->ws + WS_RC);
    const int c = 8 * lane;
    float lg[8], lb[8]; load8(p->in[I_LNXG] + c, lg); load8(p->in[I_LNXB] + c, lb);
    for (int mi = gw; mi < NTOK; mi += NGW) { const int m = (NGW == 2048) ? ((mi & 255) + 1024 * ((mi >> 8) & 7) + 256 * (mi >> 11)) : mi;

        float a[8], b[8]; load8(YF + (size_t)m * 512 + c, a); load8(YB + (size_t)m * 512 + c, b);
        float s = 0.f;
#pragma unroll
        for (int e = 0; e < 8; ++e) { a[e] += b[e]; s += a[e]; }
        const float mu = oct_sum(s) * (1.f / 64.f); float q = 0.f;
#pragma unroll
        for (int e = 0; e < 8; ++e) { a[e] -= mu; q += a[e] * a[e]; }
        const float rstd = rsqrtf(oct_sum(q) * (1.f / 64.f) + 64e-5f);
        float vv[8], g[8]; unpack8(*(const v4u*)(VN + (size_t)m * 512 + c), vv); unpack8(*(const v4u*)(G + (size_t)m * 512 + c), g);
        const float dt = DOT[(size_t)m * 8 + (lane >> 3)] + DOT[(size_t)NTOK * 8 + (size_t)m * 8 + (lane >> 3)];
#pragma unroll
        for (int e = 0; e < 8; ++e) a[e] = (a[e] * rstd * lg[e] + lb[e] + dt * vv[e]) * g[e];
        store8bf(RC + (size_t)m * 1024 + c, a);
    }
}
__device__ __forceinline__ bf16x8v p2_vfrag(const bf16* vt, int s2, int hf, int d) {
    v4u w;
    if (d == 0) { const v2u lo = *(const v2u*)(vt + 16 * s2 + 4 * hf), hi = *(const v2u*)(vt + 16 * s2 + 8 + 4 * hf); w.x = lo.x; w.y = lo.y; w.z = hi.x; w.w = hi.y; }
    else { const v2u lo = *(const v2u*)(vt + 28 - 16 * s2 - 4 * hf), hi = *(const v2u*)(vt + 20 - 16 * s2 - 4 * hf);
        w.x = __builtin_amdgcn_alignbit(lo.y, lo.y, 16); w.y = __builtin_amdgcn_alignbit(lo.x, lo.x, 16); w.z = __builtin_amdgcn_alignbit(hi.y, hi.y, 16); w.w = __builtin_amdgcn_alignbit(hi.x, hi.x, 16); }
    return __builtin_bit_cast(bf16x8v, w);
}
__device__ __forceinline__ void p5_pass2_wave(KPtr p, int X) {
    int lane; PG8_LANE(lane);
    const int r = lane & 31, hf = lane >> 5;
    const int chain = X >> 1, wq = X & 1;
    int b, h, d, m0, T, tbase; const float* s0 = nullptr; float* sfin = nullptr;
    if (chain < 32) { b = chain >> 4; h = (chain >> 1) & 7; d = chain & 1; m0 = NCTX + b * 2048; T = 2048; tbase = 1024 + (b * 8 + h) * 64; s0 = (d == 0 ? p->in[I_SF] : p->in[I_SB]) + (size_t)(b * 8 + h) * 4096; }
    else { const int cc = chain - 32; b = cc >> 4; h = (cc >> 1) & 7; d = cc & 1; m0 = b * 256; T = 256; tbase = (b * 8 + h) * 8; sfin = p->out + (size_t)NTOK * DM + (size_t)d * 524288 + (size_t)(b * 8 + h) * 4096; }
    const int nc = T / 32, vcol = 32 * wq + r;
    const bf16* VT = (const bf16*)((const unsigned char*)p->out + DO_VT) + (size_t)m0 * 512 + (size_t)h * 64 * T + (size_t)vcol * T;
    float* Y = (float*)(p->ws + (d == 0 ? WS_YF : WS_YB)) + (size_t)m0 * 512 + h * 64 + vcol;
    const float* GC = (const float*)(p->ws + WS_GC);
    f32x16 S0t, S1t;
    if (s0) {
#pragma unroll
        for (int g = 0; g < 4; ++g) { const f32x4 x0 = *(const f32x4*)(s0 + (size_t)vcol * 64 + 8 * g + 4 * hf), x1 = *(const f32x4*)(s0 + (size_t)vcol * 64 + 32 + 8 * g + 4 * hf);
#pragma unroll
            for (int e = 0; e < 4; ++e) { S0t[4 * g + e] = x0[e]; S1t[4 * g + e] = x1[e]; } }
    } else {
#pragma unroll
        for (int e = 0; e < 16; ++e) { S0t[e] = 0.f; S1t[e] = 0.f; }
    }
    bf16x8v fGP[2][4], fKP[2][2], fRP[4], fPP[2], fV[2]; f32x4 gam[2][4];
#define P2_REC(n_) (p->ws + ((((tbase + (n_)) * 2 + d) < 2048) ? WS_RECA + (size_t)((tbase + (n_)) * 2 + d) * REC_BYTES : WS_RECB + (size_t)((tbase + (n_)) * 2 + d - 2048) * REC_BYTES) + lane * 16)
#define P2_LOAD_Y(n_) do { const unsigned char* rb_ = P2_REC(n_); _Pragma("unroll") for (int s4 = 0; s4 < 4; ++s4) fRP[s4] = *(const bf16x8v*)(rb_ + (12 + s4) * 1024); \
        _Pragma("unroll") for (int s2 = 0; s2 < 2; ++s2) fPP[s2] = *(const bf16x8v*)(rb_ + (16 + s2) * 1024); } while (0)
#define P2_LOAD_S(n_) do { const unsigned char* rb_ = P2_REC(n_); const float* gc_ = GC + (size_t)((tbase + (n_)) * 2 + d) * 64 + 4 * hf; \
        _Pragma("unroll") for (int a = 0; a < 2; ++a) { _Pragma("unroll") for (int s4 = 0; s4 < 4; ++s4) fGP[a][s4] = *(const bf16x8v*)(rb_ + (a * 4 + s4) * 1024); \
            _Pragma("unroll") for (int s2 = 0; s2 < 2; ++s2) fKP[a][s2] = *(const bf16x8v*)(rb_ + (8 + a * 2 + s2) * 1024); \
            _Pragma("unroll") for (int g = 0; g < 4; ++g) gam[a][g] = *(const f32x4*)(gc_ + 32 * a + 8 * g); } \
        _Pragma("unroll") for (int s2 = 0; s2 < 2; ++s2) fV[s2] = p2_vfrag(VT + 32 * (n_), s2, hf, d); } while (0)
    { const int n0 = d ? nc - 1 : 0; P2_LOAD_Y(n0); P2_LOAD_S(n0); }
    for (int ci = 0; ci < nc; ++ci) {
        const int n = d ? nc - 1 - ci : ci, nn = d ? n - 1 : n + 1; const bool more = ci + 1 < nc;
        bf16x8v sb[4]; sb[0] = pack_acc(S0t, 0); sb[1] = pack_acc(S0t, 1); sb[2] = pack_acc(S1t, 0); sb[3] = pack_acc(S1t, 1);
        f32x16 y;
#pragma unroll
        for (int e = 0; e < 16; ++e) y[e] = 0.f;
#pragma unroll
        for (int s4 = 0; s4 < 4; ++s4) y = MFMA32(fRP[s4], sb[s4], y);
#pragma unroll
        for (int s2 = 0; s2 < 2; ++s2) y = MFMA32(fPP[s2], fV[s2], y);
        if (more) P2_LOAD_Y(nn);
        { float* yo = Y + (size_t)(32 * n) * 512;
#pragma unroll
            for (int e = 0; e < 16; ++e) yo[(size_t)(d ? 31 - trow(e, hf) : trow(e, hf)) * 512] = y[e]; }
        f32x16 n0t, n1t;
#pragma unroll
        for (int g = 0; g < 4; ++g)
#pragma unroll
            for (int e = 0; e < 4; ++e) { n0t[4 * g + e] = S0t[4 * g + e] * gam[0][g][e]; n1t[4 * g + e] = S1t[4 * g + e] * gam[1][g][e]; }
#pragma unroll
        for (int s4 = 0; s4 < 4; ++s4) { n0t = MFMA32(fGP[0][s4], sb[s4], n0t); n1t = MFMA32(fGP[1][s4], sb[s4], n1t); }
#pragma unroll
        for (int s2 = 0; s2 < 2; ++s2) { n0t = MFMA32(fKP[0][s2], fV[s2], n0t); n1t = MFMA32(fKP[1][s2], fV[s2], n1t); }
        S0t = n0t; S1t = n1t;
        if (more) P2_LOAD_S(nn);
    }
    if (sfin) {
#pragma unroll
        for (int g = 0; g < 4; ++g) { *(f32x4*)(sfin + (size_t)vcol * 64 + 8 * g + 4 * hf) = (f32x4){S0t[4 * g], S0t[4 * g + 1], S0t[4 * g + 2], S0t[4 * g + 3]};
            *(f32x4*)(sfin + (size_t)vcol * 64 + 32 + 8 * g + 4 * hf) = (f32x4){S1t[4 * g], S1t[4 * g + 1], S1t[4 * g + 2], S1t[4 * g + 3]}; }
    }
#undef P2_REC
#undef P2_LOAD_Y
#undef P2_LOAD_S
}

constexpr int P2R_NS = 5, P2R_SLOT = 25600, P2R_GAM = 18432, P2R_V = 19456, P2R_SB = 21504, P2R_FLAGS = P2R_NS * P2R_SLOT, P2R_NH = 6;
__device__ __forceinline__ void p2_chain_decode(int chain, KPtr p, int& b, int& h, int& d, int& m0, int& T, int& tbase) {
    if (chain < 32) { b = chain >> 4; h = (chain >> 1) & 7; d = chain & 1; m0 = NCTX + b * 2048; T = 2048; tbase = 1024 + (b * 8 + h) * 64; }
    else { const int cc = chain - 32; b = cc >> 4; h = (cc >> 1) & 7; d = cc & 1; m0 = b * 256; T = 256; tbase = (b * 8 + h) * 8; }
}
__device__ __forceinline__ void p5_ring_helper(KPtr p, LAS unsigned char* lds, int X, int hidx) {
    int lane; PG8_LANE(lane);
    const int r = lane & 31, hf = lane >> 5, chain = X >> 1, wq = X & 1;
    int b, h, d, m0, T, tbase; p2_chain_decode(chain, p, b, h, d, m0, T, tbase);
    const int nc = T / 32, vcol = 32 * wq + r;
    const bf16* VT = (const bf16*)((const unsigned char*)p->out + DO_VT) + (size_t)m0 * 512 + (size_t)h * 64 * T + (size_t)vcol * T;
    const float* GC = (const float*)(p->ws + WS_GC);
    volatile LAS unsigned* flags = (volatile LAS unsigned*)(lds + P2R_FLAGS);
    for (int m = hidx; m < nc; m += P2R_NH) {
        const int n = d ? nc - 1 - m : m, wt = (tbase + n) * 2 + d, slot = m % P2R_NS;
        const unsigned char* rb = p->ws + (wt < 2048 ? WS_RECA + (size_t)wt * REC_BYTES : WS_RECB + (size_t)(wt - 2048) * REC_BYTES) + lane * 16;
        bf16x8v f[18];
#pragma unroll
        for (int i = 0; i < 18; ++i) f[i] = *(const bf16x8v*)(rb + i * 1024);
        const float gv = GC[(size_t)wt * 64 + lane];
        const bf16x8v v0 = p2_vfrag(VT + 32 * n, 0, hf, d), v1 = p2_vfrag(VT + 32 * n, 1, hf, d);
        while ((int)flags[5] < m - P2R_NS + 1 || (int)flags[13] < m - P2R_NS + 1) __builtin_amdgcn_s_sleep(2);
        LAS unsigned char* sl = lds + slot * P2R_SLOT;
#pragma unroll
        for (int i = 0; i < 18; ++i) *(LAS bf16x8v*)(sl + i * 1024 + lane * 16) = f[i];
        ((LAS float*)(sl + P2R_GAM))[lane] = gv;
        *(LAS bf16x8v*)(sl + P2R_V + lane * 16) = v0; *(LAS bf16x8v*)(sl + P2R_V + 1024 + lane * 16) = v1;
        asm volatile("s_waitcnt lgkmcnt(0)" ::: "memory");
        if (lane == 0) flags[slot] = (unsigned)(m + 1);
    }
}
__device__ __forceinline__ void p5_ring_ywave(KPtr p, LAS unsigned char* lds, int X) {
    int lane; PG8_LANE(lane);
    const int r = lane & 31, hf = lane >> 5, chain = X >> 1, wq = X & 1;
    int b, h, d, m0, T, tbase; p2_chain_decode(chain, p, b, h, d, m0, T, tbase);
    const int nc = T / 32, vcol = 32 * wq + r;
    float* Y = (float*)(p->ws + (d == 0 ? WS_YF : WS_YB)) + (size_t)m0 * 512 + h * 64 + vcol;
    volatile LAS unsigned* flags = (volatile LAS unsigned*)(lds + P2R_FLAGS);
    for (int m = 0; m < nc; ++m) {
        const int n = d ? nc - 1 - m : m, slot = m % P2R_NS;
        while (flags[8 + slot] != (unsigned)(m + 1)) __builtin_amdgcn_s_sleep(1);
        asm volatile("" ::: "memory");
        const LAS unsigned char* sl = lds + slot * P2R_SLOT + lane * 16;
        f32x16 y;
#pragma unroll
        for (int e = 0; e < 16; ++e) y[e] = 0.f;
#pragma unroll
        for (int s4 = 0; s4 < 4; ++s4) y = MFMA32(*(const LAS bf16x8v*)(sl + (12 + s4) * 1024), *(const LAS bf16x8v*)(sl + P2R_SB + s4 * 1024), y);
        y = MFMA32(*(const LAS bf16x8v*)(sl + 16 * 1024), *(const LAS bf16x8v*)(sl + P2R_V), y); y = MFMA32(*(const LAS bf16x8v*)(sl + 17 * 1024), *(const LAS bf16x8v*)(sl + P2R_V + 1024), y);
        asm volatile("s_waitcnt lgkmcnt(0)" ::: "memory");
        if (lane == 0) flags[13] = (unsigned)(m + 1);
        { float* yo = Y + (size_t)(32 * n) * 512;
#pragma unroll
            for (int e = 0; e < 16; ++e) yo[(size_t)(d ? 31 - trow(e, hf) : trow(e, hf)) * 512] = y[e]; }
    }
}
__device__ __forceinline__ void p5_ring_consumer(KPtr p, LAS unsigned char* lds, int X) {
    int lane; PG8_LANE(lane);
    const int r = lane & 31, hf = lane >> 5, chain = X >> 1, wq = X & 1;
    int b, h, d, m0, T, tbase; p2_chain_decode(chain, p, b, h, d, m0, T, tbase);
    const float* s0 = (chain < 32) ? (d == 0 ? p->in[I_SF] : p->in[I_SB]) + (size_t)(b * 8 + h) * 4096 : nullptr;
    float* sfin = (chain < 32) ? nullptr : p->out + (size_t)NTOK * DM + (size_t)d * 524288 + (size_t)(b * 8 + h) * 4096;
    const int nc = T / 32, vcol = 32 * wq + r;
    volatile LAS unsigned* flags = (volatile LAS unsigned*)(lds + P2R_FLAGS);
    f32x16 S0t, S1t;
    if (s0) {
#pragma unroll
        for (int g = 0; g < 4; ++g) { const f32x4 x0 = *(const f32x4*)(s0 + (size_t)vcol * 64 + 8 * g + 4 * hf), x1 = *(const f32x4*)(s0 + (size_t)vcol * 64 + 32 + 8 * g + 4 * hf);
#pragma unroll
            for (int e = 0; e < 4; ++e) { S0t[4 * g + e] = x0[e]; S1t[4 * g + e] = x1[e]; } }
    } else {
#pragma unroll
        for (int e = 0; e < 16; ++e) { S0t[e] = 0.f; S1t[e] = 0.f; }
    }
    bf16x8v gpA[8], kpA[4], v0A, v1A, gpB[8], kpB[4], v0B, v1B;
#define C_WAIT(m_) do { while (flags[(m_) % P2R_NS] != (unsigned)((m_) + 1)) __builtin_amdgcn_s_sleep(1); asm volatile("" ::: "memory"); } while (0)
#define C_LOAD(m_, GP_, KP_, V0_, V1_) do { const LAS unsigned char* sl_ = lds + ((m_) % P2R_NS) * P2R_SLOT + lane * 16; \
        _Pragma("unroll") for (int i_ = 0; i_ < 8; ++i_) GP_[i_] = *(const LAS bf16x8v*)(sl_ + i_ * 1024); \
        _Pragma("unroll") for (int i_ = 0; i_ < 4; ++i_) KP_[i_] = *(const LAS bf16x8v*)(sl_ + (8 + i_) * 1024); \
        V0_ = *(const LAS bf16x8v*)(sl_ + P2R_V); V1_ = *(const LAS bf16x8v*)(sl_ + P2R_V + 1024); } while (0)
#define C_STEP(m_, GP_, KP_, V0_, V1_, NGP_, NKP_, NV0_, NV1_) do { const int slot_ = (m_) % P2R_NS; \
        bf16x8v sb_[4]; sb_[0] = pack_acc(S0t, 0); sb_[1] = pack_acc(S0t, 1); sb_[2] = pack_acc(S1t, 0); sb_[3] = pack_acc(S1t, 1); \
        { LAS unsigned char* slw_ = lds + slot_ * P2R_SLOT + P2R_SB + lane * 16; _Pragma("unroll") for (int s4 = 0; s4 < 4; ++s4) *(LAS bf16x8v*)(slw_ + s4 * 1024) = sb_[s4]; } \
        asm volatile("" ::: "memory"); if (lane == 0) flags[8 + slot_] = (unsigned)((m_) + 1); \
        f32x16 n0_, n1_; { const LAS float* gl_ = (const LAS float*)(lds + slot_ * P2R_SLOT + P2R_GAM) + 4 * hf; \
            _Pragma("unroll") for (int g = 0; g < 4; ++g) { const f32x4 g0 = *(const LAS f32x4*)(gl_ + 8 * g), g1 = *(const LAS f32x4*)(gl_ + 32 + 8 * g); \
                _Pragma("unroll") for (int e = 0; e < 4; ++e) { n0_[4 * g + e] = S0t[4 * g + e] * g0[e]; n1_[4 * g + e] = S1t[4 * g + e] * g1[e]; } } } \
        asm volatile("s_waitcnt lgkmcnt(0)" ::: "memory"); if (lane == 0) flags[5] = (unsigned)((m_) + 1);     \
        _Pragma("unroll") for (int s4 = 0; s4 < 4; ++s4) { n0_ = MFMA32(GP_[s4], sb_[s4], n0_); n1_ = MFMA32(GP_[4 + s4], sb_[s4], n1_); } \
        if ((m_) + 1 < nc) { C_WAIT((m_) + 1); C_LOAD((m_) + 1, NGP_, NKP_, NV0_, NV1_); }     \
        n0_ = MFMA32(KP_[0], V0_, n0_); n0_ = MFMA32(KP_[1], V1_, n0_); n1_ = MFMA32(KP_[2], V0_, n1_); n1_ = MFMA32(KP_[3], V1_, n1_); \
        S0t = n0_; S1t = n1_; } while (0)
    C_WAIT(0); C_LOAD(0, gpA, kpA, v0A, v1A);
    for (int m = 0; m < nc; m += 2) {
        C_STEP(m, gpA, kpA, v0A, v1A, gpB, kpB, v0B, v1B);
        C_STEP(m + 1, gpB, kpB, v0B, v1B, gpA, kpA, v0A, v1A);
    }
#undef C_WAIT
#undef C_LOAD
#undef C_STEP
    if (sfin) {
#pragma unroll
        for (int g = 0; g < 4; ++g) { *(f32x4*)(sfin + (size_t)vcol * 64 + 8 * g + 4 * hf) = (f32x4){S0t[4 * g], S0t[4 * g + 1], S0t[4 * g + 2], S0t[4 * g + 3]};
            *(f32x4*)(sfin + (size_t)vcol * 64 + 32 + 8 * g + 4 * hf) = (f32x4){S1t[4 * g], S1t[4 * g + 1], S1t[4 * g + 2], S1t[4 * g + 3]}; }
    }
}
__global__ void __launch_bounds__(NWAVES * 64, 2) fwd_kernel(Params p_unused) {
    extern __shared__ __attribute__((aligned(16))) unsigned char lds_raw[];
    LAS unsigned char* lds = (LAS unsigned char*)lds_raw;
    volatile LAS unsigned* MISC = (volatile LAS unsigned*)(lds + MISC_OFF);
    const int G = gridDim.x, bx = blockIdx.x, vcu = (G % 8 == 0) ? (bx % 8) * (G / 8) + bx / 8 : bx;
    const int NGW = G * NWAVES;
    const int wave0 = __builtin_amdgcn_readfirstlane(threadIdx.x >> 6);
    for (int u = threadIdx.x; u < (LDS_BYTES - LDSCTL_OFF) / 4; u += NWAVES * 64) ((LAS unsigned*)(lds + LDSCTL_OFF))[u] = 0u;
#define TID_VARS KPtr p = kp0; asm volatile("" : "+s"(p)); unsigned char* ws = p->ws; (void)ws; int lane; PG8_LANE(lane); const int wave = wave0, tid = wave0 * 64 + lane, gw = vcu * NWAVES + wave; (void)tid; (void)gw;
    __syncthreads();
    const KPtr kp0 = (KPtr)__builtin_amdgcn_kernarg_segment_ptr();
    const int lo = kp0->ph_lo, hi = kp0->ph_hi, dupm = kp0->dupmask;
    const bool multi = (hi - lo) > 1;
    XcdBarrier bar; bar.bar = (unsigned*)(kp0->ws + WS_CTL) + CW_BAR; bar.x = 0; bar.st = nullptr;
    if (multi) bar = xcd_barrier_post((unsigned*)(kp0->ws + WS_CTL) + CW_BAR, MISC + 8);
#ifndef PHMASK
#define PHMASK 0xffff
#endif
#define IN(k) (((PHMASK >> (k)) & 1) && lo <= (k) && (k) < hi)
#ifndef DUPMASK
#define DUPMASK 0
#endif
#define REP(k) for (int rep_ = 0; rep_ < 1 + ((dupm >> (k)) & 1); ++rep_)
#ifndef BARDUP
#define BARDUP 0
#endif
#define SEAM(k) do { if (IN(k) && IN((k) + 1)) { xcd_barrier(bar, wave0); if (BARDUP) xcd_barrier(bar, wave0); } } while (0)
    if (IN(0)) REP(0) { TID_VARS p0_prologue(p, lds, vcu, G, tid); }
    if (IN(1)) REP(1) { TID_VARS
        if (IN(0)) {
            if (tid == 0) { unsigned* cnt = (unsigned*)(ws + WS_CTL) + CW_MODCNT; unsigned sp = 0;
                while (__hip_atomic_load(cnt, __ATOMIC_RELAXED, __HIP_MEMORY_SCOPE_AGENT) < 192u * (1u + ((dupm >> 0) & 1))) { __builtin_amdgcn_s_sleep(2); if (++sp > (1u << 22)) break; }
                __builtin_amdgcn_fence(__ATOMIC_ACQUIRE, "agent"); asm volatile("s_waitcnt vmcnt(0)" ::: "memory"); }
            __syncthreads();
        }
        p1_norm1(p, gw, NGW, lane); } SEAM(1);
    if (IN(2)) REP(2) {
        KPtr p = kp0; asm volatile("" : "+s"(p)); unsigned char* ws = p->ws;
        typedef pg8::Gemm<1024, 1024, 1024, 1 << 20, 0, 1 << 20, 0> GT; GT g{(const bf16*)(ws + WS_XN), (const bf16*)(ws + WS_WIN)};
        pg8::StaticOrder S; S.init(NTOK, N_IN, G, bx);
        EpiG1 E{(bf16*)(ws + WS_RKV), (bf16*)(ws + WS_PB), (bf16*)(ws + WS_A2)};
        pg8::gemm_phase<EpiG1, pg8::StaticOrder, GT, true, true>(lds, g, S, E, wave0);
    } SEAM(2);
    if (IN(4)) REP(4) { TID_VARS
        if (wave < 4) { LAS unsigned char* wl = lds + wave * P1_WAVE_LDS;
            for (int W = vcu * 4 + wave; W < 4096; W += G * 4) { if (W & 1) p4_pass1<1>(p, wl, W >> 1); else p4_pass1<0>(p, wl, W >> 1); } }
        __syncthreads();
    } SEAM(4);
    if (IN(5)) REP(5) { KPtr p = kp0; asm volatile("" : "+s"(p));
        if (G == 256) {
            if (vcu < 64) {
                if (wave0 == 0) { int l_; PG8_LANE(l_); if (l_ < 16) ((volatile LAS unsigned*)(lds + P2R_FLAGS))[l_] = 0u; }
                __syncthreads();
                if (wave0 == 0) p5_ring_consumer(p, lds, vcu); else if (wave0 == 1) p5_ring_ywave(p, lds, vcu); else p5_ring_helper(p, lds, vcu, wave0 - 2);
                __syncthreads();
            } else {
                if (wave0 < 3) { const int Xc = (vcu - 64) * 3 + wave0; if (Xc < 512) p5_pass2_wave(p, 64 + Xc); }
                else { int lane; PG8_LANE(lane); LAS float* scr = (LAS float*)(lds + wave0 * 16384);
                    bf16* W1 = (bf16*)(p->ws + WS_W1); bf16* W2 = (bf16*)(p->ws + WS_W2);
                    for (int it = (vcu - 64) * 5 + (wave0 - 3); it < 4096; it += 192 * 5) { if (it < 2048) p0_transpose_item(p->in[I_W1], DFF, W1, 1024, 0, scr, it, lane); else p0_transpose_item(p->in[I_W2], DM, W2, 4096, 0, scr, it - 2048, lane); } }
            }
        } else {
            for (int X = wave0 * G + vcu; X < 576; X += NWAVES * G) p5_pass2_wave(p, X);
            { int lane; PG8_LANE(lane); LAS float* scr = (LAS float*)(lds + wave0 * 16384); bf16* W1 = (bf16*)(p->ws + WS_W1); bf16* W2 = (bf16*)(p->ws + WS_W2);
              for (int it = vcu * NWAVES + wave0; it < 4096; it += G * NWAVES) { if (it < 2048) p0_transpose_item(p->in[I_W1], DFF, W1, 1024, 0, scr, it, lane); else p0_transpose_item(p->in[I_W2], DM, W2, 4096, 0, scr, it - 2048, lane); } }
        }
    } SEAM(5);
    if (IN(6)) REP(6) { TID_VARS for (int it = vcu; it < NTOK / 32; it += G) p4_conv_item(p, lds, it, tid); p6_post(p, gw, NGW, lane); } SEAM(6);
    if (IN(7)) REP(7) {
        KPtr p = kp0; asm volatile("" : "+s"(p)); unsigned char* ws = p->ws;
        typedef pg8::Gemm<1024, 512, 512, 4, 512, 1 << 20, 0> GT; GT g{(const bf16*)(ws + WS_RC), (const bf16*)(ws + WS_WOUT)};
        pg8::StaticOrder S; S.init(NTOK, 2048, G, bx);
        EpiG3 E{(const bf16*)(ws + WS_PB), (bf16*)(ws + WS_GM)};
        pg8::gemm_phase<EpiG3, pg8::StaticOrder, GT, true, true>(lds, g, S, E, wave0);
    } SEAM(7);
    if (IN(8)) REP(8) {
        KPtr p = kp0; asm volatile("" : "+s"(p)); unsigned char* ws = p->ws;
        typedef pg8::Gemm<2048, 1024, 1024, 4, 1024, 4, 0> GT; GT g{(const bf16*)(ws + WS_GM), (const bf16*)(ws + WS_WO)};
        pg8::StaticOrder S; S.init(NTOK, 2048, G, bx);
        EpiPart E{(bf16*)(ws + WS_PART)};
        pg8::gemm_phase<EpiPart, pg8::StaticOrder, GT, true, true>(lds, g, S, E, wave0);
    } SEAM(8);
    if (IN(9)) REP(9) { TID_VARS p7_res_norm2(p, gw, NGW, lane); } SEAM(9);
    if (IN(10)) REP(10) {
        KPtr p = kp0; asm volatile("" : "+s"(p)); unsigned char* ws = p->ws;
        typedef pg8::Gemm<1024, 1024, 1024, 1 << 20, 0, 1 << 20, 0> GT; GT g{(const bf16*)(ws + WS_XN), (const bf16*)(ws + WS_W1)};
        pg8::StaticOrder S; S.init(NTOK, DFF, G, bx);
        EpiG5 E{(bf16*)(ws + WS_H)};
        pg8::gemm_phase<EpiG5, pg8::StaticOrder, GT, true, true>(lds, g, S, E, wave0);
    } SEAM(10);
    if (IN(11)) REP(11) {
        KPtr p = kp0; asm volatile("" : "+s"(p)); unsigned char* ws = p->ws;
        typedef pg8::Gemm<4096, 4096, 2048, 4, 2048, 4, 2048> GT; GT g{(const bf16*)(ws + WS_H), (const bf16*)(ws + WS_W2)};
        pg8::StaticOrder S; S.init(NTOK, 2048, G, bx);
        EpiPart E{(bf16*)(ws + WS_PART)};
        pg8::gemm_phase<EpiPart, pg8::StaticOrder, GT, true, true>(lds, g, S, E, wave0);
    } SEAM(11);
    if (IN(12)) REP(12) { TID_VARS p12_final(p, gw, NGW, lane); }
#undef IN
#undef SEAM
}

extern "C" void kernel_launch(void* const* d_in, const int* in_sizes, int n_in, void* d_out, int out_size, void* d_ws, size_t ws_size, hipStream_t stream) {
    static int grid = 0;
    if (grid == 0) {
        if (n_in != 36 || ws_size < WS_END) { fprintf(stderr, "kernel_launch: unexpected n_in %d / ws %zu\n", n_in, ws_size); grid = -1; return; }
        int dev = 0, cus = 0, per_cu = 0;
        if (hipGetDevice(&dev) != hipSuccess || hipDeviceGetAttribute(&cus, hipDeviceAttributeMultiprocessorCount, dev) != hipSuccess) { grid = -1; return; }
        if (hipFuncSetAttribute((const void*)fwd_kernel, hipFuncAttributeMaxDynamicSharedMemorySize, LDS_BYTES) != hipSuccess) { fprintf(stderr, "kernel_launch: hipFuncSetAttribute failed\n"); grid = -1; return; }
        if (hipOccupancyMaxActiveBlocksPerMultiprocessor(&per_cu, (const void*)fwd_kernel, NWAVES * 64, LDS_BYTES) != hipSuccess || per_cu < 1)
            fprintf(stderr, "kernel_launch: occupancy query reports %d\n", per_cu);
        (void)hipGetLastError();
        grid = cus;
    }
    if (grid < 0) return;
    if (hipMemsetAsync((char*)d_ws + WS_CTL, 0, CTL_ZERO_BYTES, stream) != hipSuccess) { fprintf(stderr, "kernel_launch: memset failed\n"); return; }
    Params a{};
    for (int i = 0; i < 36; ++i) a.in[i] = (const float*)d_in[i];
    a.out = (float*)d_out; a.ws = (unsigned char*)d_ws; a.dupmask = DUPMASK;
#if MK_ONE_LAUNCH
    a.ph_lo = 0; a.ph_hi = NPH;
    hipLaunchKernelGGL(fwd_kernel, dim3(grid), dim3(NWAVES * 64), LDS_BYTES, stream, a);
#else
    for (int ph = 0; ph < NPH; ++ph) { a.ph_lo = ph; a.ph_hi = ph + 1; hipLaunchKernelGGL(fwd_kernel, dim3(grid), dim3(NWAVES * 64), LDS_BYTES, stream, a); }
#endif
    const hipError_t le = hipPeekAtLastError();
    if (le != hipSuccess) fprintf(stderr, "kernel_launch: launch failed: %s\n", hipGetErrorName(le));
}
```

```cpp
#include <hip/hip_runtime.h>
#include <cstdio>
#include <cstdint>
namespace pg8 {
#define PG8_LAS __attribute__((address_space(3)))
typedef unsigned short bf16_t;
typedef short bf16x8 __attribute__((ext_vector_type(8)));
typedef float f32x4 __attribute__((ext_vector_type(4)));
typedef unsigned u32x4 __attribute__((ext_vector_type(4)));
constexpr int BM = 256, BK = 64, HALF = 128, HTB = HALF * BK * 2  , STAGE_BYTES = 8 * HTB, NXCD = 8, WGM = 4;

__host__ __device__ __forceinline__ int lds_byte(int r, int c) { const int st = (r >> 4) * 2 + (c >> 5), rr = r & 15, cc = c & 31, ob = rr * 64 + cc * 2; return st * 1024 + (ob ^ (((ob >> 9) & 1) << 5)); }
__host__ __device__ __forceinline__ void stage_rc(int b, int& R, int& C) { const int st = b / 1024, sb = b % 1024, swz = sb ^ (((sb >> 9) & 1) << 5); R = (st >> 1) * 16 + swz / 64; C = (st & 1) * 32 + (swz % 64) / 2; }
__host__ __device__ __forceinline__ int perm32(int rho) { const int n = rho >> 4, i = rho & 15; return 8 * (i >> 2) + 4 * n + (i & 3); }

struct Unit { int pm, pn; };
template <int LDA, int LDB, int KK, int GA, int ACOFF, int GB, int BCOFF>
struct Gemm { const bf16_t* A; const bf16_t* Bt;
    static constexpr int lda = LDA, ldb = LDB, K = KK;
    __device__ __forceinline__ const char* aptr(const Unit& u) const { return (const char*)(A + (size_t)u.pm * BM * LDA + (size_t)(u.pn / GA) * ACOFF); }
    __device__ __forceinline__ const char* bptr(const Unit& u) const { return (const char*)(Bt + (size_t)(u.pn % GB) * BM * LDB + (size_t)(u.pn / GB) * BCOFF); }
};

struct StaticOrder {
    int nM, nN, nwg, G, c;
    __host__ __device__ void init(int M, int N, int G_, int c_) { nM = M / BM; nN = N / BM; nwg = nM * nN; G = G_; c = c_; }
    __host__ __device__ bool next(int i, Unit& u) const {
        const long L = (long)i * G + c; if (L >= nwg) return false;
        int wgid = (int)L; { const int q = nwg / NXCD, r = nwg % NXCD, xcd = wgid % NXCD, off = wgid / NXCD; wgid = (xcd < r ? xcd * (q + 1) : r * (q + 1) + (xcd - r) * q) + off; }
        const int nig = WGM * nN, gid = wgid / nig, fm = gid * WGM, gsz = (nM - fm) < WGM ? (nM - fm) : WGM;
        u.pm = fm + ((wgid % nig) % gsz); u.pn = (wgid % nig) / gsz; return true;
    }
    __device__ __forceinline__ void a_ready(const Unit&) const {}
    __device__ __forceinline__ void done(const Unit&) const {}
};
#define PG8_LANE(x) asm volatile("v_mbcnt_lo_u32_b32 %0, -1, 0\n\tv_mbcnt_hi_u32_b32 %0, -1, %0" : "=v"(x))
typedef __bf16 bf16n2 __attribute__((ext_vector_type(2)));
typedef float f32n2 __attribute__((ext_vector_type(2)));
__device__ __forceinline__ unsigned cvt_pk_bf16(float lo, float hi) { const f32n2 v = {lo, hi}; const bf16n2 b = __builtin_convertvector(v, bf16n2); return __builtin_bit_cast(unsigned, b); }

template <class Epi, class Sched, class GemmT, bool ALIGN_EPI = false, bool SP2 = false>
__device__ __forceinline__ void gemm_phase(PG8_LAS unsigned char* lds, const GemmT g, const Sched& S, const Epi& E, const int wid) {
    int lane; PG8_LANE(lane);
    const int tid = wid * 64 + lane, wr = wid >> 2, wc = wid & 3, fr = lane & 15, fq = lane >> 4;
    const int K = g.K, nt = K / BK;
    unsigned voffA[2], voffB[2];
#pragma unroll
    for (int i = 0; i < 2; ++i) { int R, C; stage_rc(tid * 16 + i * 8192, R, C); const int Rb = Epi::PERM ? ((R & ~31) + perm32(R & 31)) : R;
        voffA[i] = (unsigned)(R * g.lda + C) * 2u; voffB[i] = (unsigned)(Rb * g.ldb + C) * 2u; }
    const size_t kstep = (size_t)(BK * 2);
    const size_t hstepA = (size_t)HALF * g.lda * 2, hstepB = (size_t)HALF * g.ldb * 2;
    const unsigned ldsw = (unsigned)wid * 1024u;
    const int aoff = lds_byte(wr * 64 + fr, fq * 8), boff = lds_byte(wc * 32 + fr, fq * 8);
#define PG8_SA(b, h) (((b) * 2 + (h)) * HTB)
#define PG8_SB(b, h) ((4 + (b) * 2 + (h)) * HTB)
#define PG8_STAGE(bufoff, gbase, voff) do { _Pragma("unroll") for (int _i = 0; _i < 2; ++_i) \
        __builtin_amdgcn_global_load_lds((const unsigned*)((const char*)(gbase) + (voff)[_i]), (PG8_LAS unsigned*)(lds + (bufoff) + ldsw + _i * 8192), 16, 0, 0); } while (0)
#define PG8_LDA(dst, b, h) do { _Pragma("unroll") for (int m = 0; m < 4; ++m) _Pragma("unroll") for (int k = 0; k < 2; ++k) dst[m][k] = *(const PG8_LAS bf16x8*)(lds + PG8_SA(b, h) + aoff + m * 2048 + k * 1024); } while (0)
#define PG8_LDB(dst, b, h) do { _Pragma("unroll") for (int n = 0; n < 2; ++n) _Pragma("unroll") for (int k = 0; k < 2; ++k) dst[n][k] = *(const PG8_LAS bf16x8*)(lds + PG8_SB(b, h) + boff + n * 2048 + k * 1024); } while (0)
#define PG8_MMA(ai, bj, At, Bt) do { __builtin_amdgcn_s_setprio(1); _Pragma("unroll") for (int m = 0; m < 4; ++m) _Pragma("unroll") for (int n = 0; n < 2; ++n) _Pragma("unroll") for (int k = 0; k < 2; ++k) \
        acc[ai][bj][m][n] = __builtin_amdgcn_mfma_f32_16x16x32_bf16(Bt[n][k], At[m][k], acc[ai][bj][m][n], 0, 0, 0); __builtin_amdgcn_s_setprio(0); } while (0)
#define PG8_WAIT_V(n) asm volatile("s_waitcnt vmcnt(" #n ")" ::: "memory")
#define PG8_WAIT_L(n) asm volatile("s_waitcnt lgkmcnt(" #n ")" ::: "memory")
#define PG8_BAR __builtin_amdgcn_s_barrier()
#define PG8_SCHED __builtin_amdgcn_sched_barrier(0)
    Unit cur, nxt; int ui = 0;
    if (!S.next(0, cur)) return;
    f32x4 acc[2][2][4][2];
#pragma unroll
    for (int a = 0; a < 2; ++a)
#pragma unroll
        for (int b = 0; b < 2; ++b)
#pragma unroll
            for (int m = 0; m < 4; ++m)
#pragma unroll
                for (int n = 0; n < 2; ++n) acc[a][b][m][n] = (f32x4){0.f, 0.f, 0.f, 0.f};
    bf16x8 At[4][2], B0[2][2], B1[2][2];
    const char* cA = g.aptr(cur); const char* cB = g.bptr(cur);
    S.a_ready(cur);
    if constexpr (SP2) {
        PG8_STAGE(PG8_SB(0, 0), cB, voffB); PG8_STAGE(PG8_SB(0, 1), cB + hstepB, voffB); PG8_STAGE(PG8_SA(0, 0), cA, voffA); PG8_STAGE(PG8_SA(0, 1), cA + hstepA, voffA);
        if (wr == 1) PG8_BAR;
        PG8_WAIT_V(2); PG8_BAR;
        PG8_STAGE(PG8_SB(1, 0), cB + kstep, voffB); PG8_STAGE(PG8_SA(1, 0), cA + kstep, voffA); PG8_STAGE(PG8_SB(1, 1), cB + hstepB + kstep, voffB);
        PG8_WAIT_V(6); PG8_BAR;
    } else {
        PG8_STAGE(PG8_SB(0, 0), cB, voffB); PG8_STAGE(PG8_SA(0, 0), cA, voffA); PG8_STAGE(PG8_SB(0, 1), cB + hstepB, voffB); PG8_STAGE(PG8_SA(0, 1), cA + hstepA, voffA);
        if (wr == 1) PG8_BAR;
        PG8_WAIT_V(4); PG8_BAR;
        PG8_STAGE(PG8_SB(1, 0), cB + kstep, voffB); PG8_STAGE(PG8_SA(1, 0), cA + kstep, voffA); PG8_STAGE(PG8_SB(1, 1), cB + hstepB + kstep, voffB);
        PG8_WAIT_V(6); PG8_BAR;
    }
    for (;;) {
        const bool has_next = S.next(ui + 1, nxt);
        const char* nA = has_next ? g.aptr(nxt) : cA; const char* nB = has_next ? g.bptr(nxt) : cB;
        for (int t = 0; t < nt; t += 2) {
            const bool last = (t == nt - 2);
            const char* a1 = cA + (size_t)(t + 1) * kstep;
            const char* a2 = last ? nA : cA + (size_t)(t + 2) * kstep; const char* b2 = last ? nB : cB + (size_t)(t + 2) * kstep;
            const char* a3 = a2 + kstep; const char* b3 = b2 + kstep;
            if (last && has_next) S.a_ready(nxt);
            if constexpr (SP2) {
            PG8_LDB(B0, 0, 0); PG8_LDB(B1, 0, 1); PG8_SCHED; PG8_LDA(At, 0, 0); PG8_STAGE(PG8_SA(1, 1), a1 + hstepA, voffA);
            PG8_WAIT_V(8); PG8_WAIT_L(0); PG8_BAR; PG8_MMA(0, 0, At, B0); PG8_MMA(0, 1, At, B1); PG8_BAR; PG8_SCHED;
            PG8_LDA(At, 0, 1); PG8_STAGE(PG8_SB(0, 0), b2, voffB); PG8_STAGE(PG8_SB(0, 1), b2 + hstepB, voffB); PG8_STAGE(PG8_SA(0, 0), a2, voffA);
            PG8_WAIT_V(8); PG8_WAIT_L(0); PG8_BAR; PG8_MMA(1, 0, At, B0); PG8_MMA(1, 1, At, B1); PG8_BAR; PG8_SCHED;
            PG8_LDB(B0, 1, 0); PG8_LDB(B1, 1, 1); PG8_SCHED; PG8_LDA(At, 1, 0); PG8_STAGE(PG8_SA(0, 1), a2 + hstepA, voffA);
            PG8_WAIT_V(8); PG8_WAIT_L(0); PG8_BAR; PG8_MMA(0, 0, At, B0); PG8_MMA(0, 1, At, B1); PG8_BAR; PG8_SCHED;
            PG8_LDA(At, 1, 1); PG8_STAGE(PG8_SB(1, 0), b3, voffB); PG8_STAGE(PG8_SB(1, 1), b3 + hstepB, voffB); PG8_STAGE(PG8_SA(1, 0), a3, voffA);
            PG8_WAIT_V(8); PG8_WAIT_L(0); PG8_BAR; PG8_MMA(1, 0, At, B0); PG8_MMA(1, 1, At, B1); PG8_BAR; PG8_SCHED;
            } else {
            PG8_LDB(B0, 0, 0); PG8_SCHED; PG8_LDA(At, 0, 0); PG8_STAGE(PG8_SA(1, 1), a1 + hstepA, voffA);
            PG8_WAIT_L(8); PG8_BAR; PG8_WAIT_L(0); PG8_MMA(0, 0, At, B0); PG8_BAR; PG8_SCHED;
            PG8_LDB(B1, 0, 1); PG8_STAGE(PG8_SB(0, 0), b2, voffB);
            PG8_BAR; PG8_WAIT_L(0); PG8_MMA(0, 1, At, B1); PG8_BAR;
            PG8_LDA(At, 0, 1); PG8_STAGE(PG8_SA(0, 0), a2, voffA);
            PG8_BAR; PG8_WAIT_L(0); PG8_MMA(1, 0, At, B0); PG8_BAR; PG8_SCHED;
            PG8_STAGE(PG8_SB(0, 1), b2 + hstepB, voffB);
            PG8_WAIT_V(6); PG8_BAR; PG8_MMA(1, 1, At, B1); PG8_BAR;
            PG8_LDB(B0, 1, 0); PG8_SCHED; PG8_LDA(At, 1, 0); PG8_STAGE(PG8_SA(0, 1), a2 + hstepA, voffA);
            PG8_WAIT_L(8); PG8_BAR; PG8_WAIT_L(0); PG8_MMA(0, 0, At, B0); PG8_BAR; PG8_SCHED;
            PG8_LDB(B1, 1, 1); PG8_STAGE(PG8_SB(1, 0), b3, voffB);
            PG8_BAR; PG8_WAIT_L(0); PG8_MMA(0, 1, At, B1); PG8_BAR;
            PG8_LDA(At, 1, 1); PG8_STAGE(PG8_SA(1, 0), a3, voffA);
            PG8_BAR; PG8_WAIT_L(0); PG8_MMA(1, 0, At, B0); PG8_BAR; PG8_SCHED;
            PG8_STAGE(PG8_SB(1, 1), b3 + hstepB, voffB);
            PG8_WAIT_V(6); PG8_BAR; PG8_MMA(1, 1, At, B1); PG8_BAR;
            }
        }
        if constexpr (ALIGN_EPI) { if (wr == 0) PG8_BAR; }
        if constexpr (!Epi::AFTER_DRAIN) { int el; PG8_LANE(el); E(acc, cur, wr, wc, el & 15, el >> 4); S.done(cur); }
        if (!has_next) break;
#pragma unroll
        for (int a = 0; a < 2; ++a)
#pragma unroll
            for (int b = 0; b < 2; ++b)
#pragma unroll
                for (int m = 0; m < 4; ++m)
#pragma unroll
                    for (int n = 0; n < 2; ++n) acc[a][b][m][n] = (f32x4){0.f, 0.f, 0.f, 0.f};
        cur = nxt; cA = nA; cB = nB; ++ui;
        if constexpr (ALIGN_EPI) { if (wr == 1) PG8_BAR; }
    }
    PG8_WAIT_V(0);
    if constexpr (!ALIGN_EPI) { if (wr == 0) PG8_BAR; }
    PG8_BAR;
    if constexpr (Epi::AFTER_DRAIN) { E.fused(acc, cur, wr, wc, fr, fq, lds, wid, lane); S.done(cur); }
#undef PG8_SA
#undef PG8_SB
#undef PG8_STAGE
#undef PG8_LDA
#undef PG8_LDB
#undef PG8_MMA
#undef PG8_WAIT_V
#undef PG8_WAIT_L
#undef PG8_BAR
#undef PG8_SCHED
}
}

constexpr int NWAVES = 8;
constexpr int NTOK = 8192, NCTX = 4096, DM = 1024, RW = 512, NH = 8, HD = 64, DFF = 4096;
constexpr int N_IN = 5888;
constexpr int NPH = 13;
#ifndef MK_ONE_LAUNCH
#define MK_ONE_LAUNCH 1
#endif
constexpr size_t MiB = 1u << 20;
constexpr size_t WS_CTL = 0, CTL_ZERO_BYTES = 64 * 1024;
constexpr size_t WS_MOD = 1 * MiB;
constexpr size_t WS_WIN = 2 * MiB;
constexpr size_t WS_B2 = 14 * MiB;
constexpr size_t WS_WOUT = 16 * MiB;
constexpr size_t WS_WO = 18 * MiB;
constexpr size_t WS_W1 = 20 * MiB;
constexpr size_t WS_W2 = 28 * MiB;
constexpr size_t WS_XN = 36 * MiB;
constexpr size_t WS_A2 = 52 * MiB;
constexpr size_t WS_RKV = 72 * MiB;
constexpr size_t WS_PB = 120 * MiB;
constexpr size_t WS_WD = 168 * MiB;
constexpr size_t WS_AL = 200 * MiB;
constexpr size_t WS_RECB = 216 * MiB;
constexpr size_t WS_GC = 252 * MiB;
constexpr size_t WS_END = 256 * MiB;
constexpr size_t WS_RECA = 168 * MiB;
constexpr size_t REC_BYTES = 18432;
constexpr size_t WS_YF = WS_RKV, WS_YB = WS_RKV + 16 * MiB, WS_RC = WS_RKV + 32 * MiB;
constexpr size_t WS_GM = 168 * MiB, WS_H = 120 * MiB, WS_X1 = 52 * MiB;
constexpr size_t WS_PARK = 96 * MiB;
constexpr size_t WS_PART = 204 * MiB;
constexpr size_t DO_G = 0, DO_V = 8 * MiB, DO_VT = 16 * MiB, DO_DOT = 24 * MiB;
constexpr int CW_MODCNT = 512;
constexpr int CW_BAR = 1024;
constexpr int RING_BYTES = 131072;
constexpr int LDSCTL_OFF = 162816, MISC_OFF = LDSCTL_OFF + 320;
constexpr int LDS_BYTES = 163840;

#define GAS __attribute__((address_space(1)))
#define LAS __attribute__((address_space(3)))
typedef unsigned short bf16;
typedef unsigned v4u __attribute__((ext_vector_type(4)));
typedef unsigned v2u __attribute__((ext_vector_type(2)));
typedef float f32x4 __attribute__((ext_vector_type(4)));
#define LDS_WAIT() asm volatile("s_waitcnt lgkmcnt(0)" ::: "memory")
#define VM_WAIT() asm volatile("s_waitcnt vmcnt(0)" ::: "memory")
__device__ __forceinline__ unsigned pk2(float lo, float hi) { return pg8::cvt_pk_bf16(lo, hi); }
__device__ __forceinline__ float bflo(unsigned u) { return __uint_as_float(u << 16); }
__device__ __forceinline__ float bfhi(unsigned u) { return __uint_as_float(u & 0xffff0000u); }
__device__ __forceinline__ float bf1(bf16 u) { return __uint_as_float((unsigned)u << 16); }
__device__ __forceinline__ float sigm(float x) { return __builtin_amdgcn_rcpf(1.0f + __expf(-x)); }
__device__ __forceinline__ float tanh_fast(float x) { const float t = __expf(2.0f * x); return 1.0f - 2.0f * __builtin_amdgcn_rcpf(t + 1.0f); }
__device__ __forceinline__ v4u pack8(const f32x4 a, const f32x4 b) { v4u w; w.x = pk2(a[0], a[1]); w.y = pk2(a[2], a[3]); w.z = pk2(b[0], b[1]); w.w = pk2(b[2], b[3]); return w; }
__device__ __forceinline__ void unpack8(const v4u w, float (&o)[8]) { o[0] = bflo(w.x); o[1] = bfhi(w.x); o[2] = bflo(w.y); o[3] = bfhi(w.y); o[4] = bflo(w.z); o[5] = bfhi(w.z); o[6] = bflo(w.w); o[7] = bfhi(w.w); }
__device__ __forceinline__ float wave_sum(float v) {
#pragma unroll
    for (int o = 1; o < 64; o <<= 1) v += __shfl_xor(v, o);
    return v;
}
__device__ __forceinline__ float oct_sum(float v) { v += __shfl_xor(v, 1); v += __shfl_xor(v, 2); v += __shfl_xor(v, 4); return v; }

#define XB_TMO      128
#define XB_XCNT(j)  (256  + 64 * (j))
#define XB_XSUB(j)  (1280 + 64 * (j))
#define XB_XGEN(j)  (2304 + 64 * (j))
#define XB_TOP      3328
#define XB_TOPGEN   3392
#define XCD_BAR_WORDS 3456
#define XB_SPIN_CAP (1u << 18)
__device__ __forceinline__ unsigned xb_ld(unsigned* p)              { return __hip_atomic_load(p, __ATOMIC_RELAXED, __HIP_MEMORY_SCOPE_AGENT); }
__device__ __forceinline__ unsigned xb_add(unsigned* p, unsigned v) { return __hip_atomic_fetch_add(p, v, __ATOMIC_RELAXED, __HIP_MEMORY_SCOPE_AGENT); }
__device__ __forceinline__ unsigned xb_xcc_id() { return (unsigned)__builtin_amdgcn_s_getreg((3 << 11) | 20) & 0xFu; }
#define XB_SPIN(cond, bar) do { unsigned _sp = 0; while (cond) { __builtin_amdgcn_s_sleep(1); \
    if ((++_sp & 255u) == 0u) { if (xb_ld(&(bar)[XB_TMO])) break; if (_sp > XB_SPIN_CAP) { atomicAdd(&(bar)[XB_TMO], 1u); break; } } } } while (0)
struct XcdBarrier { unsigned* bar; unsigned x; volatile LAS unsigned* st; };
__device__ __forceinline__ XcdBarrier xcd_barrier_post(unsigned* bar, volatile LAS unsigned* st) {
    XcdBarrier b; b.bar = bar; b.x = xb_xcc_id(); b.st = st;
    if (threadIdx.x == 0) { const unsigned rank = xb_add(&bar[XB_XCNT(b.x)], 1u); st[2] = rank; st[3] = b.x; }
    return b;
}
__device__ __forceinline__ void xcd_barrier_complete(unsigned* bar, unsigned x, unsigned& nloc, unsigned& nx, unsigned& uni) {
    const unsigned G = gridDim.x * gridDim.y * gridDim.z;
    unsigned sum, cnt, mine, even, sp = 0u;
    for (;;) {
        sum = 0u; cnt = 0u; mine = 0u; even = 1u;
#pragma unroll
        for (unsigned j = 0; j < 16; ++j) { const unsigned c = xb_ld(&bar[XB_XCNT(j)]); sum += c; cnt += (c > 0u) ? 1u : 0u; mine = (j == x) ? c : mine; even &= (c == (j < 8u ? G / 8u : 0u)) ? 1u : 0u; }
        if (sum == G) break;
        __builtin_amdgcn_s_sleep(1);
        if ((++sp & 255u) == 0u) { if (xb_ld(&bar[XB_TMO])) break; if (sp > XB_SPIN_CAP) { atomicAdd(&bar[XB_TMO], 1u); break; } }
    }
    nloc = mine > 0u ? mine : 1u; nx = cnt > 0u ? cnt : 1u;
    uni = (sum == G && (G % 8u) == 0u && even) ? 1u : 0u;
}
__device__ __forceinline__ void xcd_barrier(const XcdBarrier& b, const int wave0) {
    asm volatile("s_waitcnt vmcnt(0)" ::: "memory");
    __syncthreads();
    int l_; PG8_LANE(l_);
    if (wave0 == 0 && l_ == 0) {
        unsigned* bar = b.bar;
        __builtin_amdgcn_s_waitcnt(0);
        unsigned nloc = b.st[0], nx = b.st[1];
        if (nloc == 0u) { unsigned uni; xcd_barrier_complete(bar, b.x, nloc, nx, uni); b.st[0] = nloc; b.st[1] = nx; b.st[4] = uni; }
        const unsigned old = xb_add(&bar[XB_XSUB(b.x)], 1u);
        const unsigned gen = old / nloc;
        if (old + 1u == (gen + 1u) * nloc) {
            __builtin_amdgcn_fence(__ATOMIC_ACQUIRE, "agent");
            __builtin_amdgcn_fence(__ATOMIC_RELEASE, "agent");
            asm volatile("s_waitcnt vmcnt(0)" ::: "memory");
            const unsigned og = xb_add(&bar[XB_TOP], 1u);
            const unsigned tg = og / nx;
            if (og + 1u == (tg + 1u) * nx) xb_add(&bar[XB_TOPGEN], 1u);
            else XB_SPIN(xb_ld(&bar[XB_TOPGEN]) == tg, bar);
            xb_add(&bar[XB_XGEN(b.x)], 1u);
            asm volatile("s_waitcnt vmcnt(0)" ::: "memory");
        } else {
            __builtin_amdgcn_fence(__ATOMIC_ACQUIRE, "agent");
            XB_SPIN(xb_ld(&bar[XB_XGEN(b.x)]) == gen, bar);
            asm volatile("s_waitcnt vmcnt(0)" ::: "memory");
        }
    }
    __syncthreads();
}
#define XB_GSUB(g)  (5120 + 64 * (g))
#define XB_GGEN(g)  (9216 + 64 * (g))
__device__ __forceinline__ void group_barrier_local(const XcdBarrier& b, const int grp, const int wave0) {
    asm volatile("s_waitcnt vmcnt(0)" ::: "memory");
    __syncthreads();
    int l_; PG8_LANE(l_);
    if (wave0 == 0 && l_ == 0) {
        unsigned* bar = b.bar;
        __builtin_amdgcn_s_waitcnt(0);
        const unsigned old = xb_add(&bar[XB_GSUB(grp)], 1u);
        const unsigned gen = old / 8u;
        __builtin_amdgcn_fence(__ATOMIC_ACQUIRE, "agent");
        if (old + 1u == (gen + 1u) * 8u) xb_add(&bar[XB_GGEN(grp)], 1u);
        else XB_SPIN(xb_ld(&bar[XB_GGEN(grp)]) == gen, bar);
        asm volatile("s_waitcnt vmcnt(0)" ::: "memory");
    }
    __syncthreads();
}
__device__ __forceinline__ void xcd_barrier_local(const XcdBarrier& b, const int wave0) {
    asm volatile("s_waitcnt vmcnt(0)" ::: "memory");
    __syncthreads();
    int l_; PG8_LANE(l_);
    if (wave0 == 0 && l_ == 0) {
        unsigned* bar = b.bar;
        __builtin_amdgcn_s_waitcnt(0);
        const unsigned nloc = b.st[0];
        const unsigned old = xb_add(&bar[XB_XSUB(b.x)], 1u);
        const unsigned gen = old / nloc;
        __builtin_amdgcn_fence(__ATOMIC_ACQUIRE, "agent");
        if (old + 1u == (gen + 1u) * nloc) xb_add(&bar[XB_XGEN(b.x)], 1u);
        else XB_SPIN(xb_ld(&bar[XB_XGEN(b.x)]) == gen, bar);
        asm volatile("s_waitcnt vmcnt(0)" ::: "memory");
    }
    __syncthreads();
}

struct Params { const float* in[36]; float* out; unsigned char* ws; int ph_lo, ph_hi, dupmask, pad; };
enum { I_XP = 0, I_XS, I_SF, I_SB, I_C, I_CCTX, I_ADAW, I_ADAB, I_N1G, I_N2G, I_WIN, I_MUP, I_MUN, I_DW0, I_DW1, I_DW2, I_IA0, I_IA1, I_IA2, I_GG1, I_GG2,
       I_KK, I_KA, I_RK, I_LNXG, I_LNXB, I_WOR, I_CW, I_CB, I_CLG, I_CLB, I_WOC, I_WO, I_W1, I_W2, I_FG };

typedef const __attribute__((address_space(4))) Params* KPtr;
__device__ __forceinline__ int cond_of(int m) { return m < NCTX ? 0 : 1 + ((m - NCTX) >> 11); }

struct EpiG1 {
    static constexpr bool PERM = true, AFTER_DRAIN = false;
    bf16* RKV; bf16* PB; bf16* A2;
    __device__ __forceinline__ void operator()(const f32x4 (&acc)[2][2][4][2], const pg8::Unit& u, int wr, int wc, int fr, int fq) const {
        const int row0 = u.pm * 256 + wr * 64 + fr, colt = wc * 32 + 8 * fq;
        if (u.pn < 6) {
#pragma unroll
            for (int ai = 0; ai < 2; ++ai)
#pragma unroll
                for (int m = 0; m < 4; ++m) { bf16* rp = RKV + (size_t)(row0 + ai * 128 + m * 16) * 1536 + u.pn * 256 + colt;
#pragma unroll
                    for (int bj = 0; bj < 2; ++bj) *(v4u*)(rp + bj * 128) = pack8(acc[ai][bj][m][0], acc[ai][bj][m][1]); }
        } else if (u.pn < 18) {
#pragma unroll
            for (int ai = 0; ai < 2; ++ai)
#pragma unroll
                for (int m = 0; m < 4; ++m) { bf16* rp = PB + (size_t)(row0 + ai * 128 + m * 16) * 3072 + (u.pn - 6) * 256 + colt;
#pragma unroll
                    for (int bj = 0; bj < 2; ++bj) *(v4u*)(rp + bj * 128) = pack8(acc[ai][bj][m][0], acc[ai][bj][m][1]); }
        } else {
            const int l = u.pn - 18;
#pragma unroll
            for (int ai = 0; ai < 2; ++ai)
#pragma unroll
                for (int m = 0; m < 4; ++m) { bf16* rp = A2 + (size_t)(row0 + ai * 128 + m * 16) * 1280 + l * 256 + colt;
#pragma unroll
                    for (int bj = 0; bj < 2; ++bj) { f32x4 a = acc[ai][bj][m][0], b = acc[ai][bj][m][1];
                        if (l == 0) {
#pragma unroll
                            for (int e = 0; e < 4; ++e) { a[e] = sigm(a[e]); b[e] = sigm(b[e]); }
                        } else if (l <= 2) {
#pragma unroll
                            for (int e = 0; e < 4; ++e) { a[e] = tanh_fast(a[e]); b[e] = tanh_fast(b[e]); }
                        }
                        *(v4u*)(rp + bj * 128) = pack8(a, b); } }
        }
    }
};
struct EpiG2 {
    static constexpr bool PERM = true, AFTER_DRAIN = false;
    bf16* G; float* WD; bf16* AL; const float* w0; const float* a0;
    __device__ __forceinline__ void operator()(const f32x4 (&acc)[2][2][4][2], const pg8::Unit& u, int wr, int wc, int fr, int fq) const {
        const int row0 = u.pm * 256 + wr * 64 + fr, l = u.pn >> 1, cb = (u.pn & 1) * 256 + wc * 32 + 8 * fq;
#pragma unroll
        for (int bj = 0; bj < 2; ++bj) {
            const int c0 = cb + bj * 128;
            f32x4 o0 = (f32x4){0.f, 0.f, 0.f, 0.f}, o1 = o0;
            if (l >= 1 && l <= 2) { o0 = *(const f32x4*)(w0 + (l - 1) * 512 + c0); o1 = *(const f32x4*)(w0 + (l - 1) * 512 + c0 + 4); }
            if (l >= 3) { o0 = *(const f32x4*)(a0 + (l - 3) * 512 + c0); o1 = *(const f32x4*)(a0 + (l - 3) * 512 + c0 + 4); }
#pragma unroll
            for (int ai = 0; ai < 2; ++ai)
#pragma unroll
                for (int m = 0; m < 4; ++m) { const size_t ro = (size_t)(row0 + ai * 128 + m * 16) * 512 + c0;
                    f32x4 a = acc[ai][bj][m][0] + o0, b = acc[ai][bj][m][1] + o1;
                    if (l == 0) { *(v4u*)(G + ro) = pack8(a, b); }
                    else if (l <= 2) {
#pragma unroll
                        for (int e = 0; e < 4; ++e) { a[e] = -0.6065306597126334f * sigm(a[e]); b[e] = -0.6065306597126334f * sigm(b[e]); }
                        float* wp = WD + (size_t)(l - 1) * NTOK * 512 + ro; *(f32x4*)wp = a; *(f32x4*)(wp + 4) = b;
                    } else {
#pragma unroll
                        for (int e = 0; e < 4; ++e) { a[e] = sigm(a[e]); b[e] = sigm(b[e]); }
                        *(v4u*)(AL + (size_t)(l - 3) * NTOK * 512 + ro) = pack8(a, b);
                    } }
        }
    }
};
struct EpiG3 {
    static constexpr bool PERM = true, AFTER_DRAIN = false;
    const bf16* PB; bf16* GM;
    __device__ __forceinline__ void operator()(const f32x4 (&acc)[2][2][4][2], const pg8::Unit& u, int wr, int wc, int fr, int fq) const {
        const int row0 = u.pm * 256 + wr * 64 + fr, cb = u.pn * 256 + wc * 32 + 8 * fq;
#pragma unroll
        for (int ai = 0; ai < 2; ++ai)
#pragma unroll
            for (int m = 0; m < 4; ++m) { const int row = row0 + ai * 128 + m * 16;
#pragma unroll
                for (int bj = 0; bj < 2; ++bj) { const int c0 = cb + bj * 128;
                    const v4u gw = *(const v4u*)(PB + (size_t)row * 3072 + 1024 + c0); float g[8]; unpack8(gw, g);
                    f32x4 a = acc[ai][bj][m][0], b = acc[ai][bj][m][1];
#pragma unroll
                    for (int e = 0; e < 4; ++e) { a[e] *= sigm(g[e]); b[e] *= sigm(g[4 + e]); }
                    *(v4u*)(GM + (size_t)row * 2048 + c0) = pack8(a, b); } }
    }
};
struct EpiPart {
    static constexpr bool PERM = true, AFTER_DRAIN = false;
    bf16* PART;
    __device__ __forceinline__ void operator()(const f32x4 (&acc)[2][2][4][2], const pg8::Unit& u, int wr, int wc, int fr, int fq) const {
        const int row0 = u.pm * 256 + wr * 64 + fr, cb = (u.pn & 3) * 256 + wc * 32 + 8 * fq;
        bf16* base = PART + (size_t)(u.pn >> 2) * NTOK * 1024;
#pragma unroll
        for (int ai = 0; ai < 2; ++ai)
#pragma unroll
            for (int m = 0; m < 4; ++m) { bf16* rp = base + (size_t)(row0 + ai * 128 + m * 16) * 1024 + cb;
#pragma unroll
                for (int bj = 0; bj < 2; ++bj) *(v4u*)(rp + bj * 128) = pack8(acc[ai][bj][m][0], acc[ai][bj][m][1]); }
    }
};
struct EpiG5 {
    static constexpr bool PERM = true, AFTER_DRAIN = false;
    bf16* H;
    __device__ __forceinline__ void operator()(const f32x4 (&acc)[2][2][4][2], const pg8::Unit& u, int wr, int wc, int fr, int fq) const {
        const int row0 = u.pm * 256 + wr * 64 + fr, cb = u.pn * 256 + wc * 32 + 8 * fq;
#pragma unroll
        for (int ai = 0; ai < 2; ++ai)
#pragma unroll
            for (int m = 0; m < 4; ++m) { bf16* rp = H + (size_t)(row0 + ai * 128 + m * 16) * DFF + cb;
#pragma unroll
                for (int bj = 0; bj < 2; ++bj) { f32x4 a = acc[ai][bj][m][0], b = acc[ai][bj][m][1];
#pragma unroll
                    for (int e = 0; e < 4; ++e) { const float x = fmaxf(a[e], 0.f), y = fmaxf(b[e], 0.f); a[e] = x * x; b[e] = y * y; }
                    *(v4u*)(rp + bj * 128) = pack8(a, b); } }
    }
};

__device__ __forceinline__ void p0_transpose_item(const float* W, int N, bf16* WT, int ldt, int row_off, LAS float* scr, int item, int lane) {
    const int nblk = N / 32, kb = item / nblk, nb = item % nblk, k0 = 64 * kb, n0 = 32 * nb;
    float tv[32];
#pragma unroll
    for (int i = 0; i < 32; ++i) { const int kk = 2 * i + (lane >> 5); tv[i] = W[(size_t)(k0 + kk) * N + n0 + (lane & 31)]; }
#pragma unroll
    for (int i = 0; i < 32; ++i) { const int kk = 2 * i + (lane >> 5); scr[kk * 33 + (lane & 31)] = tv[i]; }
    LDS_WAIT(); asm volatile("" ::: "memory");
    const int c = lane & 7;
#pragma unroll
    for (int j = 0; j < 4; ++j) { const int n = (lane >> 3) + 8 * j; const LAS float* s = scr + (8 * c) * 33 + n;
        v4u o; o.x = pk2(s[0 * 33], s[1 * 33]); o.y = pk2(s[2 * 33], s[3 * 33]); o.z = pk2(s[4 * 33], s[5 * 33]); o.w = pk2(s[6 * 33], s[7 * 33]);
        *(GAS v4u*)(WT + (size_t)(row_off + n0 + n) * ldt + k0 + 8 * c) = o; }
    LDS_WAIT(); asm volatile("" ::: "memory");
}
__device__ __forceinline__ void p0_mod_item(KPtr p, LAS unsigned char* lds, int item, int tid) {
    const int wave = tid >> 6, lane = tid & 63, kk = lane >> 3, c4 = lane & 7;
    const float* ada_w = p->in[I_ADAW]; const float* cc = p->in[I_C]; const float* cx = p->in[I_CCTX];
    f32x4 a0 = (f32x4){0.f, 0.f, 0.f, 0.f}, a1 = a0, a2 = a0;
#pragma unroll
    for (int i = 0; i < 16; ++i) {
        const int k = wave * 128 + i * 8 + kk;
        const f32x4 w = *(const f32x4*)(ada_w + (size_t)k * 6144 + item * 32 + c4 * 4);
        const float c0 = cx[k], c1 = cc[k], c2 = cc[1024 + k];
        a0 += w * (c0 * sigm(c0)); a1 += w * (c1 * sigm(c1)); a2 += w * (c2 * sigm(c2));
    }
#pragma unroll
    for (int e = 0; e < 4; ++e) {
#pragma unroll
        for (int o = 8; o < 64; o <<= 1) { a0[e] += __shfl_xor(a0[e], o); a1[e] += __shfl_xor(a1[e], o); a2[e] += __shfl_xor(a2[e], o); }
    }
    LAS float* red = (LAS float*)lds;
    if (lane < 8) {
#pragma unroll
        for (int e = 0; e < 4; ++e) { red[(wave * 3 + 0) * 32 + c4 * 4 + e] = a0[e]; red[(wave * 3 + 1) * 32 + c4 * 4 + e] = a1[e]; red[(wave * 3 + 2) * 32 + c4 * 4 + e] = a2[e]; }
    }
    __syncthreads();
    if (tid < 96) { const int j = tid >> 5, c = tid & 31; float s = p->in[I_ADAB][item * 32 + c];
#pragma unroll
        for (int w = 0; w < 8; ++w) s += red[(w * 3 + j) * 32 + c];
        __hip_atomic_store((float*)(p->ws + WS_MOD) + j * 6144 + item * 32 + c, s, __ATOMIC_RELAXED, __HIP_MEMORY_SCOPE_AGENT); }
    asm volatile("s_waitcnt vmcnt(0)" ::: "memory");
    __syncthreads();
    if (tid == 0) {
        __hip_atomic_fetch_add((unsigned*)(p->ws + WS_CTL) + CW_MODCNT, 1u, __ATOMIC_RELAXED, __HIP_MEMORY_SCOPE_AGENT); }
}
__device__ __forceinline__ void p0_prologue(KPtr p, LAS unsigned char* lds, int vcu, int G, int tid) {
    const int wave = __builtin_amdgcn_readfirstlane(tid >> 6), lane = tid & 63;
    for (int it = vcu; it < 192; it += G) p0_mod_item(p, lds, it, tid);
    LAS float* scr = (LAS float*)(lds + wave * 16384);
    const int gw = vcu * NWAVES + wave, NGW = G * NWAVES;
    bf16* Win = (bf16*)(p->ws + WS_WIN); bf16* B2 = (bf16*)(p->ws + WS_B2); bf16* Wout = (bf16*)(p->ws + WS_WOUT);
    bf16* Wo = (bf16*)(p->ws + WS_WO); bf16* W1 = (bf16*)(p->ws + WS_W1); bf16* W2 = (bf16*)(p->ws + WS_W2);
    constexpr int T_WIN = 16 * 144, T_GG1 = 16 * 4, T_L1 = 16 * 2, T_GG2 = 2 * 16, T_L2 = 16, T_WOUT = 8 * 32, T_WO = 16 * 32, T_W1 = 16 * 128, T_W2 = 64 * 32;
    constexpr int NITEMS = T_WIN + T_GG1 + 4 * T_L1 + T_GG2 + 4 * T_L2;
    for (int it = gw; it < NITEMS; it += NGW) {
        int r = it;
        if (r < T_WIN) { p0_transpose_item(p->in[I_WIN], 4608, Win, 1024, 0, scr, r, lane); continue; } r -= T_WIN;
        if (r < T_GG1) { p0_transpose_item(p->in[I_GG1], 128, Win, 1024, 4608, scr, r, lane); continue; } r -= T_GG1;
        if (r < 4 * T_L1) { const int q = r / T_L1; r -= q * T_L1;
            const float* src = (q < 2 ? p->in[I_DW1] : p->in[I_IA1]) + (size_t)(q & 1) * 1024 * 64;
            p0_transpose_item(src, 64, Win, 1024, 4608 + 256 * (q + 1), scr, r, lane); continue; } r -= 4 * T_L1;
        if (r < T_GG2) { p0_transpose_item(p->in[I_GG2], 512, B2, 256, 0, scr, r, lane); continue; } r -= T_GG2;
        { const int q = r / T_L2; r -= q * T_L2;
            const float* src = (q < 2 ? p->in[I_DW2] : p->in[I_IA2]) + (size_t)(q & 1) * 64 * 512;
            p0_transpose_item(src, 512, B2, 256, 512 * (q + 1), scr, r, lane); }
    }
    const v4u z = (v4u){0u, 0u, 0u, 0u};
    for (int it = gw; it < 5 * 256; it += NGW) { const int l = it >> 8, rr = it & 255; const int real = (l == 0) ? 128 : 64;
        if (rr >= real) { GAS v4u* dst = (GAS v4u*)(Win + (size_t)(4608 + l * 256 + rr) * 1024); dst[lane] = z; dst[64 + lane] = z; } }
    for (int it = gw; it < 2560; it += NGW) { const int real = (it < 512) ? 128 : 64;
        if (lane * 4 >= real) *(GAS v2u*)(B2 + (size_t)it * 256 + lane * 4) = (v2u){0u, 0u}; }
}

__device__ __forceinline__ int row_of(int mi, int NGW, int rb = -1) { return rb >= 0 ? rb + (mi & 7) + 8 * (mi >> 11) : (NGW == 2048) ? ((mi & 255) + 1024 * ((mi >> 8) & 7) + 256 * (mi >> 11)) : mi; }
__device__ __forceinline__ void p1_norm1(KPtr p, int gw, int NGW, int lane) {
    const float* MOD = (const float*)(p->ws + WS_MOD); bf16* XN = (bf16*)(p->ws + WS_XN); const float* ng = p->in[I_N1G];
    for (int mi = gw; mi < NTOK; mi += 2 * NGW) {
        f32x4 v[2][4]; float s[2]; int mm[2];
#pragma unroll
        for (int q = 0; q < 2; ++q) { const int mi2 = mi + q * NGW; const int m = row_of(mi2 < NTOK ? mi2 : mi, NGW); mm[q] = m;
            const float* xr = (m < NCTX) ? p->in[I_XP] + (size_t)m * DM : p->in[I_XS] + (size_t)(m - NCTX) * DM;
#pragma unroll
            for (int j = 0; j < 4; ++j) v[q][j] = ((const f32x4*)xr)[lane + 64 * j]; }
#pragma unroll
        for (int q = 0; q < 2; ++q) { float ss = 0.f;
#pragma unroll
            for (int j = 0; j < 4; ++j) ss += (v[q][j][0] * v[q][j][0] + v[q][j][1] * v[q][j][1]) + (v[q][j][2] * v[q][j][2] + v[q][j][3] * v[q][j][3]);
            s[q] = ss; }
#pragma unroll
        for (int q = 0; q < 2; ++q) { const int m = mm[q]; const float* md = MOD + cond_of(m) * 6144;
            const float rstd = rsqrtf(wave_sum(s[q]) * (1.f / DM) + 1e-6f);
            GAS v2u* o8 = (GAS v2u*)(XN + (size_t)m * DM) + lane;
            if (q == 0 || mi + NGW < NTOK) {
#pragma unroll
                for (int j = 0; j < 4; ++j) { const int c = 4 * (lane + 64 * j);
                    const f32x4 g = *(const f32x4*)(ng + c), sh = *(const f32x4*)(md + c), sc = *(const f32x4*)(md + 1024 + c);
                    const f32x4 y = v[q][j] * rstd * g * (sc + 1.0f) + sh;
                    o8[64 * j] = (v2u){pk2(y[0], y[1]), pk2(y[2], y[3])}; } }
        }
    }
}
__device__ __forceinline__ void p7_res_norm2(KPtr p, int gw, int NGW, int lane, int rb) {
    const float* MOD = (const float*)(p->ws + WS_MOD); bf16* XN = (bf16*)(p->ws + WS_XN); const float* ng = p->in[I_N2G];
    const bf16* P0 = (const bf16*)(p->ws + WS_PART); const bf16* P1 = P0 + (size_t)NTOK * DM;
    for (int mi = gw; mi < NTOK; mi += 2 * NGW) {
        f32x4 v[2][4]; float s[2]; int mm[2]; const float* mdd[2];
        f32x4 xx[2][4]; v2u aw[2][4], bw[2][4];
#pragma unroll
        for (int q = 0; q < 2; ++q) { const int mi2 = mi + q * NGW; const int m = row_of(mi2 < NTOK ? mi2 : mi, NGW, rb); mm[q] = m;
            const float* xr = (m < NCTX) ? p->in[I_XP] + (size_t)m * DM : p->in[I_XS] + (size_t)(m - NCTX) * DM;
            mdd[q] = MOD + cond_of(m) * 6144;
#pragma unroll
            for (int j = 0; j < 4; ++j) { const int c = 4 * (lane + 64 * j);
                xx[q][j] = *(const f32x4*)(xr + c); aw[q][j] = *(const v2u*)(P0 + (size_t)m * DM + c); bw[q][j] = *(const v2u*)(P1 + (size_t)m * DM + c); } }
#pragma unroll
        for (int q = 0; q < 2; ++q) { const int m = mm[q]; const float* md = mdd[q]; float ss = 0.f;
            GAS v2u* x1o = (GAS v2u*)((bf16*)(p->ws + WS_X1) + (size_t)m * DM) + lane;
#pragma unroll
            for (int j = 0; j < 4; ++j) { const int c = 4 * (lane + 64 * j);
                const f32x4 g1 = *(const f32x4*)(md + 2048 + c);
                const f32x4 a = (f32x4){bflo(aw[q][j].x), bfhi(aw[q][j].x), bflo(aw[q][j].y), bfhi(aw[q][j].y)}, b = (f32x4){bflo(bw[q][j].x), bfhi(bw[q][j].x), bflo(bw[q][j].y), bfhi(bw[q][j].y)};
                const f32x4 t = xx[q][j] + g1 * (a + b);
                const v2u w = (v2u){pk2(t[0], t[1]), pk2(t[2], t[3])};
                if (q == 0 || mi + NGW < NTOK) x1o[64 * j] = w;
                v[q][j] = t;
                ss += (v[q][j][0] * v[q][j][0] + v[q][j][1] * v[q][j][1]) + (v[q][j][2] * v[q][j][2] + v[q][j][3] * v[q][j][3]); }
            s[q] = ss; }
#pragma unroll
        for (int q = 0; q < 2; ++q) { const int m = mm[q]; const float* md = mdd[q];
            const float rstd = rsqrtf(wave_sum(s[q]) * (1.f / DM) + 1e-6f);
            GAS v2u* o8 = (GAS v2u*)(XN + (size_t)m * DM) + lane;
            if (q == 0 || mi + NGW < NTOK) {
#pragma unroll
                for (int j = 0; j < 4; ++j) { const int c = 4 * (lane + 64 * j);
                    const f32x4 g = *(const f32x4*)(ng + c), sh = *(const f32x4*)(md + 3072 + c), sc = *(const f32x4*)(md + 4096 + c);
                    const f32x4 y = v[q][j] * rstd * g * (sc + 1.0f) + sh;
                    o8[64 * j] = (v2u){pk2(y[0], y[1]), pk2(y[2], y[3])}; } }
        }
    }
}
__device__ __forceinline__ void p12_final(KPtr p, int gw, int NGW, int lane, int rb) {
    const float* MOD = (const float*)(p->ws + WS_MOD); const float* fg = p->in[I_FG];
    const bf16* P0 = (const bf16*)(p->ws + WS_PART); const bf16* P1 = P0 + (size_t)NTOK * DM;
    for (int mi = gw; mi < NTOK; mi += 2 * NGW) {
        int mm[2]; v2u xw[2][4], aw[2][4], bw[2][4]; f32x4 v[2][4]; float s[2];
#pragma unroll
        for (int q = 0; q < 2; ++q) { const int mi2 = mi + q * NGW; const int m = row_of(mi2 < NTOK ? mi2 : mi, NGW, rb); mm[q] = m;
#pragma unroll
            for (int j = 0; j < 4; ++j) { const int c = 4 * (lane + 64 * j);
                xw[q][j] = *(const v2u*)((const bf16*)(p->ws + WS_X1) + (size_t)m * DM + c); aw[q][j] = *(const v2u*)(P0 + (size_t)m * DM + c); bw[q][j] = *(const v2u*)(P1 + (size_t)m * DM + c); } }
#pragma unroll
        for (int q = 0; q < 2; ++q) { const float* md = MOD + cond_of(mm[q]) * 6144; float ss = 0.f;
#pragma unroll
            for (int j = 0; j < 4; ++j) { const int c = 4 * (lane + 64 * j);
                const f32x4 g2 = *(const f32x4*)(md + 5120 + c);
                const f32x4 x = (f32x4){bflo(xw[q][j].x), bfhi(xw[q][j].x), bflo(xw[q][j].y), bfhi(xw[q][j].y)};
                const f32x4 a = (f32x4){bflo(aw[q][j].x), bfhi(aw[q][j].x), bflo(aw[q][j].y), bfhi(aw[q][j].y)}, b = (f32x4){bflo(bw[q][j].x), bfhi(bw[q][j].x), bflo(bw[q][j].y), bfhi(bw[q][j].y)};
                v[q][j] = x + g2 * (a + b);
                ss += (v[q][j][0] * v[q][j][0] + v[q][j][1] * v[q][j][1]) + (v[q][j][2] * v[q][j][2] + v[q][j][3] * v[q][j][3]); }
            s[q] = ss; }
        asm volatile("" ::: "memory");
#pragma unroll
        for (int q = 0; q < 2; ++q) { const int m = mm[q];
            const float rstd = rsqrtf(wave_sum(s[q]) * (1.f / DM) + 1e-6f);
            if (q == 0 || mi + NGW < NTOK) {
#pragma unroll
                for (int j = 0; j < 4; ++j) { const int c = 4 * (lane + 64 * j);
                    *(f32x4*)(p->out + (size_t)m * DM + c) = v[q][j] * rstd * *(const f32x4*)(fg + c); } }
        }
    }
}
template <typename T> __device__ __forceinline__ const __attribute__((address_space(1))) T* uni_ptr(const T* q) {
    unsigned long long u = (unsigned long long)q;
    unsigned lo = __builtin_amdgcn_readfirstlane((unsigned)u), hi = __builtin_amdgcn_readfirstlane((unsigned)(u >> 32));
    return (const __attribute__((address_space(1))) T*)(((unsigned long long)hi << 32) | lo);
}
__device__ __forceinline__ float ldg16(const __attribute__((address_space(1))) bf16* sb, unsigned bo, int cbytes = 0) {
    return bf1(*(const __attribute__((address_space(1))) bf16*)((const __attribute__((address_space(1))) unsigned char*)sb + bo + cbytes));
}
__device__ __forceinline__ void load8(const float* p, float (&o)[8]) { const f32x4 a = *(const f32x4*)p, b = *(const f32x4*)(p + 4); o[0] = a[0]; o[1] = a[1]; o[2] = a[2]; o[3] = a[3]; o[4] = b[0]; o[5] = b[1]; o[6] = b[2]; o[7] = b[3]; }
__device__ __forceinline__ void store8bf(bf16* p, const float (&v)[8]) { v4u w; w.x = pk2(v[0], v[1]); w.y = pk2(v[2], v[3]); w.z = pk2(v[4], v[5]); w.w = pk2(v[6], v[7]); *(GAS v4u*)p = w; }
typedef short bf16x8v __attribute__((ext_vector_type(8)));
typedef float f32x16 __attribute__((ext_vector_type(16)));
#define MFMA32(a, b, c) __builtin_amdgcn_mfma_f32_32x32x16_bf16(a, b, c, 0, 0, 0)
__device__ __forceinline__ bf16x8v ldfrag(const LAS unsigned char* base, int row_stride, int row, int col) { return *(const LAS bf16x8v*)(base + row * row_stride + col * 2); }
__device__ __forceinline__ int trow(int reg, int half) { return (reg & 3) + 8 * (reg >> 2) + 4 * half; }
__device__ __forceinline__ bf16x8v pack_acc(const f32x16& x, int s) {
    v4u w; w.x = pk2(x[8 * s], x[8 * s + 1]); w.y = pk2(x[8 * s + 2], x[8 * s + 3]); w.z = pk2(x[8 * s + 4], x[8 * s + 5]); w.w = pk2(x[8 * s + 6], x[8 * s + 7]);
    return __builtin_bit_cast(bf16x8v, w);
}
__device__ __forceinline__ int rec_off_s(int fbase, int rr, int cc) { const int s = cc >> 4, o = cc & 15, hh = (o >> 2) & 1, j = 4 * (o >> 3) + (o & 3); return (fbase + s) * 1024 + (32 * hh + rr) * 16 + j * 2; }
__device__ __forceinline__ int rec_off_n(int fbase, int rr, int ii) { const int s = ii >> 4, o = ii & 15, hh = o >> 3, j = o & 7; return (fbase + s) * 1024 + (32 * hh + rr) * 16 + j * 2; }
constexpr int P1_WAVE_LDS = 20352;
constexpr int P1_AT = 0, P1_BT = 4608, P1_RT = 9216, P1_KT = 13824, P1_RN = 18432;
constexpr int P1_L = 4608, P1_NKA = 9216, P1_BTT = 13824, P1_WT = 4608, P1_ZT = 9728, P1_NBR = 0, P1_RED0 = 0;

__device__ __forceinline__ void p4_decode(int task, int& b, int& h, int& n, int& m0, int& T) {
    if (task < 1024) { b = task >> 6; h = (task >> 3) & 7; n = task & 7; m0 = b * 256; T = 256; }
    else { const int t2 = task - 1024; b = t2 >> 9; h = (t2 >> 6) & 7; n = t2 & 63; m0 = NCTX + b * 2048; T = 2048; }
}
#if defined(TPROBE) && TPROBE >= 130 && TPROBE < 150
#define P1TOT (TPROBE == 138 || TPROBE == 139)
#define P1SEC (TPROBE == 138 || TPROBE >= 140)
#define P1K0 (P1TOT ? 0 : (TPROBE >= 140 ? TPROBE - 140 : TPROBE - 130))
#define P1K1 (P1TOT ? 8 : P1K0 + 1)
#define P1MARK(k) do { if (pslot == 0 && (P1SEC ? task >= 1024 : task < 64)) { if ((k) == P1K0) { asm volatile("s_waitcnt vmcnt(0) lgkmcnt(0)" ::: "memory"); tp0_ = __builtin_amdgcn_s_memrealtime(); } if ((k) == P1K1) { asm volatile("s_waitcnt vmcnt(0) lgkmcnt(0)" ::: "memory"); __hip_atomic_store((unsigned*)(p->ws + WS_CTL) + 8192, (unsigned)(__builtin_amdgcn_s_memrealtime() - tp0_), __ATOMIC_RELAXED, __HIP_MEMORY_SCOPE_AGENT); } } } while (0)
#else
#define P1MARK(k) do { } while (0)
#endif
template <int D>
__device__ __forceinline__ void p4_pass1(KPtr p, LAS unsigned char* wl, int task, int pslot) {
    int lane; PG8_LANE(lane);
    int b, h, n, m0, T; p4_decode(task, b, h, n, m0, T);
#if defined(TPROBE) && TPROBE >= 130 && TPROBE < 150
    unsigned long long tp0_ = 0;
#endif
    const bf16* RKV = (const bf16*)(p->ws + WS_RKV);
    const int c = h * 64 + lane, mb = m0 + 32 * n;
    const bool has_prev = n > 0, has_next = (32 * n + 32) < T;
    float kraw[34];
    {   const __attribute__((address_space(1))) bf16* srck = uni_ptr(RKV + ((size_t)mb - 1) * 1536 + 512 + h * 64);
        unsigned eo = (unsigned)lane * 2u;
        kraw[0] = has_prev ? ldg16(srck, eo) : 0.f;
#pragma unroll
        for (int i = 0; i < 32; ++i) { eo += 3072u; asm volatile("" : "+v"(eo)); kraw[i + 1] = ldg16(srck, eo); }
        eo += 3072u; kraw[33] = has_next ? ldg16(srck, eo) : 0.f; }
    P1MARK(0);
    __builtin_amdgcn_sched_barrier(0);
    float lw[32], al[32];
    {   const int fr0 = lane & 31, fh0 = lane >> 5;
        const bf16* A2p = (const bf16*)(p->ws + WS_A2) + (size_t)(mb + fr0) * 1280 + 8 * fh0;
        const bf16* B2p = (const bf16*)(p->ws + WS_B2) + (size_t)(h * 64 + fr0) * 256 + 8 * fh0;
        const float w0c = p->in[I_DW0][D * 512 + c], a0c = p->in[I_IA0][D * 512 + c];
#pragma unroll
        for (int which = 0; which < (D == 0 ? 3 : 2); ++which) {
            const int l = (which == 0) ? 1 + D : (which == 1) ? 3 + D : 0, nk = (which == 2) ? 8 : 4;
            f32x16 c0, c1;
#pragma unroll
            for (int e = 0; e < 16; ++e) { c0[e] = 0.f; c1[e] = 0.f; }
#pragma unroll
            for (int s4 = 0; s4 < nk; ++s4) { const bf16x8v a = *(const bf16x8v*)(A2p + 256 * l + 16 * s4);
                const bf16x8v b0 = *(const bf16x8v*)(B2p + (size_t)(l * 512) * 256 + 16 * s4), b1 = *(const bf16x8v*)(B2p + (size_t)(l * 512 + 32) * 256 + 16 * s4);
                c0 = MFMA32(a, b0, c0); c1 = MFMA32(a, b1, c1); }
#pragma unroll
            for (int e = 0; e < 16; ++e) {
                const auto sw = __builtin_amdgcn_permlane32_swap(__float_as_uint(c0[e]), __float_as_uint(c1[e]), false, false);
                const float x0 = __uint_as_float(sw[0]), x1 = __uint_as_float(sw[1]);
                const int t0 = trow(e, 0), t1 = trow(e, 1);
                if (which == 0) { lw[t0] = -0.6065306597126334f * sigm(w0c + x0); lw[t1] = -0.6065306597126334f * sigm(w0c + x1); }
                else if (which == 1) { al[t0] = sigm(a0c + x0); al[t1] = sigm(a0c + x1); }
                else { bf16* Gp = (bf16*)((unsigned char*)p->out + DO_G) + (size_t)mb * 512 + c; Gp[(size_t)t0 * 512] = (bf16)(pk2(x0, 0.f) & 0xffffu); Gp[(size_t)t1 * 512] = (bf16)(pk2(x1, 0.f) & 0xffffu); }
            }
        }
    }
    __builtin_amdgcn_sched_barrier(0);
    P1MARK(1);
    {   const float mp = p->in[I_MUP][512 + c], mn = p->in[I_MUN][512 + c], kkw = p->in[I_KK][c];
        LAS float* red = (LAS float*)(wl + P1_RED0);
#pragma unroll
        for (int i = 0; i < 32; ++i) { const float u = (kraw[i + 1] + (kraw[i] - kraw[i + 1]) * mp + (kraw[i + 2] - kraw[i + 1]) * mn) * kkw; red[i * 68 + lane] = u * u; }
        asm volatile("" ::: "memory");
        const int ri = lane & 31, hf = lane >> 5; float ssum = 0.f;
#pragma unroll
        for (int q = 0; q < 8; ++q) { const f32x4 x = *(const LAS f32x4*)(red + ri * 68 + hf * 32 + 4 * q); ssum += (x[0] + x[1]) + (x[2] + x[3]); }
        ssum += __int_as_float(__builtin_amdgcn_ds_bpermute((lane ^ 32) << 2, __float_as_int(ssum)));
        if (lane < 32) ((LAS float*)(wl + P1_RN))[lane] = rsqrtf(fmaxf(ssum, 1e-24f));
    }
    asm volatile("" ::: "memory");
    P1MARK(2);
    float gC;
    {   const float kaw = p->in[I_KA][c], kkw = p->in[I_KK][c];
        const float mpr = p->in[I_MUP][c], mnr = p->in[I_MUN][c], mpk = p->in[I_MUP][512 + c], mnk = p->in[I_MUN][512 + c], mpv = p->in[I_MUP][1024 + c], mnv = p->in[I_MUN][1024 + c];
        LAS bf16* lAT = (LAS bf16*)(wl + P1_AT); LAS bf16* lBT = (LAS bf16*)(wl + P1_BT); LAS bf16* lRT = (LAS bf16*)(wl + P1_RT); LAS bf16* lKT = (LAS bf16*)(wl + P1_KT);
        const LAS float* rnl = (const LAS float*)(wl + P1_RN);
        const int j0 = D ? 31 : 0;
        const __attribute__((address_space(1))) bf16* src = uni_ptr(RKV + ((size_t)mb - 1) * 1536 + h * 64);
        bf16* VN = (bf16*)((unsigned char*)p->out + DO_V) + (size_t)mb * 512 + c;
        bf16* VT = (bf16*)((unsigned char*)p->out + DO_VT) + (size_t)m0 * 512 + (size_t)h * 64 * T + (size_t)lane * T + 32 * n;
        const bool has_behind = D ? has_next : has_prev, has_ahead = D ? has_prev : has_next;
        constexpr int stp = D ? -3072 : 3072;
        unsigned eo = (unsigned)lane * 2u + (unsigned)(j0 + 1) * 3072u;
        float rb = has_behind ? ldg16(src, eo - stp) : 0.f, kb = has_behind ? ldg16(src, eo - stp, 1024) : 0.f, vb = has_behind ? ldg16(src, eo - stp, 2048) : 0.f;
        float rc = ldg16(src, eo), kc = ldg16(src, eo, 1024), vc = ldg16(src, eo, 2048);
        float Lc = 0.f, gprev = 1.f; float vtp[8];
        int vo = 0;
        float nra[8], nka[8], nva[8];
#define P1_LOAD_GROUP(g_) do { _Pragma("unroll") for (int u_ = 0; u_ < 8; ++u_) { const int s_ = 8 * (g_) + u_; \
            eo += stp; asm volatile("" : "+v"(eo)); const bool ha_ = (s_ < 31) || has_ahead; \
            nra[u_] = ha_ ? ldg16(src, eo) : 0.f; nka[u_] = ha_ ? ldg16(src, eo, 1024) : 0.f; nva[u_] = ha_ ? ldg16(src, eo, 2048) : 0.f; } } while (0)
        P1_LOAD_GROUP(0);
#pragma unroll
        for (int g8 = 0; g8 < 4; ++g8) {
            float cra[8], cka[8], cva[8];
#pragma unroll
            for (int u = 0; u < 8; ++u) { cra[u] = nra[u]; cka[u] = nka[u]; cva[u] = nva[u]; }
            if (g8 < 3) P1_LOAD_GROUP(g8 + 1);
#pragma unroll
            for (int u = 0; u < 8; ++u) {
                const int s = 8 * g8 + u, j = D ? 31 - s : s;
                const float lwj = lw[j], alj = al[j], ra = cra[u], ka = cka[u], va = cva[u];
                const float rp_ = D ? ra : rb, rn_ = D ? rb : ra, kp_ = D ? ka : kb, kn_ = D ? kb : ka, vp_ = D ? va : vb, vn_ = D ? vb : va;
                const float rj = rc + (rp_ - rc) * mpr + (rn_ - rc) * mnr, kj = kc + (kp_ - kc) * mpk + (kn_ - kc) * mnk, vj = vc + (vp_ - vc) * mpv + (vn_ - vc) * mnv;
                const float kkj = kj * kkw * rnl[j];
                Lc += lwj;
                const float g = __expf(Lc), gi = __expf(-Lc);
                const float kd = kj * (1.f + (alj - 1.f) * kaw), bb = kkj * alj;
                const float at = -kkj * gprev;
                const float rt = rj * g, bt = bb * gi, kt = kd * gi;
                lAT[s * 72 + lane] = (bf16)(pk2(at, 0.f) & 0xffffu); lBT[s * 72 + lane] = (bf16)(pk2(bt, 0.f) & 0xffffu);
                lRT[s * 72 + lane] = (bf16)(pk2(rt, 0.f) & 0xffffu); lKT[s * 72 + lane] = (bf16)(pk2(kt, 0.f) & 0xffffu);
                if (D == 0) { VN[vo] = (bf16)(pk2(vj, 0.f) & 0xffffu); vo += 512; asm volatile("" : "+v"(vo)); vtp[u] = vj; }
                gprev = g; rb = rc; kb = kc; vb = vc; rc = ra; kc = ka; vc = va;
            }
            if (D == 0) { v4u w; w.x = pk2(vtp[0], vtp[1]); w.y = pk2(vtp[2], vtp[3]); w.z = pk2(vtp[4], vtp[5]); w.w = pk2(vtp[6], vtp[7]); *(GAS v4u*)(VT + 8 * g8) = w; }
            __builtin_amdgcn_sched_barrier(0);
        }
#undef P1_LOAD_GROUP
        gC = gprev;
    }
    asm volatile("" ::: "memory");
    P1MARK(3);
    {   const int ri = lane & 31, hf = lane >> 5; float ssum = 0.f;
        const float* rkp = p->in[I_RK] + h * 64 + 32 * hf;
#pragma unroll
        for (int q = 0; q < 4; ++q) { float rr[8], kk8[8], w8[8];
            unpack8(*(const LAS v4u*)(wl + P1_RT + ri * 144 + (32 * hf + 8 * q) * 2), rr); unpack8(*(const LAS v4u*)(wl + P1_KT + ri * 144 + (32 * hf + 8 * q) * 2), kk8); load8(rkp + 8 * q, w8);
#pragma unroll
            for (int e = 0; e < 8; ++e) ssum += rr[e] * kk8[e] * w8[e]; }
        ssum += __int_as_float(__builtin_amdgcn_ds_bpermute((lane ^ 32) << 2, __float_as_int(ssum)));
        if (lane < 32) ((float*)((unsigned char*)p->out + DO_DOT))[(size_t)D * NTOK * 8 + (size_t)(mb + (D ? 31 - lane : lane)) * 8 + h] = ssum;
    }
    asm volatile("" ::: "memory");
    P1MARK(4);
    const int fr = lane & 31, fh = lane >> 5;
    f32x16 nab, nka, nbr, nkr;
#pragma unroll
    for (int e = 0; e < 16; ++e) { nab[e] = 0.f; nka[e] = 0.f; nbr[e] = 0.f; nkr[e] = 0.f; }
    { bf16x8v fa[4], fb[4], fR[4], fk[4];
#pragma unroll
        for (int s4 = 0; s4 < 4; ++s4) { fa[s4] = ldfrag(wl + P1_AT, 144, fr, 16 * s4 + 8 * fh); fb[s4] = ldfrag(wl + P1_BT, 144, fr, 16 * s4 + 8 * fh);
            fR[s4] = ldfrag(wl + P1_RT, 144, fr, 16 * s4 + 8 * fh); fk[s4] = ldfrag(wl + P1_KT, 144, fr, 16 * s4 + 8 * fh); }
#pragma unroll
        for (int s4 = 0; s4 < 4; ++s4) { nab = MFMA32(fa[s4], fb[s4], nab); nka = MFMA32(fa[s4], fk[s4], nka); nbr = MFMA32(fR[s4], fb[s4], nbr); nkr = MFMA32(fk[s4], fR[s4], nkr); }
    }
    unsigned nbp[8];
    unsigned* park = (unsigned*)(p->ws + WS_PARK) + (size_t)pslot * 2048 + lane;
    {   unsigned ktp[16], rtp[16]; const LAS bf16* lKT = (const LAS bf16*)(wl + P1_KT); const LAS bf16* lRT = (const LAS bf16*)(wl + P1_RT);
#pragma unroll
        for (int a2 = 0; a2 < 2; ++a2) {
#pragma unroll
            for (int e = 0; e < 16; e += 2) { ktp[a2 * 8 + (e >> 1)] = (unsigned)lKT[trow(e, fh) * 72 + 32 * a2 + fr] | ((unsigned)lKT[trow(e + 1, fh) * 72 + 32 * a2 + fr] << 16);
                rtp[a2 * 8 + (e >> 1)] = (unsigned)lRT[fr * 72 + 32 * a2 + trow(e, fh)] | ((unsigned)lRT[fr * 72 + 32 * a2 + trow(e + 1, fh)] << 16);
                if ((e & 6) == 6) __builtin_amdgcn_sched_barrier(0); } }
#pragma unroll
        for (int i = 0; i < 16; ++i) { __hip_atomic_store(park + i * 64, ktp[i], __ATOMIC_RELAXED, __HIP_MEMORY_SCOPE_AGENT); __hip_atomic_store(park + (16 + i) * 64, rtp[i], __ATOMIC_RELAXED, __HIP_MEMORY_SCOPE_AGENT); }
    }
    asm volatile("" ::: "memory");
    {   const LAS bf16* lBT = (const LAS bf16*)(wl + P1_BT);
        v4u bq[4];
#pragma unroll
        for (int q = 0; q < 4; ++q) { unsigned w[4];
#pragma unroll
            for (int e = 0; e < 4; ++e) w[e] = (unsigned)lBT[(8 * q + 2 * e) * 72 + lane] | ((unsigned)lBT[(8 * q + 2 * e + 1) * 72 + lane] << 16);
            bq[q] = (v4u){w[0], w[1], w[2], w[3]}; __builtin_amdgcn_sched_barrier(0); }
        asm volatile("" ::: "memory");
#pragma unroll
        for (int q = 0; q < 4; ++q) *(LAS v4u*)(wl + P1_BTT + lane * 80 + q * 16) = bq[q];
        __builtin_amdgcn_sched_barrier(0);
    }
    asm volatile("" ::: "memory");
    { LAS float* lL = (LAS float*)(wl + P1_L); LAS float* lN = (LAS float*)(wl + P1_NKA);
#pragma unroll
        for (int e = 0; e < 16; ++e) { const int t = trow(e, fh), i = fr;
            const float vab = (i < t) ? nab[e] : 0.f, vka = (i < t) ? nka[e] : 0.f; nbr[e] = (i <= t) ? nbr[e] : 0.f; nkr[e] = (t <= i) ? nkr[e] : 0.f;
            lL[t * 32 + i] = vab; lN[t * 33 + i] = vka; }
#pragma unroll
        for (int e = 0; e < 16; e += 2) nbp[e >> 1] = pk2(nbr[e], nbr[e + 1]); }
    asm volatile("" ::: "memory");
    P1MARK(5);
    pg8::f32n2 WZ[32];
    { int dep = 0; asm volatile("" : "+v"(dep));
#pragma unroll
        for (int t = 0; t < 32; ++t) {
            if (t >= 2) asm volatile("" : "+v"(dep) : "v"(WZ[t - 2]));
            const LAS float* lL = (const LAS float*)(wl + P1_L) + dep; const LAS float* lN = (const LAS float*)(wl + P1_NKA) + dep; const LAS bf16* lAT = (const LAS bf16*)(wl + P1_AT) + dep;
            pg8::f32n2 a0 = (pg8::f32n2){bf1(lAT[t * 72 + lane]), lN[t * 33 + fr]}, a1 = (pg8::f32n2){0.f, 0.f};
#pragma unroll
            for (int i4 = 0; i4 * 4 < t; ++i4) { const f32x4 l4 = *(const LAS f32x4*)(lL + t * 32 + 4 * i4);
#pragma unroll
                for (int e = 0; e < 4; ++e) { const int i = 4 * i4 + e; if (i < t) { const pg8::f32n2 lv = (pg8::f32n2){l4[e], l4[e]}; if (e & 1) a1 = __builtin_elementwise_fma(lv, WZ[i], a1); else a0 = __builtin_elementwise_fma(lv, WZ[i], a0); } } }
            WZ[t] = a0 + a1;
        } }
    float W[32], Z[32];
#pragma unroll
    for (int t = 0; t < 32; ++t) { W[t] = WZ[t][0]; Z[t] = WZ[t][1]; }
    asm volatile("" ::: "memory");
    P1MARK(6);
    unsigned ktp[16], rtp[16];
#pragma unroll
    for (int i = 0; i < 16; ++i) { ktp[i] = __hip_atomic_load(park + i * 64, __ATOMIC_RELAXED, __HIP_MEMORY_SCOPE_AGENT); rtp[i] = __hip_atomic_load(park + (16 + i) * 64, __ATOMIC_RELAXED, __HIP_MEMORY_SCOPE_AGENT); }
#pragma unroll
    for (int q = 0; q < 4; ++q) { v4u w; w.x = pk2(W[8 * q], W[8 * q + 1]); w.y = pk2(W[8 * q + 2], W[8 * q + 3]); w.z = pk2(W[8 * q + 4], W[8 * q + 5]); w.w = pk2(W[8 * q + 6], W[8 * q + 7]); *(LAS v4u*)(wl + P1_WT + lane * 80 + 16 * q) = w; }
    if (lane < 32) {
#pragma unroll
        for (int q = 0; q < 4; ++q) { v4u w; w.x = pk2(Z[8 * q], Z[8 * q + 1]); w.y = pk2(Z[8 * q + 2], Z[8 * q + 3]); w.z = pk2(Z[8 * q + 4], Z[8 * q + 5]); w.w = pk2(Z[8 * q + 6], Z[8 * q + 7]); *(LAS v4u*)(wl + P1_ZT + lane * 80 + 16 * q) = w; } }
    { LAS bf16* lB = (LAS bf16*)(wl + P1_NBR);
#pragma unroll
        for (int e = 0; e < 16; e += 2) { lB[trow(e, fh) * 40 + fr] = (bf16)(nbp[e >> 1] & 0xffffu); lB[trow(e + 1, fh) * 40 + fr] = (bf16)(nbp[e >> 1] >> 16); } }
    asm volatile("" ::: "memory");
    float gcl2[2];
    { const auto sw = __builtin_amdgcn_permlane32_swap(__float_as_uint(gC), __float_as_uint(gC), false, false); gcl2[0] = __uint_as_float(sw[0]); gcl2[1] = __uint_as_float(sw[1]); }
    P1MARK(7);
    const int wt = task * 2 + D;
    unsigned char* rec = p->ws + (wt < 2048 ? WS_RECA + (size_t)wt * REC_BYTES : WS_RECB + (size_t)(wt - 2048) * REC_BYTES);
    ((float*)(p->ws + WS_GC))[(size_t)wt * 64 + lane] = gC;
    bf16x8v fnb[2], fzt[2];
#pragma unroll
    for (int s2 = 0; s2 < 2; ++s2) { fnb[s2] = ldfrag(wl + P1_NBR, 80, fr, 16 * s2 + 8 * fh); fzt[s2] = ldfrag(wl + P1_ZT, 80, fr, 16 * s2 + 8 * fh); }
    unsigned char* recl = rec + lane * 16;
    __builtin_amdgcn_sched_barrier(0);
    { f32x16 acc = nkr;
#pragma unroll
        for (int s2 = 0; s2 < 2; ++s2) acc = MFMA32(fzt[s2], fnb[s2], acc);
        *(GAS bf16x8v*)(recl + 16 * 1024) = pack_acc(acc, 0); *(GAS bf16x8v*)(recl + 17 * 1024) = pack_acc(acc, 1); }
#pragma unroll
    for (int a2 = 0; a2 < 2; ++a2) {
        __builtin_amdgcn_sched_barrier(0);
        bf16x8v fbt[2];
#pragma unroll
        for (int s2 = 0; s2 < 2; ++s2) fbt[s2] = ldfrag(wl + P1_BTT, 80, 32 * a2 + fr, 16 * s2 + 8 * fh);
        const float gcl = gcl2[a2];
        { f32x16 acc;
#pragma unroll
            for (int e = 0; e < 16; e += 2) { acc[e] = bflo(ktp[a2 * 8 + (e >> 1)]); acc[e + 1] = bfhi(ktp[a2 * 8 + (e >> 1)]); }
#pragma unroll
            for (int s2 = 0; s2 < 2; ++s2) acc = MFMA32(fzt[s2], fbt[s2], acc);
#pragma unroll
            for (int e = 0; e < 16; ++e) acc[e] *= gcl;
            *(GAS bf16x8v*)(recl + (8 + 2 * a2) * 1024) = pack_acc(acc, 0); *(GAS bf16x8v*)(recl + (9 + 2 * a2) * 1024) = pack_acc(acc, 1); }
#pragma unroll
        for (int kt = 0; kt < 2; ++kt) { __builtin_amdgcn_sched_barrier(0); f32x16 acc;
#pragma unroll
            for (int e = 0; e < 16; ++e) acc[e] = 0.f;
#pragma unroll
            for (int s2 = 0; s2 < 2; ++s2) acc = MFMA32(ldfrag(wl + P1_WT, 80, 32 * kt + fr, 16 * s2 + 8 * fh), fbt[s2], acc);
#pragma unroll
            for (int e = 0; e < 16; ++e) acc[e] *= gcl;
            *(GAS bf16x8v*)(recl + (a2 * 4 + 2 * kt) * 1024) = pack_acc(acc, 0); *(GAS bf16x8v*)(recl + (a2 * 4 + 2 * kt + 1) * 1024) = pack_acc(acc, 1); }
    }
#pragma unroll
    for (int kt = 0; kt < 2; ++kt) { __builtin_amdgcn_sched_barrier(0); f32x16 acc;
#pragma unroll
        for (int e = 0; e < 16; e += 2) { acc[e] = bflo(rtp[kt * 8 + (e >> 1)]); acc[e + 1] = bfhi(rtp[kt * 8 + (e >> 1)]); }
#pragma unroll
        for (int s2 = 0; s2 < 2; ++s2) acc = MFMA32(ldfrag(wl + P1_WT, 80, 32 * kt + fr, 16 * s2 + 8 * fh), fnb[s2], acc);
        *(GAS bf16x8v*)(recl + (12 + 2 * kt) * 1024) = pack_acc(acc, 0); *(GAS bf16x8v*)(recl + (13 + 2 * kt) * 1024) = pack_acc(acc, 1); }
    P1MARK(8);
    asm volatile("" ::: "memory");
}
typedef __bf16 bf2v __attribute__((ext_vector_type(2)));
__device__ __forceinline__ float dot2bf(unsigned a, unsigned b, float c) { return __builtin_amdgcn_fdot2_f32_bf16(__builtin_bit_cast(bf2v, a), __builtin_bit_cast(bf2v, b), c, false); }
__device__ __forceinline__ void p4_conv_item(KPtr p, LAS unsigned char* lds, int item, int tid) {
    const int wave = __builtin_amdgcn_readfirstlane(tid >> 6), lane = tid & 63;
    const bf16* PB = (const bf16*)(p->ws + WS_PB); bf16* RC = (bf16*)(p->ws + WS_RC);
    const int t0 = item * 32;
    int lo, hi; if (t0 < NCTX) { lo = t0 & ~255; hi = lo + 256; } else { lo = t0 & ~63; hi = lo + 64; }
    LAS unsigned* U2 = (LAS unsigned*)lds;
    LAS unsigned* CW2 = (LAS unsigned*)(lds + 31 * 2048);
    {
        v2u a0[8], g0[8], a1[8], g1[8]; f32x4 wm[4], w0[4], w1[4];
#pragma unroll
        for (int k = 0; k < 8; ++k) { const int e = tid + 512 * k, m = e >> 7, q4 = (e & 127) * 4, tok = t0 - 15 + 2 * m;
            a0[k] = (v2u){0u, 0u}; g0[k] = a0[k]; a1[k] = a0[k]; g1[k] = a0[k];
            if (e < 31 * 128) { if (tok >= lo && tok < hi) { a0[k] = *(const v2u*)(PB + (size_t)tok * 3072 + q4); g0[k] = *(const v2u*)(PB + (size_t)tok * 3072 + 512 + q4); }
                if (tok + 1 >= lo && tok + 1 < hi) { a1[k] = *(const v2u*)(PB + (size_t)(tok + 1) * 3072 + q4); g1[k] = *(const v2u*)(PB + (size_t)(tok + 1) * 3072 + 512 + q4); } } }
#pragma unroll
        for (int k = 0; k < 4; ++k) { const int e = tid + 512 * k, i = e >> 7, q4 = (e & 127) * 4; const float* cw = p->in[I_CW] + q4;
            wm[k] = (i > 0) ? *(const f32x4*)(cw + (2 * i - 1) * 512) : (f32x4){0.f, 0.f, 0.f, 0.f}; w0[k] = *(const f32x4*)(cw + (2 * i) * 512);
            w1[k] = (i < 15) ? *(const f32x4*)(cw + (2 * i + 1) * 512) : (f32x4){0.f, 0.f, 0.f, 0.f}; }
#pragma unroll
        for (int k = 0; k < 8; ++k) { const int e = tid + 512 * k, m = e >> 7, q4 = (e & 127) * 4;
            if (e < 31 * 128) {
                const float x0[4] = {bflo(a0[k].x) * sigm(bflo(g0[k].x)), bfhi(a0[k].x) * sigm(bfhi(g0[k].x)), bflo(a0[k].y) * sigm(bflo(g0[k].y)), bfhi(a0[k].y) * sigm(bfhi(g0[k].y))};
                const float x1[4] = {bflo(a1[k].x) * sigm(bflo(g1[k].x)), bfhi(a1[k].x) * sigm(bfhi(g1[k].x)), bflo(a1[k].y) * sigm(bflo(g1[k].y)), bfhi(a1[k].y) * sigm(bfhi(g1[k].y))};
                *(LAS v4u*)(U2 + m * 512 + q4) = (v4u){pk2(x0[0], x1[0]), pk2(x0[1], x1[1]), pk2(x0[2], x1[2]), pk2(x0[3], x1[3])}; } }
#pragma unroll
        for (int k = 0; k < 4; ++k) { const int e = tid + 512 * k, i = e >> 7, q4 = (e & 127) * 4;
            *(LAS v4u*)(CW2 + i * 512 + q4) = (v4u){pk2(w0[k][0], w1[k][0]), pk2(w0[k][1], w1[k][1]), pk2(w0[k][2], w1[k][2]), pk2(w0[k][3], w1[k][3])};
            *(LAS v4u*)(CW2 + (16 + i) * 512 + q4) = (v4u){pk2(wm[k][0], w0[k][0]), pk2(wm[k][1], w0[k][1]), pk2(wm[k][2], w0[k][2]), pk2(wm[k][3], w0[k][3])}; }
    }
    __syncthreads();
    const int c = 8 * lane;
    float cb[8], lg[8], lb[8]; load8(p->in[I_CB] + c, cb); load8(p->in[I_CLG] + c, lg); load8(p->in[I_CLB] + c, lb);
    {
        float acc[4][8];
#pragma unroll
        for (int tt = 0; tt < 4; ++tt)
#pragma unroll
            for (int e = 0; e < 8; ++e) acc[tt][e] = cb[e];
#pragma unroll 2
        for (int i = 0; i < 16; ++i) {
            const v4u we0 = *(const LAS v4u*)(CW2 + i * 512 + c), we1 = *(const LAS v4u*)(CW2 + i * 512 + c + 4), wo0 = *(const LAS v4u*)(CW2 + (16 + i) * 512 + c), wo1 = *(const LAS v4u*)(CW2 + (16 + i) * 512 + c + 4);
            const v4u ua0 = *(const LAS v4u*)(U2 + (2 * wave + i) * 512 + c), ua1 = *(const LAS v4u*)(U2 + (2 * wave + i) * 512 + c + 4), ub0 = *(const LAS v4u*)(U2 + (2 * wave + 1 + i) * 512 + c), ub1 = *(const LAS v4u*)(U2 + (2 * wave + 1 + i) * 512 + c + 4);
            const unsigned we[8] = {we0.x, we0.y, we0.z, we0.w, we1.x, we1.y, we1.z, we1.w}, wo[8] = {wo0.x, wo0.y, wo0.z, wo0.w, wo1.x, wo1.y, wo1.z, wo1.w};
            const unsigned ua[8] = {ua0.x, ua0.y, ua0.z, ua0.w, ua1.x, ua1.y, ua1.z, ua1.w}, ub[8] = {ub0.x, ub0.y, ub0.z, ub0.w, ub1.x, ub1.y, ub1.z, ub1.w};
#pragma unroll
            for (int e = 0; e < 8; ++e) { acc[0][e] = dot2bf(ua[e], we[e], acc[0][e]); acc[1][e] = dot2bf(ua[e], wo[e], acc[1][e]); acc[2][e] = dot2bf(ub[e], we[e], acc[2][e]); acc[3][e] = dot2bf(ub[e], wo[e], acc[3][e]); }
        }
#pragma unroll
        for (int tt = 0; tt < 4; ++tt) {
            float s = 0.f;
#pragma unroll
            for (int e = 0; e < 8; ++e) s += acc[tt][e];
            const float mean = wave_sum(s) * (1.f / 512.f); float q = 0.f;
#pragma unroll
            for (int e = 0; e < 8; ++e) { acc[tt][e] -= mean; q += acc[tt][e] * acc[tt][e]; }
            const float rstd = rsqrtf(wave_sum(q) * (1.f / 512.f) + 1e-5f);
            float o[8];
#pragma unroll
            for (int e = 0; e < 8; ++e) { const float un = acc[tt][e] * rstd * lg[e] + lb[e]; o[e] = un * sigm(un); }
            store8bf(RC + (size_t)(t0 + wave * 4 + tt) * 1024 + 512 + c, o);
        }
    }
    __syncthreads();
}
__device__ __forceinline__ void p6_phase(KPtr p, LAS unsigned char* lds, int vcu, int G, int tid, int gw, int NGW, int lane, int rb) {
    const float* YF = (const float*)(p->ws + WS_YF); const float* YB = (const float*)(p->ws + WS_YB);
    const bf16* VN = (const bf16*)((const unsigned char*)p->out + DO_V); const float* DOT = (const float*)((const unsigned char*)p->out + DO_DOT); const bf16* G_ = (const bf16*)((const unsigned char*)p->out + DO_G); bf16* RC = (bf16*)(p->ws + WS_RC);
    const int c = 8 * lane;
    float a[2][8], b[2][8]; v4u vw[2], gq[2]; float dt[2]; int mm[2];
    const unsigned* YFp = (const unsigned*)YF; const unsigned* YBp = (const unsigned*)YB;
#define P6_LOAD(pj_) do { const int j_ = rb >= 0 ? (rb >> 1) + ((pj_) & 7) + 8 * ((pj_) >> 11) : (NGW == 2048) ? (512 * (((pj_) >> 8) & 7) + ((pj_) & 255) + 256 * ((pj_) >> 11)) : (pj_);     \
        { const v4u f0 = *(const v4u*)(YFp + (size_t)j_ * 512 + c), f1 = *(const v4u*)(YFp + (size_t)j_ * 512 + c + 4), b0 = *(const v4u*)(YBp + (size_t)j_ * 512 + c), b1 = *(const v4u*)(YBp + (size_t)j_ * 512 + c + 4); \
          const unsigned fw[8] = {f0.x, f0.y, f0.z, f0.w, f1.x, f1.y, f1.z, f1.w}, bw[8] = {b0.x, b0.y, b0.z, b0.w, b1.x, b1.y, b1.z, b1.w}; \
          _Pragma("unroll") for (int e = 0; e < 8; ++e) { a[0][e] = bflo(fw[e]); a[1][e] = bfhi(fw[e]); b[0][e] = bflo(bw[e]); b[1][e] = bfhi(bw[e]); } } \
        _Pragma("unroll") for (int q = 0; q < 2; ++q) { const int m = 2 * j_ + q; mm[q] = m; \
            vw[q] = *(const v4u*)(VN + (size_t)m * 512 + c); gq[q] = *(const v4u*)(G_ + (size_t)m * 512 + c); \
            dt[q] = DOT[(size_t)m * 8 + (lane >> 3)] + DOT[(size_t)NTOK * 8 + (size_t)m * 8 + (lane >> 3)]; } } while (0)
#define P6_FINISH(mi_) do { float lg[8], lb[8]; load8(p->in[I_LNXG] + c, lg); load8(p->in[I_LNXB] + c, lb); \
        _Pragma("unroll") for (int q = 0; q < 2; ++q) { float s = 0.f; \
            _Pragma("unroll") for (int e = 0; e < 8; ++e) { a[q][e] += b[q][e]; s += a[q][e]; } \
            const float mu = oct_sum(s) * (1.f / 64.f); float qq = 0.f; \
            _Pragma("unroll") for (int e = 0; e < 8; ++e) { a[q][e] -= mu; qq += a[q][e] * a[q][e]; } \
            const float rstd = rsqrtf(oct_sum(qq) * (1.f / 64.f) + 64e-5f); \
            float vv[8], g[8]; unpack8(vw[q], vv); unpack8(gq[q], g); \
            _Pragma("unroll") for (int e = 0; e < 8; ++e) a[q][e] = (a[q][e] * rstd * lg[e] + lb[e] + dt[q] * vv[e]) * g[e]; \
            store8bf(RC + (size_t)mm[q] * 1024 + c, a[q]); } } while (0)
    if (gw < NTOK / 2) P6_LOAD(gw);
    if (rb >= 0) p4_conv_item(p, lds, rb >> 5, tid); else for (int it = vcu; it < NTOK / 32; it += G) p4_conv_item(p, lds, it, tid);
    if (gw < NTOK / 2) P6_FINISH(gw);
    for (int pj = gw + NGW; pj < NTOK / 2; pj += NGW) { P6_LOAD(pj); P6_FINISH(pj); }
#undef P6_LOAD
#undef P6_FINISH
}
__device__ __forceinline__ bf16x8v p2_vfrag(const bf16* vt, int s2, int hf, int d) {
    v4u w;
    if (d == 0) { const v2u lo = *(const v2u*)(vt + 16 * s2 + 4 * hf), hi = *(const v2u*)(vt + 16 * s2 + 8 + 4 * hf); w.x = lo.x; w.y = lo.y; w.z = hi.x; w.w = hi.y; }
    else { const v2u lo = *(const v2u*)(vt + 28 - 16 * s2 - 4 * hf), hi = *(const v2u*)(vt + 20 - 16 * s2 - 4 * hf);
        w.x = __builtin_amdgcn_alignbit(lo.y, lo.y, 16); w.y = __builtin_amdgcn_alignbit(lo.x, lo.x, 16); w.z = __builtin_amdgcn_alignbit(hi.y, hi.y, 16); w.w = __builtin_amdgcn_alignbit(hi.x, hi.x, 16); }
    return __builtin_bit_cast(bf16x8v, w);
}
__device__ __forceinline__ void p5_pass2_wave(KPtr p, int X) {
    int lane; PG8_LANE(lane);
    const int r = lane & 31, hf = lane >> 5;
    const int chain = X >> 1, wq = X & 1;
    int b, h, d, m0, T, tbase; const float* s0 = nullptr; float* sfin = nullptr;
    if (chain < 32) { b = chain >> 4; h = (chain >> 1) & 7; d = chain & 1; m0 = NCTX + b * 2048; T = 2048; tbase = 1024 + (b * 8 + h) * 64; s0 = (d == 0 ? p->in[I_SF] : p->in[I_SB]) + (size_t)(b * 8 + h) * 4096; }
    else { const int cc = chain - 32; b = cc >> 4; h = (cc >> 1) & 7; d = cc & 1; m0 = b * 256; T = 256; tbase = (b * 8 + h) * 8; sfin = p->out + (size_t)NTOK * DM + (size_t)d * 524288 + (size_t)(b * 8 + h) * 4096; }
    const int nc = T / 32, vcol = 32 * wq + r;
    const bf16* VT = (const bf16*)((const unsigned char*)p->out + DO_VT) + (size_t)m0 * 512 + (size_t)h * 64 * T + (size_t)vcol * T;
    unsigned* Y = (unsigned*)(p->ws + (d == 0 ? WS_YF : WS_YB)) + (size_t)(m0 >> 1) * 512 + h * 64 + vcol;
    const float* GC = (const float*)(p->ws + WS_GC);
    f32x16 S0t, S1t;
    if (s0) {
#pragma unroll
        for (int g = 0; g < 4; ++g) { const f32x4 x0 = *(const f32x4*)(s0 + (size_t)vcol * 64 + 8 * g + 4 * hf), x1 = *(const f32x4*)(s0 + (size_t)vcol * 64 + 32 + 8 * g + 4 * hf);
#pragma unroll
            for (int e = 0; e < 4; ++e) { S0t[4 * g + e] = x0[e]; S1t[4 * g + e] = x1[e]; } }
    } else {
#pragma unroll
        for (int e = 0; e < 16; ++e) { S0t[e] = 0.f; S1t[e] = 0.f; }
    }
    bf16x8v fGP[2][4], fKP[2][2], fRP[4], fPP[2], fV[2]; f32x4 gam[2][4];
#define P2_REC(n_) (p->ws + ((((tbase + (n_)) * 2 + d) < 2048) ? WS_RECA + (size_t)((tbase + (n_)) * 2 + d) * REC_BYTES : WS_RECB + (size_t)((tbase + (n_)) * 2 + d - 2048) * REC_BYTES) + lane * 16)
#define P2_LOAD_Y(n_) do { const unsigned char* rb_ = P2_REC(n_); _Pragma("unroll") for (int s4 = 0; s4 < 4; ++s4) fRP[s4] = *(const bf16x8v*)(rb_ + (12 + s4) * 1024); \
        _Pragma("unroll") for (int s2 = 0; s2 < 2; ++s2) fPP[s2] = *(const bf16x8v*)(rb_ + (16 + s2) * 1024); } while (0)
#define P2_LOAD_S(n_) do { const unsigned char* rb_ = P2_REC(n_); const float* gc_ = GC + (size_t)((tbase + (n_)) * 2 + d) * 64 + 4 * hf; \
        _Pragma("unroll") for (int a = 0; a < 2; ++a) { _Pragma("unroll") for (int s4 = 0; s4 < 4; ++s4) fGP[a][s4] = *(const bf16x8v*)(rb_ + (a * 4 + s4) * 1024); \
            _Pragma("unroll") for (int s2 = 0; s2 < 2; ++s2) fKP[a][s2] = *(const bf16x8v*)(rb_ + (8 + a * 2 + s2) * 1024); \
            _Pragma("unroll") for (int g = 0; g < 4; ++g) gam[a][g] = *(const f32x4*)(gc_ + 32 * a + 8 * g); } \
        _Pragma("unroll") for (int s2 = 0; s2 < 2; ++s2) fV[s2] = p2_vfrag(VT + 32 * (n_), s2, hf, d); } while (0)
    { const int n0 = d ? nc - 1 : 0; P2_LOAD_Y(n0); P2_LOAD_S(n0); }
    for (int ci = 0; ci < nc; ++ci) {
        const int n = d ? nc - 1 - ci : ci, nn = d ? n - 1 : n + 1; const bool more = ci + 1 < nc;
        bf16x8v sb[4]; sb[0] = pack_acc(S0t, 0); sb[1] = pack_acc(S0t, 1); sb[2] = pack_acc(S1t, 0); sb[3] = pack_acc(S1t, 1);
        f32x16 y;
#pragma unroll
        for (int e = 0; e < 16; ++e) y[e] = 0.f;
#pragma unroll
        for (int s4 = 0; s4 < 4; ++s4) y = MFMA32(fRP[s4], sb[s4], y);
#pragma unroll
        for (int s2 = 0; s2 < 2; ++s2) y = MFMA32(fPP[s2], fV[s2], y);
        if (more) P2_LOAD_Y(nn);
        { unsigned* yo = Y + (size_t)(16 * n) * 512;
#pragma unroll
            for (int e = 0; e < 16; e += 2) { const int s_ = trow(e, hf); if (d) yo[(size_t)((30 - s_) >> 1) * 512] = pk2(y[e + 1], y[e]); else yo[(size_t)(s_ >> 1) * 512] = pk2(y[e], y[e + 1]); } }
        f32x16 n0t, n1t;
#pragma unroll
        for (int g = 0; g < 4; ++g)
#pragma unroll
            for (int e = 0; e < 4; ++e) { n0t[4 * g + e] = S0t[4 * g + e] * gam[0][g][e]; n1t[4 * g + e] = S1t[4 * g + e] * gam[1][g][e]; }
#pragma unroll
        for (int s4 = 0; s4 < 4; ++s4) { n0t = MFMA32(fGP[0][s4], sb[s4], n0t); n1t = MFMA32(fGP[1][s4], sb[s4], n1t); }
#pragma unroll
        for (int s2 = 0; s2 < 2; ++s2) { n0t = MFMA32(fKP[0][s2], fV[s2], n0t); n1t = MFMA32(fKP[1][s2], fV[s2], n1t); }
        S0t = n0t; S1t = n1t;
        if (more) P2_LOAD_S(nn);
    }
    if (sfin) {
#pragma unroll
        for (int g = 0; g < 4; ++g) { *(f32x4*)(sfin + (size_t)vcol * 64 + 8 * g + 4 * hf) = (f32x4){S0t[4 * g], S0t[4 * g + 1], S0t[4 * g + 2], S0t[4 * g + 3]};
            *(f32x4*)(sfin + (size_t)vcol * 64 + 32 + 8 * g + 4 * hf) = (f32x4){S1t[4 * g], S1t[4 * g + 1], S1t[4 * g + 2], S1t[4 * g + 3]}; }
    }
#undef P2_REC
#undef P2_LOAD_Y
#undef P2_LOAD_S
}

constexpr int P2R_NS = 5, P2R_SLOT = 25600, P2R_GAM = 18432, P2R_V = 19456, P2R_SB = 21504, P2R_FLAGS = P2R_NS * P2R_SLOT, P2R_NH = 6;
__device__ __forceinline__ void p2_chain_decode(int chain, KPtr p, int& b, int& h, int& d, int& m0, int& T, int& tbase) {
    if (chain < 32) { b = chain >> 4; h = (chain >> 1) & 7; d = chain & 1; m0 = NCTX + b * 2048; T = 2048; tbase = 1024 + (b * 8 + h) * 64; }
    else { const int cc = chain - 32; b = cc >> 4; h = (cc >> 1) & 7; d = cc & 1; m0 = b * 256; T = 256; tbase = (b * 8 + h) * 8; }
}
__device__ __forceinline__ void p5_ring_helper(KPtr p, LAS unsigned char* lds, int X, int hidx) {
    int lane; PG8_LANE(lane);
    const int r = lane & 31, hf = lane >> 5, chain = X >> 1, wq = X & 1;
    int b, h, d, m0, T, tbase; p2_chain_decode(chain, p, b, h, d, m0, T, tbase);
    const int nc = T / 32, vcol = 32 * wq + r;
    const bf16* VT = (const bf16*)((const unsigned char*)p->out + DO_VT) + (size_t)m0 * 512 + (size_t)h * 64 * T + (size_t)vcol * T;
    const float* GC = (const float*)(p->ws + WS_GC);
    volatile LAS unsigned* flags = (volatile LAS unsigned*)(lds + P2R_FLAGS);
    for (int m = hidx; m < nc; m += P2R_NH) {
        const int n = d ? nc - 1 - m : m, wt = (tbase + n) * 2 + d, slot = m % P2R_NS;
        const unsigned char* rb = p->ws + (wt < 2048 ? WS_RECA + (size_t)wt * REC_BYTES : WS_RECB + (size_t)(wt - 2048) * REC_BYTES) + lane * 16;
        bf16x8v f[18];
#pragma unroll
        for (int i = 0; i < 18; ++i) f[i] = *(const bf16x8v*)(rb + i * 1024);
        const float gv = GC[(size_t)wt * 64 + lane];
        const bf16x8v v0 = p2_vfrag(VT + 32 * n, 0, hf, d), v1 = p2_vfrag(VT + 32 * n, 1, hf, d);
        while ((int)flags[5] < m - P2R_NS + 1 || (int)flags[13] < m - P2R_NS + 1) __builtin_amdgcn_s_sleep(2);
        LAS unsigned char* sl = lds + slot * P2R_SLOT;
#pragma unroll
        for (int i = 0; i < 18; ++i) *(LAS bf16x8v*)(sl + i * 1024 + lane * 16) = f[i];
        ((LAS float*)(sl + P2R_GAM))[lane] = gv;
        *(LAS bf16x8v*)(sl + P2R_V + lane * 16) = v0; *(LAS bf16x8v*)(sl + P2R_V + 1024 + lane * 16) = v1;
        asm volatile("s_waitcnt lgkmcnt(0)" ::: "memory");
        if (lane == 0) flags[slot] = (unsigned)(m + 1);
    }
}
__device__ __forceinline__ void p5_ring_ywave(KPtr p, LAS unsigned char* lds, int X) {
    int lane; PG8_LANE(lane);
    const int r = lane & 31, hf = lane >> 5, chain = X >> 1, wq = X & 1;
    int b, h, d, m0, T, tbase; p2_chain_decode(chain, p, b, h, d, m0, T, tbase);
    const int nc = T / 32, vcol = 32 * wq + r;
    unsigned* Y = (unsigned*)(p->ws + (d == 0 ? WS_YF : WS_YB)) + (size_t)(m0 >> 1) * 512 + h * 64 + vcol;
    volatile LAS unsigned* flags = (volatile LAS unsigned*)(lds + P2R_FLAGS);
    for (int m = 0; m < nc; ++m) {
        const int n = d ? nc - 1 - m : m, slot = m % P2R_NS;
        while (flags[8 + slot] != (unsigned)(m + 1)) __builtin_amdgcn_s_sleep(1);
        asm volatile("" ::: "memory");
        const LAS unsigned char* sl = lds + slot * P2R_SLOT + lane * 16;
        f32x16 y;
#pragma unroll
        for (int e = 0; e < 16; ++e) y[e] = 0.f;
#pragma unroll
        for (int s4 = 0; s4 < 4; ++s4) y = MFMA32(*(const LAS bf16x8v*)(sl + (12 + s4) * 1024), *(const LAS bf16x8v*)(sl + P2R_SB + s4 * 1024), y);
        y = MFMA32(*(const LAS bf16x8v*)(sl + 16 * 1024), *(const LAS bf16x8v*)(sl + P2R_V), y); y = MFMA32(*(const LAS bf16x8v*)(sl + 17 * 1024), *(const LAS bf16x8v*)(sl + P2R_V + 1024), y);
        asm volatile("s_waitcnt lgkmcnt(0)" ::: "memory");
        if (lane == 0) flags[13] = (unsigned)(m + 1);
        { unsigned* yo = Y + (size_t)(16 * n) * 512;
#pragma unroll
            for (int e = 0; e < 16; e += 2) { const int s_ = trow(e, hf); if (d) yo[(size_t)((30 - s_) >> 1) * 512] = pk2(y[e + 1], y[e]); else yo[(size_t)(s_ >> 1) * 512] = pk2(y[e], y[e + 1]); } }
    }
}
__device__ __forceinline__ void p5_ring_consumer(KPtr p, LAS unsigned char* lds, int X) {
    int lane; PG8_LANE(lane);
    const int r = lane & 31, hf = lane >> 5, chain = X >> 1, wq = X & 1;
    int b, h, d, m0, T, tbase; p2_chain_decode(chain, p, b, h, d, m0, T, tbase);
    const float* s0 = (chain < 32) ? (d == 0 ? p->in[I_SF] : p->in[I_SB]) + (size_t)(b * 8 + h) * 4096 : nullptr;
    float* sfin = (chain < 32) ? nullptr : p->out + (size_t)NTOK * DM + (size_t)d * 524288 + (size_t)(b * 8 + h) * 4096;
    const int nc = T / 32, vcol = 32 * wq + r;
    volatile LAS unsigned* flags = (volatile LAS unsigned*)(lds + P2R_FLAGS);
    f32x16 S0t, S1t;
    if (s0) {
#pragma unroll
        for (int g = 0; g < 4; ++g) { const f32x4 x0 = *(const f32x4*)(s0 + (size_t)vcol * 64 + 8 * g + 4 * hf), x1 = *(const f32x4*)(s0 + (size_t)vcol * 64 + 32 + 8 * g + 4 * hf);
#pragma unroll
            for (int e = 0; e < 4; ++e) { S0t[4 * g + e] = x0[e]; S1t[4 * g + e] = x1[e]; } }
    } else {
#pragma unroll
        for (int e = 0; e < 16; ++e) { S0t[e] = 0.f; S1t[e] = 0.f; }
    }
    bf16x8v gpA[8], kpA[4], v0A, v1A, gpB[8], kpB[4], v0B, v1B;
#if defined(TPROBE) && TPROBE == 103
    unsigned long long wacc_ = 0;
#define C_WAIT(m_) do { const unsigned long long w0_ = __builtin_amdgcn_s_memrealtime(); while (flags[(m_) % P2R_NS] != (unsigned)((m_) + 1)) __builtin_amdgcn_s_sleep(1); asm volatile("" ::: "memory"); wacc_ += __builtin_amdgcn_s_memrealtime() - w0_; } while (0)
#else
#define C_WAIT(m_) do { while (flags[(m_) % P2R_NS] != (unsigned)((m_) + 1)) __builtin_amdgcn_s_sleep(1); asm volatile("" ::: "memory"); } while (0)
#endif
#define C_LOAD(m_, GP_, KP_, V0_, V1_) do { const LAS unsigned char* sl_ = lds + ((m_) % P2R_NS) * P2R_SLOT + lane * 16; \
        _Pragma("unroll") for (int i_ = 0; i_ < 8; ++i_) GP_[i_] = *(const LAS bf16x8v*)(sl_ + i_ * 1024); \
        _Pragma("unroll") for (int i_ = 0; i_ < 4; ++i_) KP_[i_] = *(const LAS bf16x8v*)(sl_ + (8 + i_) * 1024); \
        V0_ = *(const LAS bf16x8v*)(sl_ + P2R_V); V1_ = *(const LAS bf16x8v*)(sl_ + P2R_V + 1024); } while (0)
#define C_STEP(m_, GP_, KP_, V0_, V1_, NGP_, NKP_, NV0_, NV1_) do { const int slot_ = (m_) % P2R_NS; \
          \
        f32x16 u0_, u1_; { f32x16 z_; _Pragma("unroll") for (int e = 0; e < 16; ++e) z_[e] = 0.f; \
            u0_ = MFMA32(KP_[0], V0_, z_); u1_ = MFMA32(KP_[2], V0_, z_); u0_ = MFMA32(KP_[1], V1_, u0_); u1_ = MFMA32(KP_[3], V1_, u1_); } \
        bf16x8v sb_[4]; sb_[0] = pack_acc(S0t, 0); sb_[1] = pack_acc(S0t, 1); sb_[2] = pack_acc(S1t, 0); sb_[3] = pack_acc(S1t, 1); \
        { LAS unsigned char* slw_ = lds + slot_ * P2R_SLOT + P2R_SB + lane * 16; _Pragma("unroll") for (int s4 = 0; s4 < 4; ++s4) *(LAS bf16x8v*)(slw_ + s4 * 1024) = sb_[s4]; } \
        asm volatile("" ::: "memory"); if (lane == 0) flags[8 + slot_] = (unsigned)((m_) + 1); \
        f32x16 n0_, n1_; { const LAS float* gl_ = (const LAS float*)(lds + slot_ * P2R_SLOT + P2R_GAM) + 4 * hf; \
            _Pragma("unroll") for (int g = 0; g < 4; ++g) { const f32x4 g0 = *(const LAS f32x4*)(gl_ + 8 * g), g1 = *(const LAS f32x4*)(gl_ + 32 + 8 * g); \
                _Pragma("unroll") for (int e = 0; e < 4; ++e) { n0_[4 * g + e] = S0t[4 * g + e] * g0[e] + u0_[4 * g + e]; n1_[4 * g + e] = S1t[4 * g + e] * g1[e] + u1_[4 * g + e]; } } } \
        asm volatile("s_waitcnt lgkmcnt(0)" ::: "memory"); if (lane == 0) flags[5] = (unsigned)((m_) + 1);     \
        _Pragma("unroll") for (int s4 = 0; s4 < 4; ++s4) { n0_ = MFMA32(GP_[s4], sb_[s4], n0_); n1_ = MFMA32(GP_[4 + s4], sb_[s4], n1_); } \
        if ((m_) + 1 < nc) { C_WAIT((m_) + 1); C_LOAD((m_) + 1, NGP_, NKP_, NV0_, NV1_); }     \
        S0t = n0_; S1t = n1_; } while (0)
    C_WAIT(0); C_LOAD(0, gpA, kpA, v0A, v1A);
    for (int m = 0; m < nc; m += 2) {
        C_STEP(m, gpA, kpA, v0A, v1A, gpB, kpB, v0B, v1B);
        C_STEP(m + 1, gpB, kpB, v0B, v1B, gpA, kpA, v0A, v1A);
    }
#undef C_WAIT
#undef C_LOAD
#undef C_STEP
#if defined(TPROBE) && TPROBE == 103
    if (X == 0) __hip_atomic_store((unsigned*)(p->ws + WS_CTL) + 8192, (unsigned)wacc_, __ATOMIC_RELAXED, __HIP_MEMORY_SCOPE_AGENT);
#endif
    if (sfin) {
#pragma unroll
        for (int g = 0; g < 4; ++g) { *(f32x4*)(sfin + (size_t)vcol * 64 + 8 * g + 4 * hf) = (f32x4){S0t[4 * g], S0t[4 * g + 1], S0t[4 * g + 2], S0t[4 * g + 3]};
            *(f32x4*)(sfin + (size_t)vcol * 64 + 32 + 8 * g + 4 * hf) = (f32x4){S1t[4 * g], S1t[4 * g + 1], S1t[4 * g + 2], S1t[4 * g + 3]}; }
    }
}
__device__ __forceinline__ void late_convert_item(KPtr p, LAS float* scr, int it, int lane) {
    bf16* W1 = (bf16*)(p->ws + WS_W1); bf16* W2 = (bf16*)(p->ws + WS_W2); bf16* Wo = (bf16*)(p->ws + WS_WO); bf16* Wout = (bf16*)(p->ws + WS_WOUT);
    if (it < 2048) p0_transpose_item(p->in[I_W1], DFF, W1, 1024, 0, scr, it, lane);
    else if (it < 4096) p0_transpose_item(p->in[I_W2], DM, W2, 4096, 0, scr, it - 2048, lane);
    else if (it < 4608) p0_transpose_item(p->in[I_WO], DM, Wo, 1024, 0, scr, it - 4096, lane);
    else if (it < 4864) p0_transpose_item(p->in[I_WOR], DM, Wout, 512, 0, scr, it - 4608, lane);
    else p0_transpose_item(p->in[I_WOC], DM, Wout, 512, 1024, scr, it - 4864, lane);
}
__global__ void __launch_bounds__(NWAVES * 64, 2) fwd_kernel(Params p_unused) {
    extern __shared__ __attribute__((aligned(16))) unsigned char lds_raw[];
    LAS unsigned char* lds = (LAS unsigned char*)lds_raw;
    volatile LAS unsigned* MISC = (volatile LAS unsigned*)(lds + MISC_OFF);
    const int G = gridDim.x; int bx = blockIdx.x, vcu = (G % 8 == 0) ? (bx % 8) * (G / 8) + bx / 8 : bx;
    const int NGW = G * NWAVES;
    const int wave0 = __builtin_amdgcn_readfirstlane(threadIdx.x >> 6);
    for (int u = threadIdx.x; u < (LDS_BYTES - LDSCTL_OFF) / 4; u += NWAVES * 64) ((LAS unsigned*)(lds + LDSCTL_OFF))[u] = 0u;
#define TID_VARS KPtr p = kp0; asm volatile("" : "+s"(p)); unsigned char* ws = p->ws; (void)ws; int lane; PG8_LANE(lane); const int wave = wave0, tid = wave0 * 64 + lane, gw = vcu * NWAVES + wave; (void)tid; (void)gw;
    __syncthreads();
    const KPtr kp0 = (KPtr)__builtin_amdgcn_kernarg_segment_ptr();
    const int lo = kp0->ph_lo, hi = kp0->ph_hi, dupm = kp0->dupmask;
    const bool multi = (hi - lo) > 1;
#ifdef TPROBE
    unsigned long long tA_ = 0, tB_ = 0;
#define TMARK(i) do { if ((i) == TPROBE) tA_ = __builtin_amdgcn_s_memrealtime(); if ((i) == TPROBE + 1) tB_ = __builtin_amdgcn_s_memrealtime(); } while (0)
#define TSUB_BEGIN(id, cond) unsigned long long ts_ = 0; if (TPROBE == (id) && (cond)) ts_ = __builtin_amdgcn_s_memrealtime();
#define TSUB_BEGIN2(id, cond) if (TPROBE == (id) && (cond)) ts_ = __builtin_amdgcn_s_memrealtime();
#define TSUB_END(id, cond) if (TPROBE == (id) && (cond)) { const unsigned dtv_ = (unsigned)(__builtin_amdgcn_s_memrealtime() - ts_); __hip_atomic_store((unsigned*)(kp0->ws + WS_CTL) + 8192, dtv_, __ATOMIC_RELAXED, __HIP_MEMORY_SCOPE_AGENT); }
#define TSUB_END2(id, cond) TSUB_END(id, cond)
#define TMAX_END(id, cond) if (TPROBE == (id) && (cond)) { const unsigned dtv_ = (unsigned)(__builtin_amdgcn_s_memrealtime() - ts_); int l_; PG8_LANE(l_); if (l_ == 0) __hip_atomic_fetch_max((unsigned*)(kp0->ws + WS_CTL) + 8192, dtv_, __ATOMIC_RELAXED, __HIP_MEMORY_SCOPE_AGENT); }
#else
#define TMAX_END(id, cond)
#define TMARK(i) do { } while (0)
#define TSUB_BEGIN(id, cond)
#define TSUB_END(id, cond)
#define TSUB_BEGIN2(id, cond)
#define TSUB_END2(id, cond)
#endif
    TMARK(0);
#if defined(TPROBE) && TPROBE == 122
    if (wave0 == 0) { const unsigned t0_ = (unsigned)__builtin_amdgcn_s_memrealtime(); int l_; PG8_LANE(l_); if (l_ == 0) { __hip_atomic_fetch_max((unsigned*)(kp0->ws + WS_CTL) + 8193, t0_, __ATOMIC_RELAXED, __HIP_MEMORY_SCOPE_AGENT); __hip_atomic_fetch_max((unsigned*)(kp0->ws + WS_CTL) + 8194, ~t0_, __ATOMIC_RELAXED, __HIP_MEMORY_SCOPE_AGENT); } }
#endif
    XcdBarrier bar; bar.bar = (unsigned*)(kp0->ws + WS_CTL) + CW_BAR; bar.x = 0; bar.st = nullptr;
    if (multi) bar = xcd_barrier_post((unsigned*)(kp0->ws + WS_CTL) + CW_BAR, MISC + 8);
#ifndef PHMASK
#define PHMASK 0xffff
#endif
#define IN(k) (((PHMASK >> (k)) & 1) && lo <= (k) && (k) < hi)
#ifndef DUPMASK
#define DUPMASK 0
#endif
#define REP(k) for (int rep_ = 0; rep_ < 1 + ((dupm >> (k)) & 1); ++rep_)
#ifndef BARDUP
#define BARDUP 0
#endif
#define SEAM(k) do { if (IN(k) && IN((k) + 1)) { xcd_barrier(bar, wave0); if (BARDUP) xcd_barrier(bar, wave0); } } while (0)
    if (IN(0)) REP(0) { TID_VARS TSUB_BEGIN(110, vcu == 0 && wave0 == 0) TSUB_BEGIN2(111, vcu == 200 && wave0 == 0) TSUB_BEGIN2(114, vcu == 100 && wave0 == 0) TSUB_BEGIN2(115, vcu == 170 && wave0 == 0) TSUB_BEGIN2(116, vcu == 50 && wave0 == 5) TSUB_BEGIN2(120, true) TSUB_BEGIN2(129, true) p0_prologue(p, lds, vcu, G, tid); TSUB_END(110, vcu == 0 && wave0 == 0) TSUB_END2(111, vcu == 200 && wave0 == 0) TSUB_END2(114, vcu == 100 && wave0 == 0) TSUB_END2(115, vcu == 170 && wave0 == 0) TSUB_END2(116, vcu == 50 && wave0 == 5) TMAX_END(120, true)
#if defined(TPROBE) && TPROBE == 129
        { const unsigned dtv_ = (unsigned)(__builtin_amdgcn_s_memrealtime() - ts_); if (lane == 0) __hip_atomic_fetch_max((unsigned*)(kp0->ws + WS_CTL) + 8196, (dtv_ << 11) | (unsigned)gw, __ATOMIC_RELAXED, __HIP_MEMORY_SCOPE_AGENT); }
#endif
        }
    if (IN(1)) REP(1) { TID_VARS TSUB_BEGIN(113, vcu == 0 && wave0 == 0)
        if (IN(0)) {
            if (tid == 0) { unsigned* cnt = (unsigned*)(ws + WS_CTL) + CW_MODCNT; unsigned sp = 0;
                while (__hip_atomic_load(cnt, __ATOMIC_RELAXED, __HIP_MEMORY_SCOPE_AGENT) < 192u * (1u + ((dupm >> 0) & 1))) { __builtin_amdgcn_s_sleep(2); if (++sp > (1u << 22)) break; }
                __builtin_amdgcn_fence(__ATOMIC_ACQUIRE, "agent"); asm volatile("s_waitcnt vmcnt(0)" ::: "memory"); }
            __syncthreads();
        }
        TSUB_END(113, vcu == 0 && wave0 == 0) TSUB_BEGIN2(112, vcu == 0 && wave0 == 0) TSUB_BEGIN2(121, true)
        p1_norm1(p, gw, NGW, lane); TSUB_END2(112, vcu == 0 && wave0 == 0) TMAX_END(121, true) } SEAM(1); TMARK(1);
    if (IN(2)) REP(2) {
        KPtr p = kp0; asm volatile("" : "+s"(p)); unsigned char* ws = p->ws;
        typedef pg8::Gemm<1024, 1024, 1024, 1 << 20, 0, 1 << 20, 0> GT; GT g{(const bf16*)(ws + WS_XN), (const bf16*)(ws + WS_WIN)};
        pg8::StaticOrder S; S.init(NTOK, N_IN, G, bx);
        EpiG1 E{(bf16*)(ws + WS_RKV), (bf16*)(ws + WS_PB), (bf16*)(ws + WS_A2)};
        pg8::gemm_phase<EpiG1, pg8::StaticOrder, GT, true, true>(lds, g, S, E, wave0);
    } SEAM(2); TMARK(2);
    if (IN(4)) REP(4) { TID_VARS
        TSUB_BEGIN(123, true) TSUB_BEGIN2(124, true) TSUB_BEGIN2(125, true) TSUB_BEGIN2(126, true) TSUB_BEGIN2(127, true) TSUB_BEGIN2(128, true)
        { LAS unsigned char* wl = lds + wave * P1_WAVE_LDS;
            for (int W = vcu * 4 + ((wave + (wave >> 2)) & 3) + (wave >> 2) * (G * 4); W < 4096; W += G * 8) { if (W & 1) p4_pass1<1>(p, wl, W >> 1, gw); else p4_pass1<0>(p, wl, W >> 1, gw); } }
        TMAX_END(123, true) TMAX_END(125, (wave & 1) == 0) TMAX_END(126, (wave & 1) == 1) TMAX_END(127, wave < 4) TMAX_END(128, wave >= 4)
#if defined(TPROBE) && TPROBE == 124
        { const unsigned dtv_ = ~(unsigned)(__builtin_amdgcn_s_memrealtime() - ts_); int l_; PG8_LANE(l_); if (l_ == 0) __hip_atomic_fetch_max((unsigned*)(kp0->ws + WS_CTL) + 8195, dtv_, __ATOMIC_RELAXED, __HIP_MEMORY_SCOPE_AGENT); }
#endif
        __syncthreads();
    } SEAM(4); TMARK(3);
    if (IN(5)) REP(5) { KPtr p = kp0; asm volatile("" : "+s"(p));
        if (G == 256) {
            const int slot5 = vcu & 31, grp5 = vcu >> 5, Xl = (slot5 & 1) + 2 * grp5 + 16 * (slot5 >> 1), vc5 = grp5 * 24 + slot5 - 8;
            if (slot5 < 8) {
                if (wave0 == 0) { int l_; PG8_LANE(l_); if (l_ < 16) ((volatile LAS unsigned*)(lds + P2R_FLAGS))[l_] = 0u; }
                __syncthreads();
                if (wave0 == 0) { TSUB_BEGIN(100, vcu == 0) p5_ring_consumer(p, lds, Xl); TSUB_END(100, vcu == 0) } else if (wave0 == 1) p5_ring_ywave(p, lds, Xl); else p5_ring_helper(p, lds, Xl, wave0 - 2);
                __syncthreads();
            } else {
                if (wave0 < 3) { TSUB_BEGIN(101, vcu == 64 && wave0 == 0) const int Xc = vc5 * 3 + wave0; if (Xc < 512) p5_pass2_wave(p, 64 + Xc); TSUB_END(101, vcu == 64 && wave0 == 0) }
                else { TSUB_BEGIN(102, vcu == 64 && wave0 == 3) int lane; PG8_LANE(lane); LAS float* scr = (LAS float*)(lds + wave0 * 16384);
                    bf16* W1 = (bf16*)(p->ws + WS_W1); bf16* W2 = (bf16*)(p->ws + WS_W2);
                    for (int it = vc5 * 5 + (wave0 - 3); it < 5120; it += 192 * 5) late_convert_item(p, scr, it, lane); TSUB_END(102, vcu == 64 && wave0 == 3) }
            }
        } else {
            for (int X = wave0 * G + vcu; X < 576; X += NWAVES * G) p5_pass2_wave(p, X);
            { int lane; PG8_LANE(lane); LAS float* scr = (LAS float*)(lds + wave0 * 16384); bf16* W1 = (bf16*)(p->ws + WS_W1); bf16* W2 = (bf16*)(p->ws + WS_W2);
              for (int it = vcu * NWAVES + wave0; it < 5120; it += G * NWAVES) late_convert_item(p, scr, it, lane); }
        }
    } SEAM(5); TMARK(4);
    bool locs = false; int grp = 0, rb = -1;
    if (multi && IN(5) && IN(6)) { const unsigned rk_ = __builtin_amdgcn_readfirstlane(MISC[10]), xx_ = __builtin_amdgcn_readfirstlane(MISC[11]), un_ = __builtin_amdgcn_readfirstlane(MISC[12]);
        if (un_ && G == 256) { locs = true; bx = (int)(rk_ * 8u + xx_); vcu = (int)(xx_ * (unsigned)(G / 8) + rk_);
            grp = (int)(xx_ * 4u + (rk_ & 3u)); rb = 256 * grp + 32 * (int)(rk_ >> 2); } }
#define SEAML(k) do { if (IN(k) && IN((k) + 1)) { if (locs) group_barrier_local(bar, grp, wave0); else xcd_barrier(bar, wave0); } } while (0)
    if (IN(6)) REP(6) { TID_VARS p6_phase(p, lds, vcu, G, tid, gw, NGW, lane, rb); } SEAML(6); TMARK(5);
    if (IN(7)) REP(7) {
        KPtr p = kp0; asm volatile("" : "+s"(p)); unsigned char* ws = p->ws;
        typedef pg8::Gemm<1024, 512, 512, 4, 512, 1 << 20, 0> GT; GT g{(const bf16*)(ws + WS_RC), (const bf16*)(ws + WS_WOUT)};
        pg8::StaticOrder S; S.init(NTOK, 2048, G, bx);
        EpiG3 E{(const bf16*)(ws + WS_PB), (bf16*)(ws + WS_GM)};
        pg8::gemm_phase<EpiG3, pg8::StaticOrder, GT, true, true>(lds, g, S, E, wave0);
    } SEAML(7); TMARK(6);
    if (IN(8)) REP(8) {
        KPtr p = kp0; asm volatile("" : "+s"(p)); unsigned char* ws = p->ws;
        typedef pg8::Gemm<2048, 1024, 1024, 4, 1024, 4, 0> GT; GT g{(const bf16*)(ws + WS_GM), (const bf16*)(ws + WS_WO)};
        pg8::StaticOrder S; S.init(NTOK, 2048, G, bx);
        EpiPart E{(bf16*)(ws + WS_PART)};
        pg8::gemm_phase<EpiPart, pg8::StaticOrder, GT, true, true>(lds, g, S, E, wave0);
    } SEAML(8); TMARK(7);
    if (IN(9)) REP(9) { TID_VARS p7_res_norm2(p, gw, NGW, lane, rb); } SEAM(9); TMARK(8);
    if (IN(10)) REP(10) {
        KPtr p = kp0; asm volatile("" : "+s"(p)); unsigned char* ws = p->ws;
        typedef pg8::Gemm<1024, 1024, 1024, 1 << 20, 0, 1 << 20, 0> GT; GT g{(const bf16*)(ws + WS_XN), (const bf16*)(ws + WS_W1)};
        pg8::StaticOrder S; S.init(NTOK, DFF, G, bx);
        EpiG5 E{(bf16*)(ws + WS_H)};
        pg8::gemm_phase<EpiG5, pg8::StaticOrder, GT, true, true>(lds, g, S, E, wave0);
    } SEAML(10); TMARK(9);
    if (IN(11)) REP(11) {
        KPtr p = kp0; asm volatile("" : "+s"(p)); unsigned char* ws = p->ws;
        typedef pg8::Gemm<4096, 4096, 2048, 4, 2048, 4, 2048> GT; GT g{(const bf16*)(ws + WS_H), (const bf16*)(ws + WS_W2)};
        pg8::StaticOrder S; S.init(NTOK, 2048, G, bx);
        EpiPart E{(bf16*)(ws + WS_PART)};
        pg8::gemm_phase<EpiPart, pg8::StaticOrder, GT, true, true>(lds, g, S, E, wave0);
    } SEAML(11); TMARK(10);
    if (IN(12)) REP(12) { TID_VARS p12_final(p, gw, NGW, lane, rb); } TMARK(11);
#ifdef TPROBE
    if (vcu == 0 && wave0 == 0) { const unsigned long long dt_ = (TPROBE == 129 ? (unsigned long long)((__hip_atomic_load((unsigned*)(kp0->ws + WS_CTL) + 8196, __ATOMIC_RELAXED, __HIP_MEMORY_SCOPE_AGENT) & 2047u) * 5u) : TPROBE == 124 ? (unsigned long long)(~__hip_atomic_load((unsigned*)(kp0->ws + WS_CTL) + 8195, __ATOMIC_RELAXED, __HIP_MEMORY_SCOPE_AGENT)) : TPROBE == 122 ? (unsigned long long)(__hip_atomic_load((unsigned*)(kp0->ws + WS_CTL) + 8193, __ATOMIC_RELAXED, __HIP_MEMORY_SCOPE_AGENT) - ~__hip_atomic_load((unsigned*)(kp0->ws + WS_CTL) + 8194, __ATOMIC_RELAXED, __HIP_MEMORY_SCOPE_AGENT)) : TPROBE >= 100 ? (unsigned long long)__hip_atomic_load((unsigned*)(kp0->ws + WS_CTL) + 8192, __ATOMIC_RELAXED, __HIP_MEMORY_SCOPE_AGENT) : (tB_ - tA_)) * TGAIN, te_ = __builtin_amdgcn_s_memrealtime(); while (__builtin_amdgcn_s_memrealtime() - te_ < dt_) { __builtin_amdgcn_s_sleep(8); } }
#endif
#undef IN
#undef SEAM
}

extern "C" void kernel_launch(void* const* d_in, const int* in_sizes, int n_in, void* d_out, int out_size, void* d_ws, size_t ws_size, hipStream_t stream) {
    static int grid = 0;
    if (grid == 0) {
        if (n_in != 36 || ws_size < WS_END) { fprintf(stderr, "kernel_launch: unexpected n_in %d / ws %zu\n", n_in, ws_size); grid = -1; return; }
        int dev = 0, cus = 0, per_cu = 0;
        if (hipGetDevice(&dev) != hipSuccess || hipDeviceGetAttribute(&cus, hipDeviceAttributeMultiprocessorCount, dev) != hipSuccess) { grid = -1; return; }
        if (hipFuncSetAttribute((const void*)fwd_kernel, hipFuncAttributeMaxDynamicSharedMemorySize, LDS_BYTES) != hipSuccess) { fprintf(stderr, "kernel_launch: hipFuncSetAttribute failed\n"); grid = -1; return; }
        if (hipOccupancyMaxActiveBlocksPerMultiprocessor(&per_cu, (const void*)fwd_kernel, NWAVES * 64, LDS_BYTES) != hipSuccess || per_cu < 1)
            fprintf(stderr, "kernel_launch: occupancy query reports %d\n", per_cu);
        (void)hipGetLastError();
        grid = cus;
    }
    if (grid < 0) return;
    if (hipMemsetAsync((char*)d_ws + WS_CTL, 0, CTL_ZERO_BYTES, stream) != hipSuccess) { fprintf(stderr, "kernel_launch: memset failed\n"); return; }
#ifdef EXTRA_MEMSET
    if (hipMemsetAsync((char*)d_ws + WS_CTL + 32768, 0, 64, stream) != hipSuccess) return;
#endif
    Params a{};
    for (int i = 0; i < 36; ++i) a.in[i] = (const float*)d_in[i];
    a.out = (float*)d_out; a.ws = (unsigned char*)d_ws; a.dupmask = DUPMASK;
#if MK_ONE_LAUNCH
    a.ph_lo = 0; a.ph_hi = NPH;
    hipLaunchKernelGGL(fwd_kernel, dim3(grid), dim3(NWAVES * 64), LDS_BYTES, stream, a);
#else
    for (int ph = 0; ph < NPH; ++ph) { a.ph_lo = ph; a.ph_hi = ph + 1; hipLaunchKernelGGL(fwd_kernel, dim3(grid), dim3(NWAVES * 64), LDS_BYTES, stream, a); }
#endif
    const hipError_t le = hipPeekAtLastError();
    if (le != hipSuccess) fprintf(stderr, "kernel_launch: launch failed: %s\n", hipGetErrorName(le));
}
```

```cpp
#include <hip/hip_runtime.h>
#include <cstdio>
#include <cstdint>
namespace pg8 {
#define PG8_LAS __attribute__((address_space(3)))
typedef unsigned short bf16_t;
typedef short bf16x8 __attribute__((ext_vector_type(8)));
typedef float f32x4 __attribute__((ext_vector_type(4)));
typedef unsigned u32x4 __attribute__((ext_vector_type(4)));
constexpr int BM = 256, BK = 64, HALF = 128, HTB = HALF * BK * 2  , STAGE_BYTES = 8 * HTB, NXCD = 8, WGM = 4;

__host__ __device__ __forceinline__ int lds_byte(int r, int c) { const int st = (r >> 4) * 2 + (c >> 5), rr = r & 15, cc = c & 31, ob = rr * 64 + cc * 2; return st * 1024 + (ob ^ (((ob >> 9) & 1) << 5)); }
__host__ __device__ __forceinline__ void stage_rc(int b, int& R, int& C) { const int st = b / 1024, sb = b % 1024, swz = sb ^ (((sb >> 9) & 1) << 5); R = (st >> 1) * 16 + swz / 64; C = (st & 1) * 32 + (swz % 64) / 2; }
__host__ __device__ __forceinline__ int perm32(int rho) { const int n = rho >> 4, i = rho & 15; return 8 * (i >> 2) + 4 * n + (i & 3); }

struct Unit { int pm, pn; };
template <int LDA, int LDB, int KK, int GA, int ACOFF, int GB, int BCOFF>
struct Gemm { const bf16_t* A; const bf16_t* Bt;
    static constexpr int lda = LDA, ldb = LDB, K = KK;
    __device__ __forceinline__ const char* aptr(const Unit& u) const { return (const char*)(A + (size_t)u.pm * BM * LDA + (size_t)(u.pn / GA) * ACOFF); }
    __device__ __forceinline__ const char* bptr(const Unit& u) const { return (const char*)(Bt + (size_t)(u.pn % GB) * BM * LDB + (size_t)(u.pn / GB) * BCOFF); }
};

struct StaticOrder {
    int nM, nN, nwg, G, c;
    __host__ __device__ void init(int M, int N, int G_, int c_) { nM = M / BM; nN = N / BM; nwg = nM * nN; G = G_; c = c_; }
    __host__ __device__ bool next(int i, Unit& u) const {
        const long L = (long)i * G + c; if (L >= nwg) return false;
        int wgid = (int)L; { const int q = nwg / NXCD, r = nwg % NXCD, xcd = wgid % NXCD, off = wgid / NXCD; wgid = (xcd < r ? xcd * (q + 1) : r * (q + 1) + (xcd - r) * q) + off; }
        const int nig = WGM * nN, gid = wgid / nig, fm = gid * WGM, gsz = (nM - fm) < WGM ? (nM - fm) : WGM;
        u.pm = fm + ((wgid % nig) % gsz); u.pn = (wgid % nig) / gsz; return true;
    }
    __device__ __forceinline__ void a_ready(const Unit&) const {}
    __device__ __forceinline__ void done(const Unit&) const {}
};
#define PG8_LANE(x) asm volatile("v_mbcnt_lo_u32_b32 %0, -1, 0\n\tv_mbcnt_hi_u32_b32 %0, -1, %0" : "=v"(x))
typedef __bf16 bf16n2 __attribute__((ext_vector_type(2)));
typedef float f32n2 __attribute__((ext_vector_type(2)));
__device__ __forceinline__ unsigned cvt_pk_bf16(float lo, float hi) { const f32n2 v = {lo, hi}; const bf16n2 b = __builtin_convertvector(v, bf16n2); return __builtin_bit_cast(unsigned, b); }

template <class Epi, class Sched, class GemmT, bool ALIGN_EPI = false, bool SP2 = false>
__device__ __forceinline__ void gemm_phase(PG8_LAS unsigned char* lds, const GemmT g, const Sched& S, const Epi& E, const int wid) {
    int lane; PG8_LANE(lane);
    const int tid = wid * 64 + lane, wr = wid >> 2, wc = wid & 3, fr = lane & 15, fq = lane >> 4;
    const int K = g.K, nt = K / BK;
    unsigned voffA[2], voffB[2];
#pragma unroll
    for (int i = 0; i < 2; ++i) { int R, C; stage_rc(tid * 16 + i * 8192, R, C); const int Rb = Epi::PERM ? ((R & ~31) + perm32(R & 31)) : R;
        voffA[i] = (unsigned)(R * g.lda + C) * 2u; voffB[i] = (unsigned)(Rb * g.ldb + C) * 2u; }
    const size_t kstep = (size_t)(BK * 2);
    const size_t hstepA = (size_t)HALF * g.lda * 2, hstepB = (size_t)HALF * g.ldb * 2;
    const unsigned ldsw = (unsigned)wid * 1024u;
    const int aoff = lds_byte(wr * 64 + fr, fq * 8), boff = lds_byte(wc * 32 + fr, fq * 8);
#define PG8_SA(b, h) (((b) * 2 + (h)) * HTB)
#define PG8_SB(b, h) ((4 + (b) * 2 + (h)) * HTB)
#define PG8_STAGE(bufoff, gbase, voff) do { _Pragma("unroll") for (int _i = 0; _i < 2; ++_i) \
        __builtin_amdgcn_global_load_lds((const unsigned*)((const char*)(gbase) + (voff)[_i]), (PG8_LAS unsigned*)(lds + (bufoff) + ldsw + _i * 8192), 16, 0, 0); } while (0)
#define PG8_LDA(dst, b, h) do { _Pragma("unroll") for (int m = 0; m < 4; ++m) _Pragma("unroll") for (int k = 0; k < 2; ++k) dst[m][k] = *(const PG8_LAS bf16x8*)(lds + PG8_SA(b, h) + aoff + m * 2048 + k * 1024); } while (0)
#define PG8_LDB(dst, b, h) do { _Pragma("unroll") for (int n = 0; n < 2; ++n) _Pragma("unroll") for (int k = 0; k < 2; ++k) dst[n][k] = *(const PG8_LAS bf16x8*)(lds + PG8_SB(b, h) + boff + n * 2048 + k * 1024); } while (0)
#define PG8_MMA(ai, bj, At, Bt) do { __builtin_amdgcn_s_setprio(1); _Pragma("unroll") for (int m = 0; m < 4; ++m) _Pragma("unroll") for (int n = 0; n < 2; ++n) _Pragma("unroll") for (int k = 0; k < 2; ++k) \
        acc[ai][bj][m][n] = __builtin_amdgcn_mfma_f32_16x16x32_bf16(Bt[n][k], At[m][k], acc[ai][bj][m][n], 0, 0, 0); __builtin_amdgcn_s_setprio(0); } while (0)
#define PG8_WAIT_V(n) asm volatile("s_waitcnt vmcnt(" #n ")" ::: "memory")
#define PG8_WAIT_L(n) asm volatile("s_waitcnt lgkmcnt(" #n ")" ::: "memory")
#define PG8_BAR __builtin_amdgcn_s_barrier()
#define PG8_SCHED __builtin_amdgcn_sched_barrier(0)
    Unit cur, nxt; int ui = 0;
    if (!S.next(0, cur)) return;
    f32x4 acc[2][2][4][2];
#pragma unroll
    for (int a = 0; a < 2; ++a)
#pragma unroll
        for (int b = 0; b < 2; ++b)
#pragma unroll
            for (int m = 0; m < 4; ++m)
#pragma unroll
                for (int n = 0; n < 2; ++n) acc[a][b][m][n] = (f32x4){0.f, 0.f, 0.f, 0.f};
    bf16x8 At[4][2], B0[2][2], B1[2][2];
    const char* cA = g.aptr(cur); const char* cB = g.bptr(cur);
    S.a_ready(cur);
    if constexpr (SP2) {
        PG8_STAGE(PG8_SB(0, 0), cB, voffB); PG8_STAGE(PG8_SB(0, 1), cB + hstepB, voffB); PG8_STAGE(PG8_SA(0, 0), cA, voffA); PG8_STAGE(PG8_SA(0, 1), cA + hstepA, voffA);
        if (wr == 1) PG8_BAR;
        PG8_WAIT_V(2); PG8_BAR;
        PG8_STAGE(PG8_SB(1, 0), cB + kstep, voffB); PG8_STAGE(PG8_SA(1, 0), cA + kstep, voffA); PG8_STAGE(PG8_SB(1, 1), cB + hstepB + kstep, voffB);
        PG8_WAIT_V(6); PG8_BAR;
    } else {
        PG8_STAGE(PG8_SB(0, 0), cB, voffB); PG8_STAGE(PG8_SA(0, 0), cA, voffA); PG8_STAGE(PG8_SB(0, 1), cB + hstepB, voffB); PG8_STAGE(PG8_SA(0, 1), cA + hstepA, voffA);
        if (wr == 1) PG8_BAR;
        PG8_WAIT_V(4); PG8_BAR;
        PG8_STAGE(PG8_SB(1, 0), cB + kstep, voffB); PG8_STAGE(PG8_SA(1, 0), cA + kstep, voffA); PG8_STAGE(PG8_SB(1, 1), cB + hstepB + kstep, voffB);
        PG8_WAIT_V(6); PG8_BAR;
    }
    for (;;) {
        const bool has_next = S.next(ui + 1, nxt);
        const char* nA = has_next ? g.aptr(nxt) : cA; const char* nB = has_next ? g.bptr(nxt) : cB;
        for (int t = 0; t < nt; t += 2) {
            const bool last = (t == nt - 2);
            const char* a1 = cA + (size_t)(t + 1) * kstep;
            const char* a2 = last ? nA : cA + (size_t)(t + 2) * kstep; const char* b2 = last ? nB : cB + (size_t)(t + 2) * kstep;
            const char* a3 = a2 + kstep; const char* b3 = b2 + kstep;
            if (last && has_next) S.a_ready(nxt);
            if constexpr (SP2) {
            PG8_LDB(B0, 0, 0); PG8_LDB(B1, 0, 1); PG8_SCHED; PG8_LDA(At, 0, 0); PG8_STAGE(PG8_SA(1, 1), a1 + hstepA, voffA);
            PG8_WAIT_V(8); PG8_WAIT_L(0); PG8_BAR; PG8_MMA(0, 0, At, B0); PG8_MMA(0, 1, At, B1); PG8_BAR; PG8_SCHED;
            PG8_LDA(At, 0, 1); PG8_STAGE(PG8_SB(0, 0), b2, voffB); PG8_STAGE(PG8_SB(0, 1), b2 + hstepB, voffB); PG8_STAGE(PG8_SA(0, 0), a2, voffA);
            PG8_WAIT_V(8); PG8_WAIT_L(0); PG8_BAR; PG8_MMA(1, 0, At, B0); PG8_MMA(1, 1, At, B1); PG8_BAR; PG8_SCHED;
            PG8_LDB(B0, 1, 0); PG8_LDB(B1, 1, 1); PG8_SCHED; PG8_LDA(At, 1, 0); PG8_STAGE(PG8_SA(0, 1), a2 + hstepA, voffA);
            PG8_WAIT_V(8); PG8_WAIT_L(0); PG8_BAR; PG8_MMA(0, 0, At, B0); PG8_MMA(0, 1, At, B1); PG8_BAR; PG8_SCHED;
            PG8_LDA(At, 1, 1); PG8_STAGE(PG8_SB(1, 0), b3, voffB); PG8_STAGE(PG8_SB(1, 1), b3 + hstepB, voffB); PG8_STAGE(PG8_SA(1, 0), a3, voffA);
            PG8_WAIT_V(8); PG8_WAIT_L(0); PG8_BAR; PG8_MMA(1, 0, At, B0); PG8_MMA(1, 1, At, B1); PG8_BAR; PG8_SCHED;
            } else {
            PG8_LDB(B0, 0, 0); PG8_SCHED; PG8_LDA(At, 0, 0); PG8_STAGE(PG8_SA(1, 1), a1 + hstepA, voffA);
            PG8_WAIT_L(8); PG8_BAR; PG8_WAIT_L(0); PG8_MMA(0, 0, At, B0); PG8_BAR; PG8_SCHED;
            PG8_LDB(B1, 0, 1); PG8_STAGE(PG8_SB(0, 0), b2, voffB);
            PG8_BAR; PG8_WAIT_L(0); PG8_MMA(0, 1, At, B1); PG8_BAR;
            PG8_LDA(At, 0, 1); PG8_STAGE(PG8_SA(0, 0), a2, voffA);
            PG8_BAR; PG8_WAIT_L(0); PG8_MMA(1, 0, At, B0); PG8_BAR; PG8_SCHED;
            PG8_STAGE(PG8_SB(0, 1), b2 + hstepB, voffB);
            PG8_WAIT_V(6); PG8_BAR; PG8_MMA(1, 1, At, B1); PG8_BAR;
            PG8_LDB(B0, 1, 0); PG8_SCHED; PG8_LDA(At, 1, 0); PG8_STAGE(PG8_SA(0, 1), a2 + hstepA, voffA);
            PG8_WAIT_L(8); PG8_BAR; PG8_WAIT_L(0); PG8_MMA(0, 0, At, B0); PG8_BAR; PG8_SCHED;
            PG8_LDB(B1, 1, 1); PG8_STAGE(PG8_SB(1, 0), b3, voffB);
            PG8_BAR; PG8_WAIT_L(0); PG8_MMA(0, 1, At, B1); PG8_BAR;
            PG8_LDA(At, 1, 1); PG8_STAGE(PG8_SA(1, 0), a3, voffA);
            PG8_BAR; PG8_WAIT_L(0); PG8_MMA(1, 0, At, B0); PG8_BAR; PG8_SCHED;
            PG8_STAGE(PG8_SB(1, 1), b3 + hstepB, voffB);
            PG8_WAIT_V(6); PG8_BAR; PG8_MMA(1, 1, At, B1); PG8_BAR;
            }
        }
        if constexpr (ALIGN_EPI) { if (wr == 0) PG8_BAR; }
        if constexpr (!Epi::AFTER_DRAIN) { int el; PG8_LANE(el); E(acc, cur, wr, wc, el & 15, el >> 4); S.done(cur); }
        if (!has_next) break;
#pragma unroll
        for (int a = 0; a < 2; ++a)
#pragma unroll
            for (int b = 0; b < 2; ++b)
#pragma unroll
                for (int m = 0; m < 4; ++m)
#pragma unroll
                    for (int n = 0; n < 2; ++n) acc[a][b][m][n] = (f32x4){0.f, 0.f, 0.f, 0.f};
        cur = nxt; cA = nA; cB = nB; ++ui;
        if constexpr (ALIGN_EPI) { if (wr == 1) PG8_BAR; }
    }
    PG8_WAIT_V(0);
    if constexpr (!ALIGN_EPI) { if (wr == 0) PG8_BAR; }
    PG8_BAR;
    if constexpr (Epi::AFTER_DRAIN) { E.fused(acc, cur, wr, wc, fr, fq, lds, wid, lane); S.done(cur); }
#undef PG8_SA
#undef PG8_SB
#undef PG8_STAGE
#undef PG8_LDA
#undef PG8_LDB
#undef PG8_MMA
#undef PG8_WAIT_V
#undef PG8_WAIT_L
#undef PG8_BAR
#undef PG8_SCHED
}
}

constexpr int NWAVES = 8;
constexpr int NTOK = 8192, NCTX = 4096, DM = 1024, RW = 512, NH = 8, HD = 64, DFF = 4096;
constexpr int N_IN = 5888;
constexpr int NPH = 13;
#ifndef MK_ONE_LAUNCH
#define MK_ONE_LAUNCH 1
#endif
constexpr size_t MiB = 1u << 20;
constexpr size_t WS_CTL = 0, CTL_ZERO_BYTES = 64 * 1024;
constexpr size_t WS_MOD = 1 * MiB;
constexpr size_t WS_WIN = 2 * MiB;
constexpr size_t WS_B2 = 14 * MiB;
constexpr size_t WS_WOUT = 16 * MiB;
constexpr size_t WS_WO = 18 * MiB;
constexpr size_t WS_W1 = 20 * MiB;
constexpr size_t WS_W2 = 28 * MiB;
constexpr size_t WS_XN = 36 * MiB;
constexpr size_t WS_A2 = 52 * MiB;
constexpr size_t WS_RKV = 72 * MiB;
constexpr size_t WS_PB = 120 * MiB;
constexpr size_t WS_GATE8 = 136 * MiB;
constexpr size_t WS_WD = 168 * MiB;
constexpr size_t WS_AL = 200 * MiB;
constexpr size_t WS_RECB = 216 * MiB;
constexpr size_t WS_GC = 252 * MiB;
constexpr size_t WS_END = 256 * MiB;
constexpr size_t WS_RECA = 168 * MiB;
constexpr size_t REC_BYTES = 18432;
constexpr size_t WS_YF = WS_RKV, WS_YB = WS_RKV + 16 * MiB, WS_RC = WS_RKV + 32 * MiB;
constexpr size_t WS_GM = 168 * MiB, WS_H = 120 * MiB, WS_X1 = 52 * MiB;
constexpr size_t WS_PARK = 96 * MiB;
constexpr size_t WS_PART = 204 * MiB;
constexpr size_t DO_G = 0, DO_V = 8 * MiB, DO_VT = 16 * MiB, DO_DOT = 24 * MiB;
constexpr int CW_MODCNT = 512;
constexpr int CW_BAR = 1024;
constexpr int RING_BYTES = 131072;
constexpr int LDSCTL_OFF = 162816, MISC_OFF = LDSCTL_OFF + 320;
constexpr int LDS_BYTES = 163840;

#define GAS __attribute__((address_space(1)))
#define LAS __attribute__((address_space(3)))
typedef unsigned short bf16;
typedef unsigned v4u __attribute__((ext_vector_type(4)));
typedef unsigned v2u __attribute__((ext_vector_type(2)));
typedef float f32x4 __attribute__((ext_vector_type(4)));
#define LDS_WAIT() asm volatile("s_waitcnt lgkmcnt(0)" ::: "memory")
#define VM_WAIT() asm volatile("s_waitcnt vmcnt(0)" ::: "memory")
__device__ __forceinline__ unsigned pk2(float lo, float hi) { return pg8::cvt_pk_bf16(lo, hi); }
__device__ __forceinline__ float bflo(unsigned u) { return __uint_as_float(u << 16); }
__device__ __forceinline__ float bfhi(unsigned u) { return __uint_as_float(u & 0xffff0000u); }
__device__ __forceinline__ float bf1(bf16 u) { return __uint_as_float((unsigned)u << 16); }
__device__ __forceinline__ float sigm(float x) { return __builtin_amdgcn_rcpf(1.0f + __expf(-x)); }
__device__ __forceinline__ float tanh_fast(float x) { const float t = __expf(2.0f * x); return 1.0f - 2.0f * __builtin_amdgcn_rcpf(t + 1.0f); }
__device__ __forceinline__ v4u pack8(const f32x4 a, const f32x4 b) { v4u w; w.x = pk2(a[0], a[1]); w.y = pk2(a[2], a[3]); w.z = pk2(b[0], b[1]); w.w = pk2(b[2], b[3]); return w; }
__device__ __forceinline__ void unpack8(const v4u w, float (&o)[8]) { o[0] = bflo(w.x); o[1] = bfhi(w.x); o[2] = bflo(w.y); o[3] = bfhi(w.y); o[4] = bflo(w.z); o[5] = bfhi(w.z); o[6] = bflo(w.w); o[7] = bfhi(w.w); }
__device__ __forceinline__ float wave_sum(float v) {
#pragma unroll
    for (int o = 1; o < 64; o <<= 1) v += __shfl_xor(v, o);
    return v;
}
__device__ __forceinline__ float oct_sum(float v) { v += __shfl_xor(v, 1); v += __shfl_xor(v, 2); v += __shfl_xor(v, 4); return v; }

#define XB_TMO      128
#define XB_XCNT(j)  (256  + 64 * (j))
#define XB_XSUB(j)  (1280 + 64 * (j))
#define XB_XGEN(j)  (2304 + 64 * (j))
#define XB_TOP      3328
#define XB_TOPGEN   3392
#define XCD_BAR_WORDS 3456
#define XB_SPIN_CAP (1u << 18)
__device__ __forceinline__ unsigned xb_ld(unsigned* p)              { return __hip_atomic_load(p, __ATOMIC_RELAXED, __HIP_MEMORY_SCOPE_AGENT); }
__device__ __forceinline__ unsigned xb_add(unsigned* p, unsigned v) { return __hip_atomic_fetch_add(p, v, __ATOMIC_RELAXED, __HIP_MEMORY_SCOPE_AGENT); }
__device__ __forceinline__ unsigned xb_xcc_id() { return (unsigned)__builtin_amdgcn_s_getreg((3 << 11) | 20) & 0xFu; }
#define XB_SPIN(cond, bar) do { unsigned _sp = 0; while (cond) { __builtin_amdgcn_s_sleep(1); \
    if ((++_sp & 255u) == 0u) { if (xb_ld(&(bar)[XB_TMO])) break; if (_sp > XB_SPIN_CAP) { atomicAdd(&(bar)[XB_TMO], 1u); break; } } } } while (0)
struct XcdBarrier { unsigned* bar; unsigned x; volatile LAS unsigned* st; };
__device__ __forceinline__ XcdBarrier xcd_barrier_post(unsigned* bar, volatile LAS unsigned* st) {
    XcdBarrier b; b.bar = bar; b.x = xb_xcc_id(); b.st = st;
    if (threadIdx.x == 0) { const unsigned rank = xb_add(&bar[XB_XCNT(b.x)], 1u); st[2] = rank; st[3] = b.x; }
    return b;
}
__device__ __forceinline__ void xcd_barrier_complete(unsigned* bar, unsigned x, unsigned& nloc, unsigned& nx, unsigned& uni) {
    const unsigned G = gridDim.x * gridDim.y * gridDim.z;
    unsigned sum, cnt, mine, even, sp = 0u;
    for (;;) {
        sum = 0u; cnt = 0u; mine = 0u; even = 1u;
#pragma unroll
        for (unsigned j = 0; j < 16; ++j) { const unsigned c = xb_ld(&bar[XB_XCNT(j)]); sum += c; cnt += (c > 0u) ? 1u : 0u; mine = (j == x) ? c : mine; even &= (c == (j < 8u ? G / 8u : 0u)) ? 1u : 0u; }
        if (sum == G) break;
        __builtin_amdgcn_s_sleep(1);
        if ((++sp & 255u) == 0u) { if (xb_ld(&bar[XB_TMO])) break; if (sp > XB_SPIN_CAP) { atomicAdd(&bar[XB_TMO], 1u); break; } }
    }
    nloc = mine > 0u ? mine : 1u; nx = cnt > 0u ? cnt : 1u;
    uni = (sum == G && (G % 8u) == 0u && even) ? 1u : 0u;
}
__device__ __forceinline__ void xcd_barrier(const XcdBarrier& b, const int wave0) {
    asm volatile("s_waitcnt vmcnt(0)" ::: "memory");
    __syncthreads();
    int l_; PG8_LANE(l_);
    if (wave0 == 0 && l_ == 0) {
        unsigned* bar = b.bar;
        __builtin_amdgcn_s_waitcnt(0);
        unsigned nloc = b.st[0], nx = b.st[1];
        if (nloc == 0u) { unsigned uni; xcd_barrier_complete(bar, b.x, nloc, nx, uni); b.st[0] = nloc; b.st[1] = nx; b.st[4] = uni; }
        const unsigned old = xb_add(&bar[XB_XSUB(b.x)], 1u);
        const unsigned gen = old / nloc;
        if (old + 1u == (gen + 1u) * nloc) {
            __builtin_amdgcn_fence(__ATOMIC_ACQUIRE, "agent");
            __builtin_amdgcn_fence(__ATOMIC_RELEASE, "agent");
            asm volatile("s_waitcnt vmcnt(0)" ::: "memory");
            const unsigned og = xb_add(&bar[XB_TOP], 1u);
            const unsigned tg = og / nx;
            if (og + 1u == (tg + 1u) * nx) xb_add(&bar[XB_TOPGEN], 1u);
            else XB_SPIN(xb_ld(&bar[XB_TOPGEN]) == tg, bar);
            xb_add(&bar[XB_XGEN(b.x)], 1u);
            asm volatile("s_waitcnt vmcnt(0)" ::: "memory");
        } else {
            __builtin_amdgcn_fence(__ATOMIC_ACQUIRE, "agent");
            XB_SPIN(xb_ld(&bar[XB_XGEN(b.x)]) == gen, bar);
            asm volatile("s_waitcnt vmcnt(0)" ::: "memory");
        }
    }
    __syncthreads();
}
__device__ __forceinline__ void xcd_barrier_local(const XcdBarrier& b, const int wave0) {
    asm volatile("s_waitcnt vmcnt(0)" ::: "memory");
    __syncthreads();
    int l_; PG8_LANE(l_);
    if (wave0 == 0 && l_ == 0) {
        unsigned* bar = b.bar;
        __builtin_amdgcn_s_waitcnt(0);
        const unsigned nloc = b.st[0];
        const unsigned old = xb_add(&bar[XB_XSUB(b.x)], 1u);
        const unsigned gen = old / nloc;
        __builtin_amdgcn_fence(__ATOMIC_ACQUIRE, "agent");
        if (old + 1u == (gen + 1u) * nloc) xb_add(&bar[XB_XGEN(b.x)], 1u);
        else XB_SPIN(xb_ld(&bar[XB_XGEN(b.x)]) == gen, bar);
        asm volatile("s_waitcnt vmcnt(0)" ::: "memory");
    }
    __syncthreads();
}

struct Params { const float* in[36]; float* out; unsigned char* ws; int ph_lo, ph_hi, dupmask, pad; };
enum { I_XP = 0, I_XS, I_SF, I_SB, I_C, I_CCTX, I_ADAW, I_ADAB, I_N1G, I_N2G, I_WIN, I_MUP, I_MUN, I_DW0, I_DW1, I_DW2, I_IA0, I_IA1, I_IA2, I_GG1, I_GG2,
       I_KK, I_KA, I_RK, I_LNXG, I_LNXB, I_WOR, I_CW, I_CB, I_CLG, I_CLB, I_WOC, I_WO, I_W1, I_W2, I_FG };

typedef const __attribute__((address_space(4))) Params* KPtr;
__device__ __forceinline__ int cond_of(int m) { return m < NCTX ? 0 : 1 + ((m - NCTX) >> 11); }

struct EpiG1 {
    static constexpr bool PERM = true, AFTER_DRAIN = false;
    bf16* RKV; bf16* PB; bf16* A2; unsigned char* G8;
    __device__ __forceinline__ void operator()(const f32x4 (&acc)[2][2][4][2], const pg8::Unit& u, int wr, int wc, int fr, int fq) const {
        const int row0 = u.pm * 256 + wr * 64 + fr, colt = wc * 32 + 8 * fq;
        if (u.pn < 6) {
#pragma unroll
            for (int ai = 0; ai < 2; ++ai)
#pragma unroll
                for (int m = 0; m < 4; ++m) { bf16* rp = RKV + (size_t)(row0 + ai * 128 + m * 16) * 1536 + u.pn * 256 + colt;
#pragma unroll
                    for (int bj = 0; bj < 2; ++bj) *(v4u*)(rp + bj * 128) = pack8(acc[ai][bj][m][0], acc[ai][bj][m][1]); }
        } else if (u.pn < 10) {
#pragma unroll
            for (int ai = 0; ai < 2; ++ai)
#pragma unroll
                for (int m = 0; m < 4; ++m) { f32x4 a = acc[ai][0][m][0], b = acc[ai][0][m][1]; const f32x4 ga = acc[ai][1][m][0], gb = acc[ai][1][m][1];
#pragma unroll
                    for (int e = 0; e < 4; ++e) { a[e] *= sigm(ga[e]); b[e] *= sigm(gb[e]); }
                    *(v4u*)(PB + (size_t)(row0 + ai * 128 + m * 16) * 512 + (u.pn - 6) * 128 + colt) = pack8(a, b); }
        } else if (u.pn < 18) {
#pragma unroll
            for (int ai = 0; ai < 2; ++ai)
#pragma unroll
                for (int m = 0; m < 4; ++m) { unsigned char* rp = G8 + (size_t)(row0 + ai * 128 + m * 16) * 2048 + (u.pn - 10) * 256 + colt;
#pragma unroll
                    for (int bj = 0; bj < 2; ++bj) { const f32x4 a = acc[ai][bj][m][0], b = acc[ai][bj][m][1]; unsigned w0 = 0u, w1 = 0u;
#pragma unroll
                        for (int e = 0; e < 4; ++e) { w0 = __builtin_amdgcn_cvt_pk_u8_f32(sigm(a[e]) * 255.f, e, w0); w1 = __builtin_amdgcn_cvt_pk_u8_f32(sigm(b[e]) * 255.f, e, w1); }
                        *(v2u*)(rp + bj * 128) = (v2u){w0, w1}; } }
        } else {
            const int l = u.pn - 18;
#pragma unroll
            for (int ai = 0; ai < 2; ++ai)
#pragma unroll
                for (int m = 0; m < 4; ++m) { bf16* rp = A2 + (size_t)(row0 + ai * 128 + m * 16) * 1280 + l * 256 + colt;
#pragma unroll
                    for (int bj = 0; bj < 2; ++bj) { if (bj == 1 || (l >= 1 && wc >= 2)) continue;
                        f32x4 a = acc[ai][bj][m][0], b = acc[ai][bj][m][1];
                        if (l == 0) {
#pragma unroll
                            for (int e = 0; e < 4; ++e) { a[e] = sigm(a[e]); b[e] = sigm(b[e]); }
                        } else if (l <= 2) {
#pragma unroll
                            for (int e = 0; e < 4; ++e) { a[e] = tanh_fast(a[e]); b[e] = tanh_fast(b[e]); }
                        }
                        *(v4u*)(rp + bj * 128) = pack8(a, b); } }
        }
    }
};
struct EpiG2 {
    static constexpr bool PERM = true, AFTER_DRAIN = false;
    bf16* G; float* WD; bf16* AL; const float* w0; const float* a0;
    __device__ __forceinline__ void operator()(const f32x4 (&acc)[2][2][4][2], const pg8::Unit& u, int wr, int wc, int fr, int fq) const {
        const int row0 = u.pm * 256 + wr * 64 + fr, l = u.pn >> 1, cb = (u.pn & 1) * 256 + wc * 32 + 8 * fq;
#pragma unroll
        for (int bj = 0; bj < 2; ++bj) {
            const int c0 = cb + bj * 128;
            f32x4 o0 = (f32x4){0.f, 0.f, 0.f, 0.f}, o1 = o0;
            if (l >= 1 && l <= 2) { o0 = *(const f32x4*)(w0 + (l - 1) * 512 + c0); o1 = *(const f32x4*)(w0 + (l - 1) * 512 + c0 + 4); }
            if (l >= 3) { o0 = *(const f32x4*)(a0 + (l - 3) * 512 + c0); o1 = *(const f32x4*)(a0 + (l - 3) * 512 + c0 + 4); }
#pragma unroll
            for (int ai = 0; ai < 2; ++ai)
#pragma unroll
                for (int m = 0; m < 4; ++m) { const size_t ro = (size_t)(row0 + ai * 128 + m * 16) * 512 + c0;
                    f32x4 a = acc[ai][bj][m][0] + o0, b = acc[ai][bj][m][1] + o1;
                    if (l == 0) { *(v4u*)(G + ro) = pack8(a, b); }
                    else if (l <= 2) {
#pragma unroll
                        for (int e = 0; e < 4; ++e) { a[e] = -0.6065306597126334f * sigm(a[e]); b[e] = -0.6065306597126334f * sigm(b[e]); }
                        float* wp = WD + (size_t)(l - 1) * NTOK * 512 + ro; *(f32x4*)wp = a; *(f32x4*)(wp + 4) = b;
                    } else {
#pragma unroll
                        for (int e = 0; e < 4; ++e) { a[e] = sigm(a[e]); b[e] = sigm(b[e]); }
                        *(v4u*)(AL + (size_t)(l - 3) * NTOK * 512 + ro) = pack8(a, b);
                    } }
        }
    }
};
struct EpiG3 {
    static constexpr bool PERM = true, AFTER_DRAIN = false;
    const unsigned char* G8; bf16* GM;
    __device__ __forceinline__ void operator()(const f32x4 (&acc)[2][2][4][2], const pg8::Unit& u, int wr, int wc, int fr, int fq) const {
        const int row0 = u.pm * 256 + wr * 64 + fr, cb = u.pn * 256 + wc * 32 + 8 * fq;
        v2u gw[2][4][2];
#pragma unroll
        for (int ai = 0; ai < 2; ++ai)
#pragma unroll
            for (int m = 0; m < 4; ++m)
#pragma unroll
                for (int bj = 0; bj < 2; ++bj) gw[ai][m][bj] = *(const v2u*)(G8 + (size_t)(row0 + ai * 128 + m * 16) * 2048 + cb + bj * 128);
        asm volatile("" ::: "memory");
#pragma unroll
        for (int ai = 0; ai < 2; ++ai)
#pragma unroll
            for (int m = 0; m < 4; ++m) { const int row = row0 + ai * 128 + m * 16;
#pragma unroll
                for (int bj = 0; bj < 2; ++bj) { const int c0 = cb + bj * 128;
                    const v2u q8 = gw[ai][m][bj];
                    f32x4 a = acc[ai][bj][m][0], b = acc[ai][bj][m][1];
#pragma unroll
                    for (int e = 0; e < 4; ++e) { a[e] *= (float)((q8.x >> (8 * e)) & 0xffu) * (1.f / 255.f); b[e] *= (float)((q8.y >> (8 * e)) & 0xffu) * (1.f / 255.f); }
                    *(v4u*)(GM + (size_t)row * 2048 + c0) = pack8(a, b); } }
    }
};
struct EpiPart {
    static constexpr bool PERM = true, AFTER_DRAIN = false;
    bf16* PART;
    __device__ __forceinline__ void operator()(const f32x4 (&acc)[2][2][4][2], const pg8::Unit& u, int wr, int wc, int fr, int fq) const {
        const int row0 = u.pm * 256 + wr * 64 + fr, cb = (u.pn & 3) * 256 + wc * 32 + 8 * fq;
        bf16* base = PART + (size_t)(u.pn >> 2) * NTOK * 1024;
#pragma unroll
        for (int ai = 0; ai < 2; ++ai)
#pragma unroll
            for (int m = 0; m < 4; ++m) { bf16* rp = base + (size_t)(row0 + ai * 128 + m * 16) * 1024 + cb;
#pragma unroll
                for (int bj = 0; bj < 2; ++bj) *(v4u*)(rp + bj * 128) = pack8(acc[ai][bj][m][0], acc[ai][bj][m][1]); }
    }
};
struct EpiG5 {
    static constexpr bool PERM = true, AFTER_DRAIN = false;
    bf16* H;
    __device__ __forceinline__ void operator()(const f32x4 (&acc)[2][2][4][2], const pg8::Unit& u, int wr, int wc, int fr, int fq) const {
        const int row0 = u.pm * 256 + wr * 64 + fr, cb = u.pn * 256 + wc * 32 + 8 * fq;
#pragma unroll
        for (int ai = 0; ai < 2; ++ai)
#pragma unroll
            for (int m = 0; m < 4; ++m) { bf16* rp = H + (size_t)(row0 + ai * 128 + m * 16) * DFF + cb;
#pragma unroll
                for (int bj = 0; bj < 2; ++bj) { f32x4 a = acc[ai][bj][m][0], b = acc[ai][bj][m][1];
#pragma unroll
                    for (int e = 0; e < 4; ++e) { const float x = fmaxf(a[e], 0.f), y = fmaxf(b[e], 0.f); a[e] = x * x; b[e] = y * y; }
                    *(v4u*)(rp + bj * 128) = pack8(a, b); } }
    }
};

__device__ __forceinline__ void p0_transpose_item(const float* W, int N, bf16* WT, int ldt, int row_off, LAS float* scr, int item, int lane, bool glu = false) {
    const int nblk = N / 32, kb = item / nblk, nb = item % nblk, k0 = 64 * kb, n0 = 32 * nb;
    int d0 = n0; if (glu && n0 >= 1536 && n0 < 2560) { const int g_ = (n0 >= 2048) ? 1 : 0, idx = n0 - 1536 - 512 * g_; d0 = 1536 + 256 * (idx >> 7) + 128 * g_ + (idx & 127); }
    float tv[32];
#pragma unroll
    for (int i = 0; i < 32; ++i) { const int kk = 2 * i + (lane >> 5); tv[i] = W[(size_t)(k0 + kk) * N + n0 + (lane & 31)]; }
#pragma unroll
    for (int i = 0; i < 32; ++i) { const int kk = 2 * i + (lane >> 5); scr[kk * 33 + (lane & 31)] = tv[i]; }
    LDS_WAIT(); asm volatile("" ::: "memory");
    const int c = lane & 7;
#pragma unroll
    for (int j = 0; j < 4; ++j) { const int n = (lane >> 3) + 8 * j; const LAS float* s = scr + (8 * c) * 33 + n;
        v4u o; o.x = pk2(s[0 * 33], s[1 * 33]); o.y = pk2(s[2 * 33], s[3 * 33]); o.z = pk2(s[4 * 33], s[5 * 33]); o.w = pk2(s[6 * 33], s[7 * 33]);
        *(GAS v4u*)(WT + (size_t)(row_off + d0 + n) * ldt + k0 + 8 * c) = o; }
    LDS_WAIT(); asm volatile("" ::: "memory");
}
__device__ __forceinline__ void p0_mod_item(KPtr p, LAS unsigned char* lds, int item, int tid) {
    const int wave = tid >> 6, lane = tid & 63, kk = lane >> 3, c4 = lane & 7;
    const float* ada_w = p->in[I_ADAW]; const float* cc = p->in[I_C]; const float* cx = p->in[I_CCTX];
    f32x4 a0 = (f32x4){0.f, 0.f, 0.f, 0.f}, a1 = a0, a2 = a0;
#pragma unroll
    for (int i = 0; i < 16; ++i) {
        const int k = wave * 128 + i * 8 + kk;
        const f32x4 w = *(const f32x4*)(ada_w + (size_t)k * 6144 + item * 32 + c4 * 4);
        const float c0 = cx[k], c1 = cc[k], c2 = cc[1024 + k];
        a0 += w * (c0 * sigm(c0)); a1 += w * (c1 * sigm(c1)); a2 += w * (c2 * sigm(c2));
    }
#pragma unroll
    for (int e = 0; e < 4; ++e) {
#pragma unroll
        for (int o = 8; o < 64; o <<= 1) { a0[e] += __shfl_xor(a0[e], o); a1[e] += __shfl_xor(a1[e], o); a2[e] += __shfl_xor(a2[e], o); }
    }
    LAS float* red = (LAS float*)lds;
    if (lane < 8) {
#pragma unroll
        for (int e = 0; e < 4; ++e) { red[(wave * 3 + 0) * 32 + c4 * 4 + e] = a0[e]; red[(wave * 3 + 1) * 32 + c4 * 4 + e] = a1[e]; red[(wave * 3 + 2) * 32 + c4 * 4 + e] = a2[e]; }
    }
    __syncthreads();
    if (tid < 96) { const int j = tid >> 5, c = tid & 31; float s = p->in[I_ADAB][item * 32 + c];
#pragma unroll
        for (int w = 0; w < 8; ++w) s += red[(w * 3 + j) * 32 + c];
        __hip_atomic_store((float*)(p->ws + WS_MOD) + j * 6144 + item * 32 + c, s, __ATOMIC_RELAXED, __HIP_MEMORY_SCOPE_AGENT); }
    asm volatile("s_waitcnt vmcnt(0)" ::: "memory");
    __syncthreads();
    if (tid == 0) {
        __hip_atomic_fetch_add((unsigned*)(p->ws + WS_CTL) + CW_MODCNT, 1u, __ATOMIC_RELAXED, __HIP_MEMORY_SCOPE_AGENT); }
}
__device__ __forceinline__ void p0_prologue(KPtr p, LAS unsigned char* lds, int vcu, int G, int tid) {
    const int wave = __builtin_amdgcn_readfirstlane(tid >> 6), lane = tid & 63;
    for (int it = vcu; it < (G == 256 ? 64 : 192); it += G) p0_mod_item(p, lds, it, tid);
    LAS float* scr = (LAS float*)(lds + wave * 16384);
    const int gw = vcu * NWAVES + wave, NGW = G * NWAVES;
    bf16* Win = (bf16*)(p->ws + WS_WIN); bf16* B2 = (bf16*)(p->ws + WS_B2); bf16* Wout = (bf16*)(p->ws + WS_WOUT);
    bf16* Wo = (bf16*)(p->ws + WS_WO); bf16* W1 = (bf16*)(p->ws + WS_W1); bf16* W2 = (bf16*)(p->ws + WS_W2);
    constexpr int T_WIN = 16 * 144, T_GG1 = 16 * 4, T_L1 = 16 * 2, T_GG2 = 2 * 16, T_L2 = 16, T_WOUT = 8 * 32, T_WO = 16 * 32, T_W1 = 16 * 128, T_W2 = 64 * 32;
    constexpr int NITEMS = T_WIN + T_GG1 + 4 * T_L1 + T_GG2 + 4 * T_L2;
    for (int rnd = 0; ; ++rnd) { int it; if (G == 256) { if (rnd > 1) break; it = (rnd == 0) ? gw : (gw >= 512 ? NGW + gw - 512 : NITEMS); if (it >= NITEMS) continue; } else { it = gw + rnd * NGW; if (it >= NITEMS) break; }
        int r = it;
        if (r < T_WIN) { p0_transpose_item(p->in[I_WIN], 4608, Win, 1024, 0, scr, r, lane, true); continue; } r -= T_WIN;
        if (r < T_GG1) { p0_transpose_item(p->in[I_GG1], 128, Win, 1024, 4608, scr, r, lane); continue; } r -= T_GG1;
        if (r < 4 * T_L1) { const int q = r / T_L1; r -= q * T_L1;
            const float* src = (q < 2 ? p->in[I_DW1] : p->in[I_IA1]) + (size_t)(q & 1) * 1024 * 64;
            p0_transpose_item(src, 64, Win, 1024, 4608 + 256 * (q + 1), scr, r, lane); continue; } r -= 4 * T_L1;
        if (r < T_GG2) { p0_transpose_item(p->in[I_GG2], 512, B2, 256, 0, scr, r, lane); continue; } r -= T_GG2;
        { const int q = r / T_L2; r -= q * T_L2;
            const float* src = (q < 2 ? p->in[I_DW2] : p->in[I_IA2]) + (size_t)(q & 1) * 64 * 512;
            p0_transpose_item(src, 512, B2, 256, 512 * (q + 1), scr, r, lane); }
    }
    const v4u z = (v4u){0u, 0u, 0u, 0u};
    for (int it = gw; it < 5 * 256; it += NGW) { const int l = it >> 8, rr = it & 255; const int real = (l == 0) ? 128 : 64;
        if (rr >= real) { GAS v4u* dst = (GAS v4u*)(Win + (size_t)(4608 + l * 256 + rr) * 1024); dst[lane] = z; dst[64 + lane] = z; } }
    for (int it = gw; it < 2560; it += NGW) { const int real = (it < 512) ? 128 : 64;
        if (lane * 4 >= real) *(GAS v2u*)(B2 + (size_t)it * 256 + lane * 4) = (v2u){0u, 0u}; }
}

__device__ __forceinline__ int row_of(int mi, int NGW) { return (NGW == 2048) ? ((mi & 255) + 1024 * ((mi >> 8) & 7) + 256 * (mi >> 11)) : mi; }
__device__ __forceinline__ void p1_norm1(KPtr p, int gw, int NGW, int lane) {
    const float* MOD = (const float*)(p->ws + WS_MOD); bf16* XN = (bf16*)(p->ws + WS_XN); const float* ng = p->in[I_N1G];
    for (int mi = gw; mi < NTOK; mi += 2 * NGW) {
        f32x4 v[2][4]; float s[2]; int mm[2];
#pragma unroll
        for (int q = 0; q < 2; ++q) { const int mi2 = mi + q * NGW; const int m = row_of(mi2 < NTOK ? mi2 : mi, NGW); mm[q] = m;
            const float* xr = (m < NCTX) ? p->in[I_XP] + (size_t)m * DM : p->in[I_XS] + (size_t)(m - NCTX) * DM;
#pragma unroll
            for (int j = 0; j < 4; ++j) v[q][j] = ((const f32x4*)xr)[lane + 64 * j]; }
#pragma unroll
        for (int q = 0; q < 2; ++q) { float ss = 0.f;
#pragma unroll
            for (int j = 0; j < 4; ++j) ss += (v[q][j][0] * v[q][j][0] + v[q][j][1] * v[q][j][1]) + (v[q][j][2] * v[q][j][2] + v[q][j][3] * v[q][j][3]);
            s[q] = ss; }
#pragma unroll
        for (int q = 0; q < 2; ++q) { const int m = mm[q]; const float* md = MOD + cond_of(m) * 6144;
            const float rstd = rsqrtf(wave_sum(s[q]) * (1.f / DM) + 1e-6f);
            GAS v2u* o8 = (GAS v2u*)(XN + (size_t)m * DM) + lane;
            if (q == 0 || mi + NGW < NTOK) {
#pragma unroll
                for (int j = 0; j < 4; ++j) { const int c = 4 * (lane + 64 * j);
                    const f32x4 g = *(const f32x4*)(ng + c), sh = *(const f32x4*)(md + c), sc = *(const f32x4*)(md + 1024 + c);
                    const f32x4 y = v[q][j] * rstd * g * (sc + 1.0f) + sh;
                    o8[64 * j] = (v2u){pk2(y[0], y[1]), pk2(y[2], y[3])}; } }
        }
    }
}
__device__ __forceinline__ void p7_res_norm2(KPtr p, int gw, int NGW, int lane) {
    const float* MOD = (const float*)(p->ws + WS_MOD); bf16* XN = (bf16*)(p->ws + WS_XN); const float* ng = p->in[I_N2G];
    const bf16* P0 = (const bf16*)(p->ws + WS_PART); const bf16* P1 = P0 + (size_t)NTOK * DM;
    for (int mi = gw; mi < NTOK; mi += 2 * NGW) {
        f32x4 v[2][4]; float s[2]; int mm[2]; const float* mdd[2];
        f32x4 xx[2][4]; v2u aw[2][4], bw[2][4];
#pragma unroll
        for (int q = 0; q < 2; ++q) { const int mi2 = mi + q * NGW; const int m = row_of(mi2 < NTOK ? mi2 : mi, NGW); mm[q] = m;
            const float* xr = (m < NCTX) ? p->in[I_XP] + (size_t)m * DM : p->in[I_XS] + (size_t)(m - NCTX) * DM;
            mdd[q] = MOD + cond_of(m) * 6144;
#pragma unroll
            for (int j = 0; j < 4; ++j) { const int c = 4 * (lane + 64 * j);
                xx[q][j] = *(const f32x4*)(xr + c); aw[q][j] = *(const v2u*)(P0 + (size_t)m * DM + c); bw[q][j] = *(const v2u*)(P1 + (size_t)m * DM + c); } }
#pragma unroll
        for (int q = 0; q < 2; ++q) { const int m = mm[q]; const float* md = mdd[q]; float ss = 0.f;
            GAS v2u* x1o = (GAS v2u*)((bf16*)(p->ws + WS_X1) + (size_t)m * DM) + lane;
#pragma unroll
            for (int j = 0; j < 4; ++j) { const int c = 4 * (lane + 64 * j);
                const f32x4 g1 = *(const f32x4*)(md + 2048 + c);
                const f32x4 a = (f32x4){bflo(aw[q][j].x), bfhi(aw[q][j].x), bflo(aw[q][j].y), bfhi(aw[q][j].y)}, b = (f32x4){bflo(bw[q][j].x), bfhi(bw[q][j].x), bflo(bw[q][j].y), bfhi(bw[q][j].y)};
                const f32x4 t = xx[q][j] + g1 * (a + b);
                const v2u w = (v2u){pk2(t[0], t[1]), pk2(t[2], t[3])};
                if (q == 0 || mi + NGW < NTOK) x1o[64 * j] = w;
                v[q][j] = t;
                ss += (v[q][j][0] * v[q][j][0] + v[q][j][1] * v[q][j][1]) + (v[q][j][2] * v[q][j][2] + v[q][j][3] * v[q][j][3]); }
            s[q] = ss; }
#pragma unroll
        for (int q = 0; q < 2; ++q) { const int m = mm[q]; const float* md = mdd[q];
            const float rstd = rsqrtf(wave_sum(s[q]) * (1.f / DM) + 1e-6f);
            GAS v2u* o8 = (GAS v2u*)(XN + (size_t)m * DM) + lane;
            if (q == 0 || mi + NGW < NTOK) {
#pragma unroll
                for (int j = 0; j < 4; ++j) { const int c = 4 * (lane + 64 * j);
                    const f32x4 g = *(const f32x4*)(ng + c), sh = *(const f32x4*)(md + 3072 + c), sc = *(const f32x4*)(md + 4096 + c);
                    const f32x4 y = v[q][j] * rstd * g * (sc + 1.0f) + sh;
                    o8[64 * j] = (v2u){pk2(y[0], y[1]), pk2(y[2], y[3])}; } }
        }
    }
}
__device__ __forceinline__ void p12_final(KPtr p, int gw, int NGW, int lane) {
    const float* MOD = (const float*)(p->ws + WS_MOD); const float* fg = p->in[I_FG];
    const bf16* P0 = (const bf16*)(p->ws + WS_PART); const bf16* P1 = P0 + (size_t)NTOK * DM;
    for (int mi = gw; mi < NTOK; mi += 2 * NGW) {
        int mm[2]; v2u xw[2][4], aw[2][4], bw[2][4]; f32x4 v[2][4]; float s[2];
#pragma unroll
        for (int q = 0; q < 2; ++q) { const int mi2 = mi + q * NGW; const int m = row_of(mi2 < NTOK ? mi2 : mi, NGW); mm[q] = m;
#pragma unroll
            for (int j = 0; j < 4; ++j) { const int c = 4 * (lane + 64 * j);
                xw[q][j] = *(const v2u*)((const bf16*)(p->ws + WS_X1) + (size_t)m * DM + c); aw[q][j] = *(const v2u*)(P0 + (size_t)m * DM + c); bw[q][j] = *(const v2u*)(P1 + (size_t)m * DM + c); } }
#pragma unroll
        for (int q = 0; q < 2; ++q) { const float* md = MOD + cond_of(mm[q]) * 6144; float ss = 0.f;
#pragma unroll
            for (int j = 0; j < 4; ++j) { const int c = 4 * (lane + 64 * j);
                const f32x4 g2 = *(const f32x4*)(md + 5120 + c);
                const f32x4 x = (f32x4){bflo(xw[q][j].x), bfhi(xw[q][j].x), bflo(xw[q][j].y), bfhi(xw[q][j].y)};
                const f32x4 a = (f32x4){bflo(aw[q][j].x), bfhi(aw[q][j].x), bflo(aw[q][j].y), bfhi(aw[q][j].y)}, b = (f32x4){bflo(bw[q][j].x), bfhi(bw[q][j].x), bflo(bw[q][j].y), bfhi(bw[q][j].y)};
                v[q][j] = x + g2 * (a + b);
                ss += (v[q][j][0] * v[q][j][0] + v[q][j][1] * v[q][j][1]) + (v[q][j][2] * v[q][j][2] + v[q][j][3] * v[q][j][3]); }
            s[q] = ss; }
        asm volatile("" ::: "memory");
#pragma unroll
        for (int q = 0; q < 2; ++q) { const int m = mm[q];
            const float rstd = rsqrtf(wave_sum(s[q]) * (1.f / DM) + 1e-6f);
            if (q == 0 || mi + NGW < NTOK) {
#pragma unroll
                for (int j = 0; j < 4; ++j) { const int c = 4 * (lane + 64 * j);
                    *(f32x4*)(p->out + (size_t)m * DM + c) = v[q][j] * rstd * *(const f32x4*)(fg + c); } }
        }
    }
}
template <typename T> __device__ __forceinline__ const __attribute__((address_space(1))) T* uni_ptr(const T* q) {
    unsigned long long u = (unsigned long long)q;
    unsigned lo = __builtin_amdgcn_readfirstlane((unsigned)u), hi = __builtin_amdgcn_readfirstlane((unsigned)(u >> 32));
    return (const __attribute__((address_space(1))) T*)(((unsigned long long)hi << 32) | lo);
}
__device__ __forceinline__ float ldg16(const __attribute__((address_space(1))) bf16* sb, unsigned bo, int cbytes = 0) {
    return bf1(*(const __attribute__((address_space(1))) bf16*)((const __attribute__((address_space(1))) unsigned char*)sb + bo + cbytes));
}
__device__ __forceinline__ void load8(const float* p, float (&o)[8]) { const f32x4 a = *(const f32x4*)p, b = *(const f32x4*)(p + 4); o[0] = a[0]; o[1] = a[1]; o[2] = a[2]; o[3] = a[3]; o[4] = b[0]; o[5] = b[1]; o[6] = b[2]; o[7] = b[3]; }
__device__ __forceinline__ void store8bf(bf16* p, const float (&v)[8]) { v4u w; w.x = pk2(v[0], v[1]); w.y = pk2(v[2], v[3]); w.z = pk2(v[4], v[5]); w.w = pk2(v[6], v[7]); *(GAS v4u*)p = w; }
typedef short bf16x8v __attribute__((ext_vector_type(8)));
typedef float f32x16 __attribute__((ext_vector_type(16)));
#define MFMA32(a, b, c) __builtin_amdgcn_mfma_f32_32x32x16_bf16(a, b, c, 0, 0, 0)
__device__ __forceinline__ bf16x8v ldfrag(const LAS unsigned char* base, int row_stride, int row, int col) { return *(const LAS bf16x8v*)(base + row * row_stride + col * 2); }
__device__ __forceinline__ int trow(int reg, int half) { return (reg & 3) + 8 * (reg >> 2) + 4 * half; }
__device__ __forceinline__ bf16x8v pack_acc(const f32x16& x, int s) {
    v4u w; w.x = pk2(x[8 * s], x[8 * s + 1]); w.y = pk2(x[8 * s + 2], x[8 * s + 3]); w.z = pk2(x[8 * s + 4], x[8 * s + 5]); w.w = pk2(x[8 * s + 6], x[8 * s + 7]);
    return __builtin_bit_cast(bf16x8v, w);
}
__device__ __forceinline__ int rec_off_s(int fbase, int rr, int cc) { const int s = cc >> 4, o = cc & 15, hh = (o >> 2) & 1, j = 4 * (o >> 3) + (o & 3); return (fbase + s) * 1024 + (32 * hh + rr) * 16 + j * 2; }
__device__ __forceinline__ int rec_off_n(int fbase, int rr, int ii) { const int s = ii >> 4, o = ii & 15, hh = o >> 3, j = o & 7; return (fbase + s) * 1024 + (32 * hh + rr) * 16 + j * 2; }
constexpr int P1_WAVE_LDS = 20352;
constexpr int P1_AT = 0, P1_BT = 4608, P1_RT = 9216, P1_KT = 13824, P1_RN = 18432;
constexpr int P1_L = 4608, P1_NKA = 9216, P1_BTT = 13824, P1_WT = 4608, P1_ZT = 9728, P1_NBR = 0, P1_RED0 = 0;

__device__ __forceinline__ void p4_decode(int task, int& b, int& h, int& n, int& m0, int& T) {
    if (task < 1024) { b = task >> 6; h = (task >> 3) & 7; n = task & 7; m0 = b * 256; T = 256; }
    else { const int t2 = task - 1024; b = t2 >> 9; h = (t2 >> 6) & 7; n = t2 & 63; m0 = NCTX + b * 2048; T = 2048; }
}
#if defined(TPROBE) && TPROBE >= 130 && TPROBE < 150
#define P1TOT (TPROBE == 138 || TPROBE == 139)
#define P1SEC (TPROBE == 138 || TPROBE >= 140)
#define P1K0 (P1TOT ? 0 : (TPROBE >= 140 ? TPROBE - 140 : TPROBE - 130))
#define P1K1 (P1TOT ? 8 : P1K0 + 1)
#define P1MARK(k) do { if (pslot == 0 && (P1SEC ? task >= 1024 : task < 64)) { if ((k) == P1K0) { asm volatile("s_waitcnt vmcnt(0) lgkmcnt(0)" ::: "memory"); tp0_ = __builtin_amdgcn_s_memrealtime(); } if ((k) == P1K1) { asm volatile("s_waitcnt vmcnt(0) lgkmcnt(0)" ::: "memory"); __hip_atomic_store((unsigned*)(p->ws + WS_CTL) + 8192, (unsigned)(__builtin_amdgcn_s_memrealtime() - tp0_), __ATOMIC_RELAXED, __HIP_MEMORY_SCOPE_AGENT); } } } while (0)
#else
#define P1MARK(k) do { } while (0)
#endif
template <int D>
__device__ __forceinline__ void p4_pass1(KPtr p, LAS unsigned char* wl, int task, int pslot) {
    int lane; PG8_LANE(lane);
    int b, h, n, m0, T; p4_decode(task, b, h, n, m0, T);
#if defined(TPROBE) && TPROBE >= 130 && TPROBE < 150
    unsigned long long tp0_ = 0;
#endif
    const bf16* RKV = (const bf16*)(p->ws + WS_RKV);
    const int c = h * 64 + lane, mb = m0 + 32 * n;
    const bool has_prev = n > 0, has_next = (32 * n + 32) < T;
    float kraw[34];
    {   const __attribute__((address_space(1))) bf16* srck = uni_ptr(RKV + ((size_t)mb - 1) * 1536 + 512 + h * 64);
        unsigned eo = (unsigned)lane * 2u;
        kraw[0] = has_prev ? ldg16(srck, eo) : 0.f;
#pragma unroll
        for (int i = 0; i < 32; ++i) { eo += 3072u; asm volatile("" : "+v"(eo)); kraw[i + 1] = ldg16(srck, eo); }
        eo += 3072u; kraw[33] = has_next ? ldg16(srck, eo) : 0.f; }
    P1MARK(0);
    __builtin_amdgcn_sched_barrier(0);
    float lw[32], al[32];
    {   const int fr0 = lane & 31, fh0 = lane >> 5;
        const bf16* A2p = (const bf16*)(p->ws + WS_A2) + (size_t)(mb + fr0) * 1280 + 8 * fh0;
        const bf16* B2p = (const bf16*)(p->ws + WS_B2) + (size_t)(h * 64 + fr0) * 256 + 8 * fh0;
        const float w0c = -1.4426950408889634f * p->in[I_DW0][D * 512 + c], a0c = -1.4426950408889634f * p->in[I_IA0][D * 512 + c];
#pragma unroll
        for (int which = 0; which < (D == 0 ? 3 : 2); ++which) {
            const int l = (which == 0) ? 1 + D : (which == 1) ? 3 + D : 0, nk = (which == 2) ? 8 : 4;
            f32x16 c0, c1;
#pragma unroll
            for (int e = 0; e < 16; ++e) { c0[e] = 0.f; c1[e] = 0.f; }
#pragma unroll
            for (int s4 = 0; s4 < nk; ++s4) { const bf16x8v a = *(const bf16x8v*)(A2p + 256 * l + 16 * s4);
                const bf16x8v b0 = *(const bf16x8v*)(B2p + (size_t)(l * 512) * 256 + 16 * s4), b1 = *(const bf16x8v*)(B2p + (size_t)(l * 512 + 32) * 256 + 16 * s4);
                c0 = MFMA32(a, b0, c0); c1 = MFMA32(a, b1, c1); }
#pragma unroll
            for (int e = 0; e < 16; ++e) {
                const auto sw = __builtin_amdgcn_permlane32_swap(__float_as_uint(c0[e]), __float_as_uint(c1[e]), false, false);
                const float x0 = __uint_as_float(sw[0]), x1 = __uint_as_float(sw[1]);
                const int t0 = trow(e, 0), t1 = trow(e, 1);
                if (which == 0) { lw[t0] = -0.8750387749145276f * __builtin_amdgcn_rcpf(1.0f + __builtin_amdgcn_exp2f(__builtin_fmaf(x0, -1.4426950408889634f, w0c))); lw[t1] = -0.8750387749145276f * __builtin_amdgcn_rcpf(1.0f + __builtin_amdgcn_exp2f(__builtin_fmaf(x1, -1.4426950408889634f, w0c))); }
                else if (which == 1) { al[t0] = __builtin_amdgcn_rcpf(1.0f + __builtin_amdgcn_exp2f(__builtin_fmaf(x0, -1.4426950408889634f, a0c))); al[t1] = __builtin_amdgcn_rcpf(1.0f + __builtin_amdgcn_exp2f(__builtin_fmaf(x1, -1.4426950408889634f, a0c))); }
                else { bf16* Gp = (bf16*)((unsigned char*)p->out + DO_G) + (size_t)mb * 512 + c; Gp[(size_t)t0 * 512] = (bf16)(pk2(x0, 0.f) & 0xffffu); Gp[(size_t)t1 * 512] = (bf16)(pk2(x1, 0.f) & 0xffffu); }
            }
        }
    }
    __builtin_amdgcn_sched_barrier(0);
    P1MARK(1);
    {   const float mp = p->in[I_MUP][512 + c], mn = p->in[I_MUN][512 + c], kkw = p->in[I_KK][c];
        LAS float* red = (LAS float*)(wl + P1_RED0);
        const float wp_ = mp * kkw, wn_ = mn * kkw, wc_ = (1.f - mp - mn) * kkw;
#pragma unroll
        for (int i = 0; i < 32; ++i) { const float u = __builtin_fmaf(kraw[i + 2], wn_, __builtin_fmaf(kraw[i], wp_, kraw[i + 1] * wc_)); red[i * 68 + lane] = u * u; }
        asm volatile("" ::: "memory");
        const int ri = lane & 31, hf = lane >> 5; float ssum = 0.f;
#pragma unroll
        for (int q = 0; q < 8; ++q) { const f32x4 x = *(const LAS f32x4*)(red + ri * 68 + hf * 32 + 4 * q); ssum += (x[0] + x[1]) + (x[2] + x[3]); }
        ssum += __int_as_float(__builtin_amdgcn_ds_bpermute((lane ^ 32) << 2, __float_as_int(ssum)));
        if (lane < 32) ((LAS float*)(wl + P1_RN))[lane] = rsqrtf(fmaxf(ssum, 1e-24f));
    }
    asm volatile("" ::: "memory");
    P1MARK(2);
    float gC;
    {   const float kaw = p->in[I_KA][c], kkw = p->in[I_KK][c];
        const float mpr = p->in[I_MUP][c], mnr = p->in[I_MUN][c], mpk = p->in[I_MUP][512 + c], mnk = p->in[I_MUN][512 + c], mpv = p->in[I_MUP][1024 + c], mnv = p->in[I_MUN][1024 + c];
        const float mcr = 1.f - mpr - mnr, mck = 1.f - mpk - mnk, mcv = 1.f - mpv - mnv, kac = 1.f - kaw;
        LAS bf16* lAT = (LAS bf16*)(wl + P1_AT); LAS bf16* lBT = (LAS bf16*)(wl + P1_BT); LAS bf16* lRT = (LAS bf16*)(wl + P1_RT); LAS bf16* lKT = (LAS bf16*)(wl + P1_KT);
        const LAS float* rnl = (const LAS float*)(wl + P1_RN);
        const int j0 = D ? 31 : 0;
        const __attribute__((address_space(1))) bf16* src = uni_ptr(RKV + ((size_t)mb - 1) * 1536 + h * 64);
        bf16* VN = (bf16*)((unsigned char*)p->out + DO_V) + (size_t)mb * 512 + c;
        bf16* VT = (bf16*)((unsigned char*)p->out + DO_VT) + (size_t)m0 * 512 + (size_t)h * 64 * T + (size_t)lane * T + 32 * n;
        const bool has_behind = D ? has_next : has_prev, has_ahead = D ? has_prev : has_next;
        constexpr int stp = D ? -3072 : 3072;
        unsigned eo = (unsigned)lane * 2u + (unsigned)(j0 + 1) * 3072u;
        float rb = has_behind ? ldg16(src, eo - stp) : 0.f, kb = has_behind ? ldg16(src, eo - stp, 1024) : 0.f, vb = has_behind ? ldg16(src, eo - stp, 2048) : 0.f;
        float rc = ldg16(src, eo), kc = ldg16(src, eo, 1024), vc = ldg16(src, eo, 2048);
        float Lc = 0.f, gprev = 1.f; float vtp[8];
        int vo = 0;
        float nra[8], nka[8], nva[8];
#define P1_LOAD_GROUP(g_) do { _Pragma("unroll") for (int u_ = 0; u_ < 8; ++u_) { const int s_ = 8 * (g_) + u_; \
            eo += stp; asm volatile("" : "+v"(eo)); const bool ha_ = (s_ < 31) || has_ahead; \
            nra[u_] = ha_ ? ldg16(src, eo) : 0.f; nka[u_] = ha_ ? ldg16(src, eo, 1024) : 0.f; nva[u_] = ha_ ? ldg16(src, eo, 2048) : 0.f; } } while (0)
        P1_LOAD_GROUP(0);
#pragma unroll
        for (int g8 = 0; g8 < 4; ++g8) {
            float cra[8], cka[8], cva[8];
#pragma unroll
            for (int u = 0; u < 8; ++u) { cra[u] = nra[u]; cka[u] = nka[u]; cva[u] = nva[u]; }
            if (g8 < 3) P1_LOAD_GROUP(g8 + 1);
            float rn8[8]; { const int gq = D ? 3 - g8 : g8; const f32x4 r0_ = *(const LAS f32x4*)(rnl + 8 * gq), r1_ = *(const LAS f32x4*)(rnl + 8 * gq + 4);
                rn8[0] = r0_[0]; rn8[1] = r0_[1]; rn8[2] = r0_[2]; rn8[3] = r0_[3]; rn8[4] = r1_[0]; rn8[5] = r1_[1]; rn8[6] = r1_[2]; rn8[7] = r1_[3]; }
#pragma unroll
            for (int u = 0; u < 8; ++u) {
                const int s = 8 * g8 + u, j = D ? 31 - s : s;
                const float lwj = lw[j], alj = al[j], ra = cra[u], ka = cka[u], va = cva[u];
                const float rp_ = D ? ra : rb, rn_ = D ? rb : ra, kp_ = D ? ka : kb, kn_ = D ? kb : ka, vp_ = D ? va : vb, vn_ = D ? vb : va;
                const float rj = __builtin_fmaf(rn_, mnr, __builtin_fmaf(rp_, mpr, rc * mcr)), kj = __builtin_fmaf(kn_, mnk, __builtin_fmaf(kp_, mpk, kc * mck)), vj = __builtin_fmaf(vn_, mnv, __builtin_fmaf(vp_, mpv, vc * mcv));
                const float kkj = kj * kkw * rn8[D ? 7 - u : u];
                Lc += lwj;
                const float g = __builtin_amdgcn_exp2f(Lc), gi = __builtin_amdgcn_exp2f(-Lc);
                const float kd = kj * __builtin_fmaf(alj, kaw, kac), bb = kkj * alj;
                const float at = -kkj * gprev;
                const float rt = rj * g, bt = bb * gi, kt = kd * gi;
                lAT[s * 72 + lane] = (bf16)(pk2(at, 0.f) & 0xffffu); lBT[s * 72 + lane] = (bf16)(pk2(bt, 0.f) & 0xffffu);
                lRT[s * 72 + lane] = (bf16)(pk2(rt, 0.f) & 0xffffu); lKT[s * 72 + lane] = (bf16)(pk2(kt, 0.f) & 0xffffu);
                if (D == 0) { VN[vo] = (bf16)(pk2(vj, 0.f) & 0xffffu); vo += 512; asm volatile("" : "+v"(vo)); vtp[u] = vj; }
                gprev = g; rb = rc; kb = kc; vb = vc; rc = ra; kc = ka; vc = va;
            }
            if (D == 0) { v4u w; w.x = pk2(vtp[0], vtp[1]); w.y = pk2(vtp[2], vtp[3]); w.z = pk2(vtp[4], vtp[5]); w.w = pk2(vtp[6], vtp[7]); *(GAS v4u*)(VT + 8 * g8) = w; }
            __builtin_amdgcn_sched_barrier(0);
        }
#undef P1_LOAD_GROUP
        gC = gprev;
    }
    asm volatile("" ::: "memory");
    P1MARK(3);
    {   const int ri = lane & 31, hf = lane >> 5; float ssum = 0.f;
        const float* rkp = p->in[I_RK] + h * 64 + 32 * hf;
#pragma unroll
        for (int q = 0; q < 4; ++q) { float rr[8], kk8[8], w8[8];
            unpack8(*(const LAS v4u*)(wl + P1_RT + ri * 144 + (32 * hf + 8 * q) * 2), rr); unpack8(*(const LAS v4u*)(wl + P1_KT + ri * 144 + (32 * hf + 8 * q) * 2), kk8); load8(rkp + 8 * q, w8);
#pragma unroll
            for (int e = 0; e < 8; ++e) ssum += rr[e] * kk8[e] * w8[e]; }
        ssum += __int_as_float(__builtin_amdgcn_ds_bpermute((lane ^ 32) << 2, __float_as_int(ssum)));
        if (lane < 32) ((float*)((unsigned char*)p->out + DO_DOT))[(size_t)D * NTOK * 8 + (size_t)(mb + (D ? 31 - lane : lane)) * 8 + h] = ssum;
    }
    asm volatile("" ::: "memory");
    P1MARK(4);
    const int fr = lane & 31, fh = lane >> 5;
    f32x16 nab, nka, nbr, nkr;
#pragma unroll
    for (int e = 0; e < 16; ++e) { nab[e] = 0.f; nka[e] = 0.f; nbr[e] = 0.f; nkr[e] = 0.f; }
    { bf16x8v fa[4], fb[4], fR[4], fk[4];
#pragma unroll
        for (int s4 = 0; s4 < 4; ++s4) { fa[s4] = ldfrag(wl + P1_AT, 144, fr, 16 * s4 + 8 * fh); fb[s4] = ldfrag(wl + P1_BT, 144, fr, 16 * s4 + 8 * fh);
            fR[s4] = ldfrag(wl + P1_RT, 144, fr, 16 * s4 + 8 * fh); fk[s4] = ldfrag(wl + P1_KT, 144, fr, 16 * s4 + 8 * fh); }
#pragma unroll
        for (int s4 = 0; s4 < 4; ++s4) { nab = MFMA32(fa[s4], fb[s4], nab); nka = MFMA32(fa[s4], fk[s4], nka); nbr = MFMA32(fR[s4], fb[s4], nbr); nkr = MFMA32(fk[s4], fR[s4], nkr); }
    }
    unsigned nbp[8];
    unsigned* park = (unsigned*)(p->ws + WS_PARK) + (size_t)pslot * 2048 + lane;
    {   unsigned ktp[16], rtp[16]; const LAS bf16* lKT = (const LAS bf16*)(wl + P1_KT); const LAS bf16* lRT = (const LAS bf16*)(wl + P1_RT);
#pragma unroll
        for (int a2 = 0; a2 < 2; ++a2) {
#pragma unroll
            for (int e = 0; e < 16; e += 2) { ktp[a2 * 8 + (e >> 1)] = (unsigned)lKT[trow(e, fh) * 72 + 32 * a2 + fr] | ((unsigned)lKT[trow(e + 1, fh) * 72 + 32 * a2 + fr] << 16);
                rtp[a2 * 8 + (e >> 1)] = (unsigned)lRT[fr * 72 + 32 * a2 + trow(e, fh)] | ((unsigned)lRT[fr * 72 + 32 * a2 + trow(e + 1, fh)] << 16);
                if ((e & 6) == 6) __builtin_amdgcn_sched_barrier(0); } }
#pragma unroll
        for (int i = 0; i < 16; ++i) { __hip_atomic_store(park + i * 64, ktp[i], __ATOMIC_RELAXED, __HIP_MEMORY_SCOPE_AGENT); __hip_atomic_store(park + (16 + i) * 64, rtp[i], __ATOMIC_RELAXED, __HIP_MEMORY_SCOPE_AGENT); }
    }
    asm volatile("" ::: "memory");
    {   const LAS bf16* lBT = (const LAS bf16*)(wl + P1_BT);
        v4u bq[4];
#pragma unroll
        for (int q = 0; q < 4; ++q) { unsigned w[4];
#pragma unroll
            for (int e = 0; e < 4; ++e) w[e] = (unsigned)lBT[(8 * q + 2 * e) * 72 + lane] | ((unsigned)lBT[(8 * q + 2 * e + 1) * 72 + lane] << 16);
            bq[q] = (v4u){w[0], w[1], w[2], w[3]}; __builtin_amdgcn_sched_barrier(0); }
        asm volatile("" ::: "memory");
#pragma unroll
        for (int q = 0; q < 4; ++q) *(LAS v4u*)(wl + P1_BTT + lane * 80 + q * 16) = bq[q];
        __builtin_amdgcn_sched_barrier(0);
    }
    asm volatile("" ::: "memory");
    { LAS float* lL = (LAS float*)(wl + P1_L); LAS float* lN = (LAS float*)(wl + P1_NKA);
#pragma unroll
        for (int e = 0; e < 16; ++e) { const int t = trow(e, fh), i = fr;
            const float vab = (i < t) ? nab[e] : 0.f, vka = (i < t) ? nka[e] : 0.f; nbr[e] = (i <= t) ? nbr[e] : 0.f; nkr[e] = (t <= i) ? nkr[e] : 0.f;
            lL[t * 32 + i] = vab; lN[t * 33 + i] = vka; }
#pragma unroll
        for (int e = 0; e < 16; e += 2) nbp[e >> 1] = pk2(nbr[e], nbr[e + 1]); }
    asm volatile("" ::: "memory");
    P1MARK(5);
    pg8::f32n2 WZ[32];
    { int dep = 0; asm volatile("" : "+v"(dep));
#pragma unroll
        for (int t = 0; t < 32; ++t) {
            if (t >= 2) asm volatile("" : "+v"(dep) : "v"(WZ[t - 2]));
            const LAS float* lL = (const LAS float*)(wl + P1_L) + dep; const LAS float* lN = (const LAS float*)(wl + P1_NKA) + dep; const LAS bf16* lAT = (const LAS bf16*)(wl + P1_AT) + dep;
            pg8::f32n2 a0 = (pg8::f32n2){bf1(lAT[t * 72 + lane]), lN[t * 33 + fr]}, a1 = (pg8::f32n2){0.f, 0.f};
#pragma unroll
            for (int i4 = 0; i4 * 4 < t; ++i4) { const f32x4 l4 = *(const LAS f32x4*)(lL + t * 32 + 4 * i4);
#pragma unroll
                for (int e = 0; e < 4; ++e) { const int i = 4 * i4 + e; if (i < t) { const pg8::f32n2 lv = (pg8::f32n2){l4[e], l4[e]}; if (e & 1) a1 = __builtin_elementwise_fma(lv, WZ[i], a1); else a0 = __builtin_elementwise_fma(lv, WZ[i], a0); } } }
            WZ[t] = a0 + a1;
        } }
    float W[32], Z[32];
#pragma unroll
    for (int t = 0; t < 32; ++t) { W[t] = WZ[t][0]; Z[t] = WZ[t][1]; }
    asm volatile("" ::: "memory");
    P1MARK(6);
    unsigned ktp[16], rtp[16];
#pragma unroll
    for (int i = 0; i < 16; ++i) { ktp[i] = __hip_atomic_load(park + i * 64, __ATOMIC_RELAXED, __HIP_MEMORY_SCOPE_AGENT); rtp[i] = __hip_atomic_load(park + (16 + i) * 64, __ATOMIC_RELAXED, __HIP_MEMORY_SCOPE_AGENT); }
#pragma unroll
    for (int q = 0; q < 4; ++q) { v4u w; w.x = pk2(W[8 * q], W[8 * q + 1]); w.y = pk2(W[8 * q + 2], W[8 * q + 3]); w.z = pk2(W[8 * q + 4], W[8 * q + 5]); w.w = pk2(W[8 * q + 6], W[8 * q + 7]); *(LAS v4u*)(wl + P1_WT + lane * 80 + 16 * q) = w; }
    if (lane < 32) {
#pragma unroll
        for (int q = 0; q < 4; ++q) { v4u w; w.x = pk2(Z[8 * q], Z[8 * q + 1]); w.y = pk2(Z[8 * q + 2], Z[8 * q + 3]); w.z = pk2(Z[8 * q + 4], Z[8 * q + 5]); w.w = pk2(Z[8 * q + 6], Z[8 * q + 7]); *(LAS v4u*)(wl + P1_ZT + lane * 80 + 16 * q) = w; } }
    { LAS bf16* lB = (LAS bf16*)(wl + P1_NBR);
#pragma unroll
        for (int e = 0; e < 16; e += 2) { lB[trow(e, fh) * 40 + fr] = (bf16)(nbp[e >> 1] & 0xffffu); lB[trow(e + 1, fh) * 40 + fr] = (bf16)(nbp[e >> 1] >> 16); } }
    asm volatile("" ::: "memory");
    float gcl2[2];
    { const auto sw = __builtin_amdgcn_permlane32_swap(__float_as_uint(gC), __float_as_uint(gC), false, false); gcl2[0] = __uint_as_float(sw[0]); gcl2[1] = __uint_as_float(sw[1]); }
    P1MARK(7);
    const int wt = task * 2 + D;
    unsigned char* rec = p->ws + (wt < 2048 ? WS_RECA + (size_t)wt * REC_BYTES : WS_RECB + (size_t)(wt - 2048) * REC_BYTES);
    ((float*)(p->ws + WS_GC))[(size_t)wt * 64 + lane] = gC;
    bf16x8v fnb[2], fzt[2];
#pragma unroll
    for (int s2 = 0; s2 < 2; ++s2) { fnb[s2] = ldfrag(wl + P1_NBR, 80, fr, 16 * s2 + 8 * fh); fzt[s2] = ldfrag(wl + P1_ZT, 80, fr, 16 * s2 + 8 * fh); }
    unsigned char* recl = rec + lane * 16;
    __builtin_amdgcn_sched_barrier(0);
    { f32x16 acc = nkr;
#pragma unroll
        for (int s2 = 0; s2 < 2; ++s2) acc = MFMA32(fzt[s2], fnb[s2], acc);
        *(GAS bf16x8v*)(recl + 16 * 1024) = pack_acc(acc, 0); *(GAS bf16x8v*)(recl + 17 * 1024) = pack_acc(acc, 1); }
#pragma unroll
    for (int a2 = 0; a2 < 2; ++a2) {
        __builtin_amdgcn_sched_barrier(0);
        bf16x8v fbt[2];
#pragma unroll
        for (int s2 = 0; s2 < 2; ++s2) fbt[s2] = ldfrag(wl + P1_BTT, 80, 32 * a2 + fr, 16 * s2 + 8 * fh);
        const float gcl = gcl2[a2];
        { f32x16 acc;
#pragma unroll
            for (int e = 0; e < 16; e += 2) { acc[e] = bflo(ktp[a2 * 8 + (e >> 1)]); acc[e + 1] = bfhi(ktp[a2 * 8 + (e >> 1)]); }
#pragma unroll
            for (int s2 = 0; s2 < 2; ++s2) acc = MFMA32(fzt[s2], fbt[s2], acc);
#pragma unroll
            for (int e = 0; e < 16; ++e) acc[e] *= gcl;
            *(GAS bf16x8v*)(recl + (8 + 2 * a2) * 1024) = pack_acc(acc, 0); *(GAS bf16x8v*)(recl + (9 + 2 * a2) * 1024) = pack_acc(acc, 1); }
#pragma unroll
        for (int kt = 0; kt < 2; ++kt) { __builtin_amdgcn_sched_barrier(0); f32x16 acc;
#pragma unroll
            for (int e = 0; e < 16; ++e) acc[e] = 0.f;
#pragma unroll
            for (int s2 = 0; s2 < 2; ++s2) acc = MFMA32(ldfrag(wl + P1_WT, 80, 32 * kt + fr, 16 * s2 + 8 * fh), fbt[s2], acc);
#pragma unroll
            for (int e = 0; e < 16; ++e) acc[e] *= gcl;
            *(GAS bf16x8v*)(recl + (a2 * 4 + 2 * kt) * 1024) = pack_acc(acc, 0); *(GAS bf16x8v*)(recl + (a2 * 4 + 2 * kt + 1) * 1024) = pack_acc(acc, 1); }
    }
#pragma unroll
    for (int kt = 0; kt < 2; ++kt) { __builtin_amdgcn_sched_barrier(0); f32x16 acc;
#pragma unroll
        for (int e = 0; e < 16; e += 2) { acc[e] = bflo(rtp[kt * 8 + (e >> 1)]); acc[e + 1] = bfhi(rtp[kt * 8 + (e >> 1)]); }
#pragma unroll
        for (int s2 = 0; s2 < 2; ++s2) acc = MFMA32(ldfrag(wl + P1_WT, 80, 32 * kt + fr, 16 * s2 + 8 * fh), fnb[s2], acc);
        *(GAS bf16x8v*)(recl + (12 + 2 * kt) * 1024) = pack_acc(acc, 0); *(GAS bf16x8v*)(recl + (13 + 2 * kt) * 1024) = pack_acc(acc, 1); }
    P1MARK(8);
    asm volatile("" ::: "memory");
}
typedef __bf16 bf2v __attribute__((ext_vector_type(2)));
__device__ __forceinline__ float dot2bf(unsigned a, unsigned b, float c) { return __builtin_amdgcn_fdot2_f32_bf16(__builtin_bit_cast(bf2v, a), __builtin_bit_cast(bf2v, b), c, false); }
__device__ __forceinline__ void p4_conv_item(KPtr p, LAS unsigned char* lds, int item, int tid) {
    const int wave = __builtin_amdgcn_readfirstlane(tid >> 6), lane = tid & 63;
    const bf16* PB = (const bf16*)(p->ws + WS_PB); bf16* RC = (bf16*)(p->ws + WS_RC);
    const int t0 = item * 32;
    int lo, hi; if (t0 < NCTX) { lo = t0 & ~255; hi = lo + 256; } else { lo = t0 & ~63; hi = lo + 64; }
    LAS unsigned* U2 = (LAS unsigned*)lds;
    LAS unsigned* CW2 = (LAS unsigned*)(lds + 31 * 2048);
    {
        v2u a0[8], a1[8]; f32x4 wm[4], w0[4], w1[4];
#pragma unroll
        for (int k = 0; k < 8; ++k) { const int e = tid + 512 * k, m = e >> 7, q4 = (e & 127) * 4, tok = t0 - 15 + 2 * m;
            a0[k] = (v2u){0u, 0u}; a1[k] = a0[k];
            if (e < 31 * 128) { if (tok >= lo && tok < hi) a0[k] = *(const v2u*)(PB + (size_t)tok * 512 + q4);
                if (tok + 1 >= lo && tok + 1 < hi) a1[k] = *(const v2u*)(PB + (size_t)(tok + 1) * 512 + q4); } }
#pragma unroll
        for (int k = 0; k < 4; ++k) { const int e = tid + 512 * k, i = e >> 7, q4 = (e & 127) * 4; const float* cw = p->in[I_CW] + q4;
            wm[k] = (i > 0) ? *(const f32x4*)(cw + (2 * i - 1) * 512) : (f32x4){0.f, 0.f, 0.f, 0.f}; w0[k] = *(const f32x4*)(cw + (2 * i) * 512);
            w1[k] = (i < 15) ? *(const f32x4*)(cw + (2 * i + 1) * 512) : (f32x4){0.f, 0.f, 0.f, 0.f}; }
#pragma unroll
        for (int k = 0; k < 8; ++k) { const int e = tid + 512 * k, m = e >> 7, q4 = (e & 127) * 4;
            if (e < 31 * 128) {
                *(LAS v4u*)(U2 + m * 512 + q4) = (v4u){(a0[k].x & 0xffffu) | (a1[k].x << 16), (a0[k].x >> 16) | (a1[k].x & 0xffff0000u), (a0[k].y & 0xffffu) | (a1[k].y << 16), (a0[k].y >> 16) | (a1[k].y & 0xffff0000u)}; } }
#pragma unroll
        for (int k = 0; k < 4; ++k) { const int e = tid + 512 * k, i = e >> 7, q4 = (e & 127) * 4;
            *(LAS v4u*)(CW2 + i * 512 + q4) = (v4u){pk2(w0[k][0], w1[k][0]), pk2(w0[k][1], w1[k][1]), pk2(w0[k][2], w1[k][2]), pk2(w0[k][3], w1[k][3])};
            *(LAS v4u*)(CW2 + (16 + i) * 512 + q4) = (v4u){pk2(wm[k][0], w0[k][0]), pk2(wm[k][1], w0[k][1]), pk2(wm[k][2], w0[k][2]), pk2(wm[k][3], w0[k][3])}; }
    }
    __syncthreads();
    const int c = 8 * lane;
    float cb[8], lg[8], lb[8]; load8(p->in[I_CB] + c, cb); load8(p->in[I_CLG] + c, lg); load8(p->in[I_CLB] + c, lb);
    {
        float acc[4][8];
#pragma unroll
        for (int tt = 0; tt < 4; ++tt)
#pragma unroll
            for (int e = 0; e < 8; ++e) acc[tt][e] = cb[e];
#pragma unroll 2
        for (int i = 0; i < 16; ++i) {
            const v4u we0 = *(const LAS v4u*)(CW2 + i * 512 + c), we1 = *(const LAS v4u*)(CW2 + i * 512 + c + 4), wo0 = *(const LAS v4u*)(CW2 + (16 + i) * 512 + c), wo1 = *(const LAS v4u*)(CW2 + (16 + i) * 512 + c + 4);
            const v4u ua0 = *(const LAS v4u*)(U2 + (2 * wave + i) * 512 + c), ua1 = *(const LAS v4u*)(U2 + (2 * wave + i) * 512 + c + 4), ub0 = *(const LAS v4u*)(U2 + (2 * wave + 1 + i) * 512 + c), ub1 = *(const LAS v4u*)(U2 + (2 * wave + 1 + i) * 512 + c + 4);
            const unsigned we[8] = {we0.x, we0.y, we0.z, we0.w, we1.x, we1.y, we1.z, we1.w}, wo[8] = {wo0.x, wo0.y, wo0.z, wo0.w, wo1.x, wo1.y, wo1.z, wo1.w};
            const unsigned ua[8] = {ua0.x, ua0.y, ua0.z, ua0.w, ua1.x, ua1.y, ua1.z, ua1.w}, ub[8] = {ub0.x, ub0.y, ub0.z, ub0.w, ub1.x, ub1.y, ub1.z, ub1.w};
#pragma unroll
            for (int e = 0; e < 8; ++e) { acc[0][e] = dot2bf(ua[e], we[e], acc[0][e]); acc[1][e] = dot2bf(ua[e], wo[e], acc[1][e]); acc[2][e] = dot2bf(ub[e], we[e], acc[2][e]); acc[3][e] = dot2bf(ub[e], wo[e], acc[3][e]); }
        }
#pragma unroll
        for (int tt = 0; tt < 4; ++tt) {
            float s = 0.f;
#pragma unroll
            for (int e = 0; e < 8; ++e) s += acc[tt][e];
            const float mean = wave_sum(s) * (1.f / 512.f); float q = 0.f;
#pragma unroll
            for (int e = 0; e < 8; ++e) { acc[tt][e] -= mean; q += acc[tt][e] * acc[tt][e]; }
            const float rstd = rsqrtf(wave_sum(q) * (1.f / 512.f) + 1e-5f);
            float o[8];
#pragma unroll
            for (int e = 0; e < 8; ++e) { const float un = acc[tt][e] * rstd * lg[e] + lb[e]; o[e] = un * sigm(un); }
            store8bf(RC + (size_t)(t0 + wave * 4 + tt) * 1024 + 512 + c, o);
        }
    }
    __syncthreads();
}
__device__ __forceinline__ void p6_phase(KPtr p, LAS unsigned char* lds, int vcu, int G, int tid, int gw, int NGW, int lane) {
    const float* YF = (const float*)(p->ws + WS_YF); const float* YB = (const float*)(p->ws + WS_YB);
    const bf16* VN = (const bf16*)((const unsigned char*)p->out + DO_V); const float* DOT = (const float*)((const unsigned char*)p->out + DO_DOT); const bf16* G_ = (const bf16*)((const unsigned char*)p->out + DO_G); bf16* RC = (bf16*)(p->ws + WS_RC);
    const int c = 8 * lane;
    float a[2][8], b[2][8]; v4u vw[2], gq[2]; float dt[2]; int mm[2];
    const unsigned* YFp = (const unsigned*)YF; const unsigned* YBp = (const unsigned*)YB;
#define P6_LOAD(pj_) do { const int j_ = (NGW == 2048) ? (512 * (((pj_) >> 8) & 7) + ((pj_) & 255) + 256 * ((pj_) >> 11)) : (pj_);     \
        { const v4u f0 = *(const v4u*)(YFp + (size_t)j_ * 512 + c), f1 = *(const v4u*)(YFp + (size_t)j_ * 512 + c + 4), b0 = *(const v4u*)(YBp + (size_t)j_ * 512 + c), b1 = *(const v4u*)(YBp + (size_t)j_ * 512 + c + 4); \
          const unsigned fw[8] = {f0.x, f0.y, f0.z, f0.w, f1.x, f1.y, f1.z, f1.w}, bw[8] = {b0.x, b0.y, b0.z, b0.w, b1.x, b1.y, b1.z, b1.w}; \
          _Pragma("unroll") for (int e = 0; e < 8; ++e) { a[0][e] = bflo(fw[e]); a[1][e] = bfhi(fw[e]); b[0][e] = bflo(bw[e]); b[1][e] = bfhi(bw[e]); } } \
        _Pragma("unroll") for (int q = 0; q < 2; ++q) { const int m = 2 * j_ + q; mm[q] = m; \
            vw[q] = *(const v4u*)(VN + (size_t)m * 512 + c); gq[q] = *(const v4u*)(G_ + (size_t)m * 512 + c); \
            dt[q] = DOT[(size_t)m * 8 + (lane >> 3)] + DOT[(size_t)NTOK * 8 + (size_t)m * 8 + (lane >> 3)]; } } while (0)
#define P6_FINISH(mi_) do { float lg[8], lb[8]; load8(p->in[I_LNXG] + c, lg); load8(p->in[I_LNXB] + c, lb); \
        _Pragma("unroll") for (int q = 0; q < 2; ++q) { float s = 0.f; \
            _Pragma("unroll") for (int e = 0; e < 8; ++e) { a[q][e] += b[q][e]; s += a[q][e]; } \
            const float mu = oct_sum(s) * (1.f / 64.f); float qq = 0.f; \
            _Pragma("unroll") for (int e = 0; e < 8; ++e) { a[q][e] -= mu; qq += a[q][e] * a[q][e]; } \
            const float rstd = rsqrtf(oct_sum(qq) * (1.f / 64.f) + 64e-5f); \
            float vv[8], g[8]; unpack8(vw[q], vv); unpack8(gq[q], g); \
            _Pragma("unroll") for (int e = 0; e < 8; ++e) a[q][e] = (a[q][e] * rstd * lg[e] + lb[e] + dt[q] * vv[e]) * g[e]; \
            store8bf(RC + (size_t)mm[q] * 1024 + c, a[q]); } } while (0)
    if (gw < NTOK / 2) P6_LOAD(gw);
    if (G != 256) { for (int it = vcu; it < NTOK / 32; it += G) p4_conv_item(p, lds, it, tid); }
    if (gw < NTOK / 2) P6_FINISH(gw);
    for (int pj = gw + NGW; pj < NTOK / 2; pj += NGW) { P6_LOAD(pj); P6_FINISH(pj); }
#undef P6_LOAD
#undef P6_FINISH
}
__device__ __forceinline__ bf16x8v p2_vfrag(const bf16* vt, int s2, int hf, int d) {
    v4u w;
    if (d == 0) { const v2u lo = *(const v2u*)(vt + 16 * s2 + 4 * hf), hi = *(const v2u*)(vt + 16 * s2 + 8 + 4 * hf); w.x = lo.x; w.y = lo.y; w.z = hi.x; w.w = hi.y; }
    else { const v2u lo = *(const v2u*)(vt + 28 - 16 * s2 - 4 * hf), hi = *(const v2u*)(vt + 20 - 16 * s2 - 4 * hf);
        w.x = __builtin_amdgcn_alignbit(lo.y, lo.y, 16); w.y = __builtin_amdgcn_alignbit(lo.x, lo.x, 16); w.z = __builtin_amdgcn_alignbit(hi.y, hi.y, 16); w.w = __builtin_amdgcn_alignbit(hi.x, hi.x, 16); }
    return __builtin_bit_cast(bf16x8v, w);
}
__device__ __forceinline__ void p5_pass2_wave(KPtr p, int X) {
    int lane; PG8_LANE(lane);
    const int r = lane & 31, hf = lane >> 5;
    const int chain = X >> 1, wq = X & 1;
    int b, h, d, m0, T, tbase; const float* s0 = nullptr; float* sfin = nullptr;
    if (chain < 32) { b = chain >> 4; h = (chain >> 1) & 7; d = chain & 1; m0 = NCTX + b * 2048; T = 2048; tbase = 1024 + (b * 8 + h) * 64; s0 = (d == 0 ? p->in[I_SF] : p->in[I_SB]) + (size_t)(b * 8 + h) * 4096; }
    else { const int cc = chain - 32; b = cc >> 4; h = (cc >> 1) & 7; d = cc & 1; m0 = b * 256; T = 256; tbase = (b * 8 + h) * 8; sfin = p->out + (size_t)NTOK * DM + (size_t)d * 524288 + (size_t)(b * 8 + h) * 4096; }
    const int nc = T / 32, vcol = 32 * wq + r;
    const bf16* VT = (const bf16*)((const unsigned char*)p->out + DO_VT) + (size_t)m0 * 512 + (size_t)h * 64 * T + (size_t)vcol * T;
    unsigned* Y = (unsigned*)(p->ws + (d == 0 ? WS_YF : WS_YB)) + (size_t)(m0 >> 1) * 512 + h * 64 + vcol;
    const float* GC = (const float*)(p->ws + WS_GC);
    f32x16 S0t, S1t;
    if (s0) {
#pragma unroll
        for (int g = 0; g < 4; ++g) { const f32x4 x0 = *(const f32x4*)(s0 + (size_t)vcol * 64 + 8 * g + 4 * hf), x1 = *(const f32x4*)(s0 + (size_t)vcol * 64 + 32 + 8 * g + 4 * hf);
#pragma unroll
            for (int e = 0; e < 4; ++e) { S0t[4 * g + e] = x0[e]; S1t[4 * g + e] = x1[e]; } }
    } else {
#pragma unroll
        for (int e = 0; e < 16; ++e) { S0t[e] = 0.f; S1t[e] = 0.f; }
    }
    bf16x8v fGP[2][4], fKP[2][2], fRP[4], fPP[2], fV[2]; f32x4 gam[2][4];
#define P2_REC(n_) (p->ws + ((((tbase + (n_)) * 2 + d) < 2048) ? WS_RECA + (size_t)((tbase + (n_)) * 2 + d) * REC_BYTES : WS_RECB + (size_t)((tbase + (n_)) * 2 + d - 2048) * REC_BYTES) + lane * 16)
#define P2_LOAD_Y(n_) do { const unsigned char* rb_ = P2_REC(n_); _Pragma("unroll") for (int s4 = 0; s4 < 4; ++s4) fRP[s4] = *(const bf16x8v*)(rb_ + (12 + s4) * 1024); \
        _Pragma("unroll") for (int s2 = 0; s2 < 2; ++s2) fPP[s2] = *(const bf16x8v*)(rb_ + (16 + s2) * 1024); } while (0)
#define P2_LOAD_S(n_) do { const unsigned char* rb_ = P2_REC(n_); const float* gc_ = GC + (size_t)((tbase + (n_)) * 2 + d) * 64 + 4 * hf; \
        _Pragma("unroll") for (int a = 0; a < 2; ++a) { _Pragma("unroll") for (int s4 = 0; s4 < 4; ++s4) fGP[a][s4] = *(const bf16x8v*)(rb_ + (a * 4 + s4) * 1024); \
            _Pragma("unroll") for (int s2 = 0; s2 < 2; ++s2) fKP[a][s2] = *(const bf16x8v*)(rb_ + (8 + a * 2 + s2) * 1024); \
            _Pragma("unroll") for (int g = 0; g < 4; ++g) gam[a][g] = *(const f32x4*)(gc_ + 32 * a + 8 * g); } \
        _Pragma("unroll") for (int s2 = 0; s2 < 2; ++s2) fV[s2] = p2_vfrag(VT + 32 * (n_), s2, hf, d); } while (0)
    { const int n0 = d ? nc - 1 : 0; P2_LOAD_Y(n0); P2_LOAD_S(n0); }
    for (int ci = 0; ci < nc; ++ci) {
        const int n = d ? nc - 1 - ci : ci, nn = d ? n - 1 : n + 1; const bool more = ci + 1 < nc;
        bf16x8v sb[4]; sb[0] = pack_acc(S0t, 0); sb[1] = pack_acc(S0t, 1); sb[2] = pack_acc(S1t, 0); sb[3] = pack_acc(S1t, 1);
        f32x16 y;
#pragma unroll
        for (int e = 0; e < 16; ++e) y[e] = 0.f;
#pragma unroll
        for (int s4 = 0; s4 < 4; ++s4) y = MFMA32(fRP[s4], sb[s4], y);
#pragma unroll
        for (int s2 = 0; s2 < 2; ++s2) y = MFMA32(fPP[s2], fV[s2], y);
        if (more) P2_LOAD_Y(nn);
        { unsigned* yo = Y + (size_t)(16 * n) * 512;
#pragma unroll
            for (int e = 0; e < 16; e += 2) { const int s_ = trow(e, hf); if (d) yo[(size_t)((30 - s_) >> 1) * 512] = pk2(y[e + 1], y[e]); else yo[(size_t)(s_ >> 1) * 512] = pk2(y[e], y[e + 1]); } }
        f32x16 n0t, n1t;
#pragma unroll
        for (int g = 0; g < 4; ++g)
#pragma unroll
            for (int e = 0; e < 4; ++e) { n0t[4 * g + e] = S0t[4 * g + e] * gam[0][g][e]; n1t[4 * g + e] = S1t[4 * g + e] * gam[1][g][e]; }
#pragma unroll
        for (int s4 = 0; s4 < 4; ++s4) { n0t = MFMA32(fGP[0][s4], sb[s4], n0t); n1t = MFMA32(fGP[1][s4], sb[s4], n1t); }
#pragma unroll
        for (int s2 = 0; s2 < 2; ++s2) { n0t = MFMA32(fKP[0][s2], fV[s2], n0t); n1t = MFMA32(fKP[1][s2], fV[s2], n1t); }
        S0t = n0t; S1t = n1t;
        if (more) P2_LOAD_S(nn);
    }
    if (sfin) {
#pragma unroll
        for (int g = 0; g < 4; ++g) { *(f32x4*)(sfin + (size_t)vcol * 64 + 8 * g + 4 * hf) = (f32x4){S0t[4 * g], S0t[4 * g + 1], S0t[4 * g + 2], S0t[4 * g + 3]};
            *(f32x4*)(sfin + (size_t)vcol * 64 + 32 + 8 * g + 4 * hf) = (f32x4){S1t[4 * g], S1t[4 * g + 1], S1t[4 * g + 2], S1t[4 * g + 3]}; }
    }
#undef P2_REC
#undef P2_LOAD_Y
#undef P2_LOAD_S
}

constexpr int P2R_NS = 5, P2R_SLOT = 25600, P2R_GAM = 18432, P2R_V = 19456, P2R_SB = 21504, P2R_FLAGS = P2R_NS * P2R_SLOT, P2R_NH = 6;
__device__ __forceinline__ void p2_chain_decode(int chain, KPtr p, int& b, int& h, int& d, int& m0, int& T, int& tbase) {
    if (chain < 32) { b = chain >> 4; h = (chain >> 1) & 7; d = chain & 1; m0 = NCTX + b * 2048; T = 2048; tbase = 1024 + (b * 8 + h) * 64; }
    else { const int cc = chain - 32; b = cc >> 4; h = (cc >> 1) & 7; d = cc & 1; m0 = b * 256; T = 256; tbase = (b * 8 + h) * 8; }
}
__device__ __forceinline__ void p5_ring_helper(KPtr p, LAS unsigned char* lds, int X, int hidx) {
    int lane; PG8_LANE(lane);
    const int r = lane & 31, hf = lane >> 5, chain = X >> 1, wq = X & 1;
    int b, h, d, m0, T, tbase; p2_chain_decode(chain, p, b, h, d, m0, T, tbase);
    const int nc = T / 32, vcol = 32 * wq + r;
    const bf16* VT = (const bf16*)((const unsigned char*)p->out + DO_VT) + (size_t)m0 * 512 + (size_t)h * 64 * T + (size_t)vcol * T;
    const float* GC = (const float*)(p->ws + WS_GC);
    volatile LAS unsigned* flags = (volatile LAS unsigned*)(lds + P2R_FLAGS);
    for (int m = hidx; m < nc; m += P2R_NH) {
        const int n = d ? nc - 1 - m : m, wt = (tbase + n) * 2 + d, slot = m % P2R_NS;
        const unsigned char* rb = p->ws + (wt < 2048 ? WS_RECA + (size_t)wt * REC_BYTES : WS_RECB + (size_t)(wt - 2048) * REC_BYTES) + lane * 16;
        bf16x8v f[18];
#pragma unroll
        for (int i = 0; i < 18; ++i) f[i] = *(const bf16x8v*)(rb + i * 1024);
        const float gv = GC[(size_t)wt * 64 + lane];
        const bf16x8v v0 = p2_vfrag(VT + 32 * n, 0, hf, d), v1 = p2_vfrag(VT + 32 * n, 1, hf, d);
        while ((int)flags[5] < m - P2R_NS + 1 || (int)flags[13] < m - P2R_NS + 1) __builtin_amdgcn_s_sleep(2);
        LAS unsigned char* sl = lds + slot * P2R_SLOT;
#pragma unroll
        for (int i = 0; i < 18; ++i) *(LAS bf16x8v*)(sl + i * 1024 + lane * 16) = f[i];
        ((LAS float*)(sl + P2R_GAM))[lane] = gv;
        *(LAS bf16x8v*)(sl + P2R_V + lane * 16) = v0; *(LAS bf16x8v*)(sl + P2R_V + 1024 + lane * 16) = v1;
        asm volatile("s_waitcnt lgkmcnt(0)" ::: "memory");
        if (lane == 0) flags[slot] = (unsigned)(m + 1);
    }
}
__device__ __forceinline__ void p5_ring_ywave(KPtr p, LAS unsigned char* lds, int X) {
    int lane; PG8_LANE(lane);
    const int r = lane & 31, hf = lane >> 5, chain = X >> 1, wq = X & 1;
    int b, h, d, m0, T, tbase; p2_chain_decode(chain, p, b, h, d, m0, T, tbase);
    const int nc = T / 32, vcol = 32 * wq + r;
    unsigned* Y = (unsigned*)(p->ws + (d == 0 ? WS_YF : WS_YB)) + (size_t)(m0 >> 1) * 512 + h * 64 + vcol;
    volatile LAS unsigned* flags = (volatile LAS unsigned*)(lds + P2R_FLAGS);
    for (int m = 0; m < nc; ++m) {
        const int n = d ? nc - 1 - m : m, slot = m % P2R_NS;
        while (flags[8 + slot] != (unsigned)(m + 1)) __builtin_amdgcn_s_sleep(1);
        asm volatile("" ::: "memory");
        const LAS unsigned char* sl = lds + slot * P2R_SLOT + lane * 16;
        f32x16 y;
#pragma unroll
        for (int e = 0; e < 16; ++e) y[e] = 0.f;
#pragma unroll
        for (int s4 = 0; s4 < 4; ++s4) y = MFMA32(*(const LAS bf16x8v*)(sl + (12 + s4) * 1024), *(const LAS bf16x8v*)(sl + P2R_SB + s4 * 1024), y);
        y = MFMA32(*(const LAS bf16x8v*)(sl + 16 * 1024), *(const LAS bf16x8v*)(sl + P2R_V), y); y = MFMA32(*(const LAS bf16x8v*)(sl + 17 * 1024), *(const LAS bf16x8v*)(sl + P2R_V + 1024), y);
        asm volatile("s_waitcnt lgkmcnt(0)" ::: "memory");
        if (lane == 0) flags[13] = (unsigned)(m + 1);
        { unsigned* yo = Y + (size_t)(16 * n) * 512;
#pragma unroll
            for (int e = 0; e < 16; e += 2) { const int s_ = trow(e, hf); if (d) yo[(size_t)((30 - s_) >> 1) * 512] = pk2(y[e + 1], y[e]); else yo[(size_t)(s_ >> 1) * 512] = pk2(y[e], y[e + 1]); } }
    }
}
__device__ __forceinline__ void p5_ring_consumer(KPtr p, LAS unsigned char* lds, int X) {
    int lane; PG8_LANE(lane);
    const int r = lane & 31, hf = lane >> 5, chain = X >> 1, wq = X & 1;
    int b, h, d, m0, T, tbase; p2_chain_decode(chain, p, b, h, d, m0, T, tbase);
    const float* s0 = (chain < 32) ? (d == 0 ? p->in[I_SF] : p->in[I_SB]) + (size_t)(b * 8 + h) * 4096 : nullptr;
    float* sfin = (chain < 32) ? nullptr : p->out + (size_t)NTOK * DM + (size_t)d * 524288 + (size_t)(b * 8 + h) * 4096;
    const int nc = T / 32, vcol = 32 * wq + r;
    volatile LAS unsigned* flags = (volatile LAS unsigned*)(lds + P2R_FLAGS);
    f32x16 S0t, S1t;
    if (s0) {
#pragma unroll
        for (int g = 0; g < 4; ++g) { const f32x4 x0 = *(const f32x4*)(s0 + (size_t)vcol * 64 + 8 * g + 4 * hf), x1 = *(const f32x4*)(s0 + (size_t)vcol * 64 + 32 + 8 * g + 4 * hf);
#pragma unroll
            for (int e = 0; e < 4; ++e) { S0t[4 * g + e] = x0[e]; S1t[4 * g + e] = x1[e]; } }
    } else {
#pragma unroll
        for (int e = 0; e < 16; ++e) { S0t[e] = 0.f; S1t[e] = 0.f; }
    }
    bf16x8v gpA[8], kpA[4], v0A, v1A, gpB[8], kpB[4], v0B, v1B;
#if defined(TPROBE) && TPROBE == 103
    unsigned long long wacc_ = 0;
#define C_WAIT(m_) do { const unsigned long long w0_ = __builtin_amdgcn_s_memrealtime(); while (flags[(m_) % P2R_NS] != (unsigned)((m_) + 1)) __builtin_amdgcn_s_sleep(1); asm volatile("" ::: "memory"); wacc_ += __builtin_amdgcn_s_memrealtime() - w0_; } while (0)
#else
#define C_WAIT(m_) do { while (flags[(m_) % P2R_NS] != (unsigned)((m_) + 1)) __builtin_amdgcn_s_sleep(1); asm volatile("" ::: "memory"); } while (0)
#endif
#define C_LOAD(m_, GP_, KP_, V0_, V1_) do { const LAS unsigned char* sl_ = lds + ((m_) % P2R_NS) * P2R_SLOT + lane * 16; \
        _Pragma("unroll") for (int i_ = 0; i_ < 8; ++i_) GP_[i_] = *(const LAS bf16x8v*)(sl_ + i_ * 1024); \
        _Pragma("unroll") for (int i_ = 0; i_ < 4; ++i_) KP_[i_] = *(const LAS bf16x8v*)(sl_ + (8 + i_) * 1024); \
        V0_ = *(const LAS bf16x8v*)(sl_ + P2R_V); V1_ = *(const LAS bf16x8v*)(sl_ + P2R_V + 1024); } while (0)
#define C_STEP(m_, GP_, KP_, V0_, V1_, NGP_, NKP_, NV0_, NV1_) do { const int slot_ = (m_) % P2R_NS; \
          \
        f32x16 u0_, u1_; { f32x16 z_; _Pragma("unroll") for (int e = 0; e < 16; ++e) z_[e] = 0.f; \
            u0_ = MFMA32(KP_[0], V0_, z_); u1_ = MFMA32(KP_[2], V0_, z_); u0_ = MFMA32(KP_[1], V1_, u0_); u1_ = MFMA32(KP_[3], V1_, u1_); } \
        bf16x8v sb_[4]; sb_[0] = pack_acc(S0t, 0); sb_[1] = pack_acc(S0t, 1); sb_[2] = pack_acc(S1t, 0); sb_[3] = pack_acc(S1t, 1); \
        { LAS unsigned char* slw_ = lds + slot_ * P2R_SLOT + P2R_SB + lane * 16; _Pragma("unroll") for (int s4 = 0; s4 < 4; ++s4) *(LAS bf16x8v*)(slw_ + s4 * 1024) = sb_[s4]; } \
        asm volatile("" ::: "memory"); if (lane == 0) flags[8 + slot_] = (unsigned)((m_) + 1); \
        f32x16 n0_, n1_; { const LAS float* gl_ = (const LAS float*)(lds + slot_ * P2R_SLOT + P2R_GAM) + 4 * hf; \
            _Pragma("unroll") for (int g = 0; g < 4; ++g) { const f32x4 g0 = *(const LAS f32x4*)(gl_ + 8 * g), g1 = *(const LAS f32x4*)(gl_ + 32 + 8 * g); \
                _Pragma("unroll") for (int e = 0; e < 4; ++e) { n0_[4 * g + e] = S0t[4 * g + e] * g0[e] + u0_[4 * g + e]; n1_[4 * g + e] = S1t[4 * g + e] * g1[e] + u1_[4 * g + e]; } } } \
        asm volatile("s_waitcnt lgkmcnt(0)" ::: "memory"); if (lane == 0) flags[5] = (unsigned)((m_) + 1);     \
        _Pragma("unroll") for (int s4 = 0; s4 < 4; ++s4) { n0_ = MFMA32(GP_[s4], sb_[s4], n0_); n1_ = MFMA32(GP_[4 + s4], sb_[s4], n1_); } \
        if ((m_) + 1 < nc) { C_WAIT((m_) + 1); C_LOAD((m_) + 1, NGP_, NKP_, NV0_, NV1_); }     \
        S0t = n0_; S1t = n1_; } while (0)
    __builtin_amdgcn_s_setprio(3);
    C_WAIT(0); C_LOAD(0, gpA, kpA, v0A, v1A);
    for (int m = 0; m < nc; m += 2) {
        C_STEP(m, gpA, kpA, v0A, v1A, gpB, kpB, v0B, v1B);
        C_STEP(m + 1, gpB, kpB, v0B, v1B, gpA, kpA, v0A, v1A);
    }
    __builtin_amdgcn_s_setprio(0);
#undef C_WAIT
#undef C_LOAD
#undef C_STEP
#if defined(TPROBE) && TPROBE == 103
    if (X == 0) __hip_atomic_store((unsigned*)(p->ws + WS_CTL) + 8192, (unsigned)wacc_, __ATOMIC_RELAXED, __HIP_MEMORY_SCOPE_AGENT);
#endif
    if (sfin) {
#pragma unroll
        for (int g = 0; g < 4; ++g) { *(f32x4*)(sfin + (size_t)vcol * 64 + 8 * g + 4 * hf) = (f32x4){S0t[4 * g], S0t[4 * g + 1], S0t[4 * g + 2], S0t[4 * g + 3]};
            *(f32x4*)(sfin + (size_t)vcol * 64 + 32 + 8 * g + 4 * hf) = (f32x4){S1t[4 * g], S1t[4 * g + 1], S1t[4 * g + 2], S1t[4 * g + 3]}; }
    }
}
__device__ __forceinline__ void late_convert_item(KPtr p, LAS float* scr, int it, int lane) {
    bf16* W1 = (bf16*)(p->ws + WS_W1); bf16* W2 = (bf16*)(p->ws + WS_W2); bf16* Wo = (bf16*)(p->ws + WS_WO); bf16* Wout = (bf16*)(p->ws + WS_WOUT);
    if (it < 2048) p0_transpose_item(p->in[I_W1], DFF, W1, 1024, 0, scr, it, lane);
    else if (it < 4096) p0_transpose_item(p->in[I_W2], DM, W2, 4096, 0, scr, it - 2048, lane);
    else if (it < 4608) p0_transpose_item(p->in[I_WO], DM, Wo, 1024, 0, scr, it - 4096, lane);
    else if (it < 4864) p0_transpose_item(p->in[I_WOR], DM, Wout, 512, 0, scr, it - 4608, lane);
    else p0_transpose_item(p->in[I_WOC], DM, Wout, 512, 1024, scr, it - 4864, lane);
}
__global__ void __launch_bounds__(NWAVES * 64, 2) fwd_kernel(Params p_unused) {
    extern __shared__ __attribute__((aligned(16))) unsigned char lds_raw[];
    LAS unsigned char* lds = (LAS unsigned char*)lds_raw;
    volatile LAS unsigned* MISC = (volatile LAS unsigned*)(lds + MISC_OFF);
    const int G = gridDim.x; int bx = blockIdx.x, vcu = (G % 8 == 0) ? (bx % 8) * (G / 8) + bx / 8 : bx;
    const int NGW = G * NWAVES;
    const int wave0 = __builtin_amdgcn_readfirstlane(threadIdx.x >> 6);
    for (int u = threadIdx.x; u < (LDS_BYTES - LDSCTL_OFF) / 4; u += NWAVES * 64) ((LAS unsigned*)(lds + LDSCTL_OFF))[u] = 0u;
#define TID_VARS KPtr p = kp0; asm volatile("" : "+s"(p)); unsigned char* ws = p->ws; (void)ws; int lane; PG8_LANE(lane); const int wave = wave0, tid = wave0 * 64 + lane, gw = vcu * NWAVES + wave; (void)tid; (void)gw;
    __syncthreads();
    const KPtr kp0 = (KPtr)__builtin_amdgcn_kernarg_segment_ptr();
    const int lo = kp0->ph_lo, hi = kp0->ph_hi, dupm = kp0->dupmask;
    const bool multi = (hi - lo) > 1;
#ifdef TPROBE
    unsigned long long tA_ = 0, tB_ = 0;
#define TMARK(i) do { if ((i) == TPROBE) tA_ = __builtin_amdgcn_s_memrealtime(); if ((i) == TPROBE + 1) tB_ = __builtin_amdgcn_s_memrealtime(); } while (0)
#define TSUB_BEGIN(id, cond) unsigned long long ts_ = 0; if (TPROBE == (id) && (cond)) ts_ = __builtin_amdgcn_s_memrealtime();
#define TSUB_BEGIN2(id, cond) if (TPROBE == (id) && (cond)) ts_ = __builtin_amdgcn_s_memrealtime();
#define TSUB_END(id, cond) if (TPROBE == (id) && (cond)) { const unsigned dtv_ = (unsigned)(__builtin_amdgcn_s_memrealtime() - ts_); __hip_atomic_store((unsigned*)(kp0->ws + WS_CTL) + 8192, dtv_, __ATOMIC_RELAXED, __HIP_MEMORY_SCOPE_AGENT); }
#define TSUB_END2(id, cond) TSUB_END(id, cond)
#define TMAX_END(id, cond) if (TPROBE == (id) && (cond)) { const unsigned dtv_ = (unsigned)(__builtin_amdgcn_s_memrealtime() - ts_); int l_; PG8_LANE(l_); if (l_ == 0) __hip_atomic_fetch_max((unsigned*)(kp0->ws + WS_CTL) + 8192, dtv_, __ATOMIC_RELAXED, __HIP_MEMORY_SCOPE_AGENT); }
#else
#define TMAX_END(id, cond)
#define TMARK(i) do { } while (0)
#define TSUB_BEGIN(id, cond)
#define TSUB_END(id, cond)
#define TSUB_BEGIN2(id, cond)
#define TSUB_END2(id, cond)
#endif
    TMARK(0);
#if defined(TPROBE) && TPROBE == 122
    if (wave0 == 0) { const unsigned t0_ = (unsigned)__builtin_amdgcn_s_memrealtime(); int l_; PG8_LANE(l_); if (l_ == 0) { __hip_atomic_fetch_max((unsigned*)(kp0->ws + WS_CTL) + 8193, t0_, __ATOMIC_RELAXED, __HIP_MEMORY_SCOPE_AGENT); __hip_atomic_fetch_max((unsigned*)(kp0->ws + WS_CTL) + 8194, ~t0_, __ATOMIC_RELAXED, __HIP_MEMORY_SCOPE_AGENT); } }
#endif
    XcdBarrier bar; bar.bar = (unsigned*)(kp0->ws + WS_CTL) + CW_BAR; bar.x = 0; bar.st = nullptr;
    if (multi) bar = xcd_barrier_post((unsigned*)(kp0->ws + WS_CTL) + CW_BAR, MISC + 8);
#ifndef PHMASK
#define PHMASK 0xffff
#endif
#define IN(k) (((PHMASK >> (k)) & 1) && lo <= (k) && (k) < hi)
#ifndef DUPMASK
#define DUPMASK 0
#endif
#define REP(k) for (int rep_ = 0; rep_ < 1 + ((dupm >> (k)) & 1); ++rep_)
#ifndef BARDUP
#define BARDUP 0
#endif
#define SEAM(k) do { if (IN(k) && IN((k) + 1)) { xcd_barrier(bar, wave0); if (BARDUP) xcd_barrier(bar, wave0); } } while (0)
    if (IN(0)) REP(0) { TID_VARS TSUB_BEGIN(110, vcu == 0 && wave0 == 0) TSUB_BEGIN2(111, vcu == 200 && wave0 == 0) TSUB_BEGIN2(114, vcu == 100 && wave0 == 0) TSUB_BEGIN2(115, vcu == 170 && wave0 == 0) TSUB_BEGIN2(116, vcu == 50 && wave0 == 5) TSUB_BEGIN2(120, true) TSUB_BEGIN2(129, true) p0_prologue(p, lds, vcu, G, tid); TSUB_END(110, vcu == 0 && wave0 == 0) TSUB_END2(111, vcu == 200 && wave0 == 0) TSUB_END2(114, vcu == 100 && wave0 == 0) TSUB_END2(115, vcu == 170 && wave0 == 0) TSUB_END2(116, vcu == 50 && wave0 == 5) TMAX_END(120, true)
#if defined(TPROBE) && TPROBE == 129
        { const unsigned dtv_ = (unsigned)(__builtin_amdgcn_s_memrealtime() - ts_); if (lane == 0) __hip_atomic_fetch_max((unsigned*)(kp0->ws + WS_CTL) + 8196, (dtv_ << 11) | (unsigned)gw, __ATOMIC_RELAXED, __HIP_MEMORY_SCOPE_AGENT); }
#endif
        }
    if (IN(1)) REP(1) { TID_VARS TSUB_BEGIN(113, vcu == 0 && wave0 == 0)
        if (IN(0)) {
            if (tid == 0) { unsigned* cnt = (unsigned*)(ws + WS_CTL) + CW_MODCNT; unsigned sp = 0;
                while (__hip_atomic_load(cnt, __ATOMIC_RELAXED, __HIP_MEMORY_SCOPE_AGENT) < (G == 256 ? 64u : 192u) * (1u + ((dupm >> 0) & 1))) { __builtin_amdgcn_s_sleep(2); if (++sp > (1u << 22)) break; }
                __builtin_amdgcn_fence(__ATOMIC_ACQUIRE, "agent"); asm volatile("s_waitcnt vmcnt(0)" ::: "memory"); }
            __syncthreads();
        }
        TSUB_END(113, vcu == 0 && wave0 == 0) TSUB_BEGIN2(112, vcu == 0 && wave0 == 0) TSUB_BEGIN2(121, true)
        p1_norm1(p, gw, NGW, lane); TSUB_END2(112, vcu == 0 && wave0 == 0) TMAX_END(121, true) } SEAM(1); TMARK(1);
    if (IN(2)) REP(2) {
        KPtr p = kp0; asm volatile("" : "+s"(p)); unsigned char* ws = p->ws;
        typedef pg8::Gemm<1024, 1024, 1024, 1 << 20, 0, 1 << 20, 0> GT; GT g{(const bf16*)(ws + WS_XN), (const bf16*)(ws + WS_WIN)};
        pg8::StaticOrder S; S.init(NTOK, N_IN, G, bx);
        EpiG1 E{(bf16*)(ws + WS_RKV), (bf16*)(ws + WS_PB), (bf16*)(ws + WS_A2), (unsigned char*)(ws + WS_GATE8)};
        pg8::gemm_phase<EpiG1, pg8::StaticOrder, GT, true, true>(lds, g, S, E, wave0);
    } SEAM(2); TMARK(2);
    if (IN(4)) REP(4) { TID_VARS
        TSUB_BEGIN(123, true) TSUB_BEGIN2(124, true) TSUB_BEGIN2(125, true) TSUB_BEGIN2(126, true) TSUB_BEGIN2(127, true) TSUB_BEGIN2(128, true)
        { LAS unsigned char* wl = lds + wave * P1_WAVE_LDS;
            for (int W = vcu * 4 + ((wave + (wave >> 2)) & 3) + (wave >> 2) * (G * 4); W < 4096; W += G * 8) { if (W & 1) p4_pass1<1>(p, wl, W >> 1, gw); else p4_pass1<0>(p, wl, W >> 1, gw); } }
        TMAX_END(123, true) TMAX_END(125, (wave & 1) == 0) TMAX_END(126, (wave & 1) == 1) TMAX_END(127, wave < 4) TMAX_END(128, wave >= 4)
#if defined(TPROBE) && TPROBE == 124
        { const unsigned dtv_ = ~(unsigned)(__builtin_amdgcn_s_memrealtime() - ts_); int l_; PG8_LANE(l_); if (l_ == 0) __hip_atomic_fetch_max((unsigned*)(kp0->ws + WS_CTL) + 8195, dtv_, __ATOMIC_RELAXED, __HIP_MEMORY_SCOPE_AGENT); }
#endif
        __syncthreads();
    } SEAM(4); TMARK(3);
    if (IN(5)) REP(5) { KPtr p = kp0; asm volatile("" : "+s"(p));
        if (G == 256) {
            const int slot5 = vcu & 31, grp5 = vcu >> 5, Xl = (slot5 & 1) + 2 * grp5 + 16 * (slot5 >> 1), vc5 = grp5 * 24 + slot5 - 8;
            if (slot5 < 8) {
                if (wave0 == 0) { int l_; PG8_LANE(l_); if (l_ < 16) ((volatile LAS unsigned*)(lds + P2R_FLAGS))[l_] = 0u; }
                __syncthreads();
                if (wave0 == 0) { TSUB_BEGIN(100, vcu == 0) p5_ring_consumer(p, lds, Xl); TSUB_END(100, vcu == 0) } else if (wave0 == 1) p5_ring_ywave(p, lds, Xl); else p5_ring_helper(p, lds, Xl, wave0 - 2);
                __syncthreads();
            } else {
                if (wave0 < 3) { TSUB_BEGIN(101, vcu == 64 && wave0 == 0) const int Xc = vc5 * 3 + wave0; if (Xc < 512) p5_pass2_wave(p, 64 + Xc); TSUB_END(101, vcu == 64 && wave0 == 0) }
                else { TSUB_BEGIN(102, vcu == 64 && wave0 == 3) int lane; PG8_LANE(lane); LAS float* scr = (LAS float*)(lds + wave0 * 16384);
                    bf16* W1 = (bf16*)(p->ws + WS_W1); bf16* W2 = (bf16*)(p->ws + WS_W2);
                    for (int it = vc5 * 5 + (wave0 - 3); it < 5120; it += 192 * 5) late_convert_item(p, scr, it, lane); TSUB_END(102, vcu == 64 && wave0 == 3) }
                __syncthreads();
                { int lane; PG8_LANE(lane); const int tid = wave0 * 64 + lane; if (vc5 < 128) p0_mod_item(p, lds, 64 + vc5, tid);
                  __syncthreads();
                  if (vc5 < 128) p4_conv_item(p, lds, vc5, tid); else { p4_conv_item(p, lds, 128 + 2 * (vc5 - 128), tid); p4_conv_item(p, lds, 129 + 2 * (vc5 - 128), tid); } }
            }
        } else {
            for (int X = wave0 * G + vcu; X < 576; X += NWAVES * G) p5_pass2_wave(p, X);
            { int lane; PG8_LANE(lane); LAS float* scr = (LAS float*)(lds + wave0 * 16384); bf16* W1 = (bf16*)(p->ws + WS_W1); bf16* W2 = (bf16*)(p->ws + WS_W2);
              for (int it = vcu * NWAVES + wave0; it < 5120; it += G * NWAVES) late_convert_item(p, scr, it, lane); }
        }
    } SEAM(5); TMARK(4);
    bool locs = false;
    if (multi && IN(5) && IN(6)) { const unsigned rk_ = __builtin_amdgcn_readfirstlane(MISC[10]), xx_ = __builtin_amdgcn_readfirstlane(MISC[11]), un_ = __builtin_amdgcn_readfirstlane(MISC[12]);
        if (un_) { locs = true; bx = (int)(rk_ * 8u + xx_); vcu = (int)(xx_ * (unsigned)(G / 8) + rk_); } }
#define SEAML(k) do { if (IN(k) && IN((k) + 1)) { if (locs) xcd_barrier_local(bar, wave0); else xcd_barrier(bar, wave0); } } while (0)
    if (IN(6)) REP(6) { TID_VARS p6_phase(p, lds, vcu, G, tid, gw, NGW, lane); } SEAML(6); TMARK(5);
    if (IN(7)) REP(7) {
        KPtr p = kp0; asm volatile("" : "+s"(p)); unsigned char* ws = p->ws;
        typedef pg8::Gemm<1024, 512, 512, 4, 512, 1 << 20, 0> GT; GT g{(const bf16*)(ws + WS_RC), (const bf16*)(ws + WS_WOUT)};
        pg8::StaticOrder S; S.init(NTOK, 2048, G, bx);
        EpiG3 E{(const unsigned char*)(ws + WS_GATE8), (bf16*)(ws + WS_GM)};
        pg8::gemm_phase<EpiG3, pg8::StaticOrder, GT, true, true>(lds, g, S, E, wave0);
    } SEAML(7); TMARK(6);
    if (IN(8)) REP(8) {
        KPtr p = kp0; asm volatile("" : "+s"(p)); unsigned char* ws = p->ws;
        typedef pg8::Gemm<2048, 1024, 1024, 4, 1024, 4, 0> GT; GT g{(const bf16*)(ws + WS_GM), (const bf16*)(ws + WS_WO)};
        pg8::StaticOrder S; S.init(NTOK, 2048, G, bx);
        EpiPart E{(bf16*)(ws + WS_PART)};
        pg8::gemm_phase<EpiPart, pg8::StaticOrder, GT, true, true>(lds, g, S, E, wave0);
    } SEAML(8); TMARK(7);
    if (IN(9)) REP(9) { TID_VARS p7_res_norm2(p, gw, NGW, lane); } SEAM(9); TMARK(8);
    if (IN(10)) REP(10) {
        KPtr p = kp0; asm volatile("" : "+s"(p)); unsigned char* ws = p->ws;
        typedef pg8::Gemm<1024, 1024, 1024, 1 << 20, 0, 1 << 20, 0> GT; GT g{(const bf16*)(ws + WS_XN), (const bf16*)(ws + WS_W1)};
        pg8::StaticOrder S; S.init(NTOK, DFF, G, bx);
        EpiG5 E{(bf16*)(ws + WS_H)};
        pg8::gemm_phase<EpiG5, pg8::StaticOrder, GT, true, true>(lds, g, S, E, wave0);
    } SEAML(10); TMARK(9);
    if (IN(11)) REP(11) {
        KPtr p = kp0; asm volatile("" : "+s"(p)); unsigned char* ws = p->ws;
        typedef pg8::Gemm<4096, 4096, 2048, 4, 2048, 4, 2048> GT; GT g{(const bf16*)(ws + WS_H), (const bf16*)(ws + WS_W2)};
        pg8::StaticOrder S; S.init(NTOK, 2048, G, bx);
        EpiPart E{(bf16*)(ws + WS_PART)};
        pg8::gemm_phase<EpiPart, pg8::StaticOrder, GT, true, true>(lds, g, S, E, wave0);
    } SEAML(11); TMARK(10);
    if (IN(12)) REP(12) { TID_VARS p12_final(p, gw, NGW, lane); } TMARK(11);
#ifdef TPROBE
    if (vcu == 0 && wave0 == 0) { const unsigned long long dt_ = (TPROBE == 129 ? (unsigned long long)((__hip_atomic_load((unsigned*)(kp0->ws + WS_CTL) + 8196, __ATOMIC_RELAXED, __HIP_MEMORY_SCOPE_AGENT) & 2047u) * 5u) : TPROBE == 124 ? (unsigned long long)(~__hip_atomic_load((unsigned*)(kp0->ws + WS_CTL) + 8195, __ATOMIC_RELAXED, __HIP_MEMORY_SCOPE_AGENT)) : TPROBE == 122 ? (unsigned long long)(__hip_atomic_load((unsigned*)(kp0->ws + WS_CTL) + 8193, __ATOMIC_RELAXED, __HIP_MEMORY_SCOPE_AGENT) - ~__hip_atomic_load((unsigned*)(kp0->ws + WS_CTL) + 8194, __ATOMIC_RELAXED, __HIP_MEMORY_SCOPE_AGENT)) : TPROBE >= 100 ? (unsigned long long)__hip_atomic_load((unsigned*)(kp0->ws + WS_CTL) + 8192, __ATOMIC_RELAXED, __HIP_MEMORY_SCOPE_AGENT) : (tB_ - tA_)) * TGAIN, te_ = __builtin_amdgcn_s_memrealtime(); while (__builtin_amdgcn_s_memrealtime() - te_ < dt_) { __builtin_amdgcn_s_sleep(8); } }
#endif
#undef IN
#undef SEAM
}

extern "C" void kernel_launch(void* const* d_in, const int* in_sizes, int n_in, void* d_out, int out_size, void* d_ws, size_t ws_size, hipStream_t stream) {
    static int grid = 0;
    if (grid == 0) {
        if (n_in != 36 || ws_size < WS_END) { fprintf(stderr, "kernel_launch: unexpected n_in %d / ws %zu\n", n_in, ws_size); grid = -1; return; }
        int dev = 0, cus = 0, per_cu = 0;
        if (hipGetDevice(&dev) != hipSuccess || hipDeviceGetAttribute(&cus, hipDeviceAttributeMultiprocessorCount, dev) != hipSuccess) { grid = -1; return; }
        if (hipFuncSetAttribute((const void*)fwd_kernel, hipFuncAttributeMaxDynamicSharedMemorySize, LDS_BYTES) != hipSuccess) { fprintf(stderr, "kernel_launch: hipFuncSetAttribute failed\n"); grid = -1; return; }
        if (hipOccupancyMaxActiveBlocksPerMultiprocessor(&per_cu, (const void*)fwd_kernel, NWAVES * 64, LDS_BYTES) != hipSuccess || per_cu < 1)
            fprintf(stderr, "kernel_launch: occupancy query reports %d\n", per_cu);
        (void)hipGetLastError();
        grid = cus;
    }
    if (grid < 0) return;
    if (hipMemsetAsync((char*)d_ws + WS_CTL, 0, CTL_ZERO_BYTES, stream) != hipSuccess) { fprintf(stderr, "kernel_launch: memset failed\n"); return; }
#ifdef EXTRA_MEMSET
    if (hipMemsetAsync((char*)d_ws + WS_CTL + 32768, 0, 64, stream) != hipSuccess) return;
#endif
    Params a{};
    for (int i = 0; i < 36; ++i) a.in[i] = (const float*)d_in[i];
    a.out = (float*)d_out; a.ws = (unsigned char*)d_ws; a.dupmask = DUPMASK;
#if MK_ONE_LAUNCH
    a.ph_lo = 0; a.ph_hi = NPH;
    hipLaunchKernelGGL(fwd_kernel, dim3(grid), dim3(NWAVES * 64), LDS_BYTES, stream, a);
#else
    for (int ph = 0; ph < NPH; ++ph) { a.ph_lo = ph; a.ph_hi = ph + 1; hipLaunchKernelGGL(fwd_kernel, dim3(grid), dim3(NWAVES * 64), LDS_BYTES, stream, a); }
#endif
    const hipError_t le = hipPeekAtLastError();
    if (le != hipSuccess) fprintf(stderr, "kernel_launch: launch failed: %s\n", hipGetErrorName(le));
}
```
